# Optimizing an MI355X kernel written in HIP

```python
import jax, jax.numpy as jnp
from jax import lax
import numpy as np

D_MODEL = 1024
BATCH = 16
SEQ = 2048
DEPTH = 1

CHUNK = 64
D_MIX = D_MODEL
D_CONV = D_MIX // 2
CONV_GROUPS = 8
CONV_GROUP_DIM = D_CONV // CONV_GROUPS
CONV_WIDTH = 3
D_RWKV = D_MIX - D_CONV
RWKV_HEAD_DIM = 64
RWKV_HEADS = D_RWKV // RWKV_HEAD_DIM
DECAY_LORA = 64
AAA_LORA = 64
GATE_LORA = 128
N_EXPERTS = 32
TOP_K = 4
D_EXPERT = D_MODEL
SWIGLU_LIMIT = 7.0
SWIGLU_ALPHA = 1.702
NORM_EPS = 1e-5
GN_EPS = 64e-5
MOE_BLOCK = 256

COLS_CONV = 3 * D_CONV
COLS_RWKV = 3 * D_RWKV + DECAY_LORA + AAA_LORA + GATE_LORA
D_IN_PROJ = COLS_CONV + COLS_RWKV

kernel_name = 'hymba_conv_rwkv7_moe_adaln_block'


def rms_norm(x, gain):
    xf = x.astype(jnp.float32)
    y = xf * lax.rsqrt(jnp.mean(xf * xf, axis=-1, keepdims=True) + NORM_EPS)
    return (y * gain.astype(jnp.float32)).astype(x.dtype)


def modulate(h, shift, scale):
    return h * (1 + scale[:, None, :]) + shift[:, None, :]


def causal_shift(p):
    return jnp.pad(p, ((0, 0), (1, 0), (0, 0)))[:, :-1]


def short_conv_mixer(p_conv, conv_w, conv_gn):
    b_gate, c_gate, h = jnp.split(p_conv, 3, axis=-1)
    u = c_gate * h
    y = lax.conv_general_dilated(
        u, conv_w[:, None, :].astype(u.dtype), window_strides=(1,),
        padding=[(CONV_WIDTH - 1, 0)], dimension_numbers=('NWC', 'WIO', 'NWC'),
        feature_group_count=D_CONV)
    y = (b_gate * y).astype(jnp.float32)
    bn, t, _ = y.shape
    yg = y.reshape(bn, t, CONV_GROUPS, CONV_GROUP_DIM)
    yg = yg * lax.rsqrt(jnp.mean(yg * yg, axis=-1, keepdims=True) + NORM_EPS)
    return (yg.reshape(bn, t, D_CONV) * conv_gn.astype(jnp.float32)).astype(p_conv.dtype)


def rwkv7_mixer(p_rwkv, mu, w0, w_up, a0, a_up, g_up, k_k, k_a, r_k, ln_w, ln_b):
    p = p_rwkv + (causal_shift(p_rwkv) - p_rwkv) * mu
    s1, s2, s3 = D_RWKV, 2 * D_RWKV, 3 * D_RWKV
    r, k, v, dw, da, dg = jnp.split(p, [s1, s2, s3, s3 + DECAY_LORA, s3 + DECAY_LORA + AAA_LORA], axis=-1)
    w_log = -jax.nn.softplus(-(w0 + jnp.tanh(dw) @ w_up)) - 0.5
    decay = jnp.exp(-jnp.exp(w_log.astype(jnp.float32)))
    a = jax.nn.sigmoid(a0 + da @ a_up)
    g = (jax.nn.sigmoid(dg) @ g_up).astype(jnp.float32)
    bn, t, _ = r.shape

    def heads(z):
        return z.reshape(bn, t, RWKV_HEADS, RWKV_HEAD_DIM).astype(jnp.float32)

    r, k, v, a, decay = heads(r), heads(k), heads(v), heads(a), heads(decay)
    hn = (RWKV_HEADS, RWKV_HEAD_DIM)
    kk = k * k_k.reshape(hn).astype(jnp.float32)
    kk = kk / jnp.maximum(jnp.sqrt(jnp.sum(kk * kk, axis=-1, keepdims=True)), 1e-12)
    k = k * (1 + (a - 1) * k_a.reshape(hn).astype(jnp.float32))

    def step(state, inp):
        r_t, w_t, k_t, v_t, kk_t, a_t = inp
        sa = jnp.einsum('bhij,bhj->bhi', state, -kk_t)
        state = (state * w_t[:, :, None, :]
                 + sa[..., :, None] * (kk_t * a_t)[..., None, :]
                 + v_t[..., :, None] * k_t[..., None, :])
        return state, jnp.einsum('bhij,bhj->bhi', state, r_t)

    xs = tuple(jnp.moveaxis(z, 1, 0) for z in (r, decay, k, v, kk, a))
    state0 = jnp.zeros((bn, RWKV_HEADS, RWKV_HEAD_DIM, RWKV_HEAD_DIM), jnp.float32)
    _, o = lax.scan(step, state0, xs)
    o = jnp.moveaxis(o, 0, 1)
    mean = jnp.mean(o, axis=-1, keepdims=True)
    var = jnp.mean(jnp.square(o - mean), axis=-1, keepdims=True)
    o = (o - mean) * lax.rsqrt(var + GN_EPS) * ln_w.reshape(hn).astype(jnp.float32) + ln_b.reshape(hn).astype(jnp.float32)
    o = o + jnp.sum(r * k * r_k.reshape(hn).astype(jnp.float32), axis=-1, keepdims=True) * v
    return (o.reshape(bn, t, D_RWKV) * g).astype(p_rwkv.dtype)


def moe_ffn(h, router_w, router_b, w1, b1, w2, b2):
    bn, t, d = h.shape
    xf = h.reshape(-1, d)
    n_tok = xf.shape[0]
    n_rows = n_tok * TOP_K
    logits = (xf @ router_w + router_b).astype(jnp.float32)
    top_logits, top_idx = lax.top_k(logits, TOP_K)
    gates = jax.nn.softmax(top_logits, axis=-1)
    flat_e = top_idx.reshape(-1)
    flat_tok = jnp.repeat(jnp.arange(n_tok, dtype=jnp.int32), TOP_K)
    flat_g = gates.reshape(-1)
    order = jnp.argsort(flat_e)
    e_sorted, tok_sorted, g_sorted = flat_e[order], flat_tok[order], flat_g[order]
    counts = jnp.bincount(flat_e, length=N_EXPERTS)
    padded = (counts + MOE_BLOCK - 1) // MOE_BLOCK * MOE_BLOCK
    pad_end = jnp.cumsum(padded)
    pad_start = pad_end - padded
    start = jnp.cumsum(counts) - counts
    dest = pad_start[e_sorted] + jnp.arange(n_rows, dtype=jnp.int32) - start[e_sorted]
    n_blocks = -(-n_rows // MOE_BLOCK) + N_EXPERTS
    m_pad = n_blocks * MOE_BLOCK
    row_tok = jnp.zeros((m_pad,), jnp.int32).at[dest].set(tok_sorted)
    row_gate = jnp.zeros((m_pad,), jnp.float32).at[dest].set(g_sorted)
    block_expert = jnp.minimum(
        jnp.searchsorted(pad_end, jnp.arange(n_blocks, dtype=jnp.int32) * MOE_BLOCK, side='right'),
        N_EXPERTS - 1)

    def expert_block(args):
        e, toks, gts = args
        xb = xf[toks]
        hb = xb @ w1[e] + b1[e]
        x_glu = jnp.minimum(hb[:, ::2], SWIGLU_LIMIT)
        x_lin = jnp.clip(hb[:, 1::2], -SWIGLU_LIMIT, SWIGLU_LIMIT)
        act = x_glu * jax.nn.sigmoid(SWIGLU_ALPHA * x_glu) * (x_lin + 1)
        yb = act @ w2[e] + b2[e]
        return yb * gts[:, None].astype(yb.dtype)

    y_rows = lax.map(expert_block, (block_expert,
                                    row_tok.reshape(n_blocks, MOE_BLOCK),
                                    row_gate.reshape(n_blocks, MOE_BLOCK)))
    y = jax.ops.segment_sum(y_rows.reshape(m_pad, d), row_tok, num_segments=n_tok)
    return y.reshape(bn, t, d)


def setup_inputs(seed: int = 0) -> dict:
    key = jax.random.key(seed)
    ks = jax.random.split(key, 30)
    L = DEPTH

    def nrm(k, shape, s):
        return jax.random.normal(k, shape, jnp.float32) * s

    return {
        'x': nrm(ks[0], (BATCH, SEQ, D_MODEL), 1.0),
        'c': nrm(ks[1], (BATCH, D_MODEL), 1.0),
        'ada_w': nrm(ks[2], (L, D_MODEL, 6 * D_MODEL), 0.5 * D_MODEL ** -0.5),
        'ada_b': nrm(ks[3], (L, 6 * D_MODEL), 0.01),
        'norm1_g': 1.0 + nrm(ks[4], (L, D_MODEL), 0.05),
        'w_in': nrm(ks[5], (L, D_MODEL, D_IN_PROJ), D_MODEL ** -0.5),
        'conv_w': nrm(ks[6], (L, CONV_WIDTH, D_CONV), CONV_WIDTH ** -0.5),
        'conv_gn': 1.0 + nrm(ks[7], (L, D_CONV), 0.05),
        'rwkv_mu': jax.random.uniform(ks[8], (L, COLS_RWKV), jnp.float32),
        'rwkv_w0': jax.random.uniform(ks[9], (L, D_RWKV), jnp.float32, -6.0, 1.0),
        'rwkv_w_up': nrm(ks[10], (L, DECAY_LORA, D_RWKV), 0.5 * DECAY_LORA ** -0.5),
        'rwkv_a0': nrm(ks[11], (L, D_RWKV), 0.1),
        'rwkv_a_up': nrm(ks[12], (L, AAA_LORA, D_RWKV), AAA_LORA ** -0.5),
        'rwkv_g_up': nrm(ks[13], (L, GATE_LORA, D_RWKV), GATE_LORA ** -0.5),
        'rwkv_k_k': 0.85 + nrm(ks[14], (L, D_RWKV), 0.05),
        'rwkv_k_a': 1.0 + nrm(ks[15], (L, D_RWKV), 0.05),
        'rwkv_r_k': nrm(ks[16], (L, D_RWKV), 0.1),
        'rwkv_ln_w': 1.0 + nrm(ks[17], (L, D_RWKV), 0.05),
        'rwkv_ln_b': nrm(ks[18], (L, D_RWKV), 0.01),
        'w_out': nrm(ks[19], (L, D_MIX, D_MODEL), D_MIX ** -0.5),
        'norm2_g': 1.0 + nrm(ks[20], (L, D_MODEL), 0.05),
        'router_w': nrm(ks[21], (L, D_MODEL, N_EXPERTS), D_MODEL ** -0.5),
        'router_b': nrm(ks[22], (L, N_EXPERTS), 0.01),
        'exp_w1': nrm(ks[23], (L, N_EXPERTS, D_MODEL, 2 * D_EXPERT), D_MODEL ** -0.5),
        'exp_b1': nrm(ks[24], (L, N_EXPERTS, 2 * D_EXPERT), 0.01),
        'exp_w2': nrm(ks[25], (L, N_EXPERTS, D_EXPERT, D_MODEL), D_EXPERT ** -0.5),
        'exp_b2': nrm(ks[26], (L, N_EXPERTS, D_MODEL), 0.01),
        'final_g': 1.0 + nrm(ks[27], (D_MODEL,), 0.05),
    }


def reference(x, c, ada_w, ada_b, norm1_g, w_in, conv_w, conv_gn, rwkv_mu, rwkv_w0, rwkv_w_up,
              rwkv_a0, rwkv_a_up, rwkv_g_up, rwkv_k_k, rwkv_k_a, rwkv_r_k, rwkv_ln_w, rwkv_ln_b,
              w_out, norm2_g, router_w, router_b, exp_w1, exp_b1, exp_w2, exp_b2, final_g):
    h = x
    c_act = jax.nn.silu(c)
    for l in range(DEPTH):
        mod = c_act @ ada_w[l] + ada_b[l]
        sh1, sc1, gt1, sh2, sc2, gt2 = jnp.split(mod, 6, axis=-1)
        u = modulate(rms_norm(h, norm1_g[l]), sh1, sc1)
        proj = u @ w_in[l]
        y_conv = short_conv_mixer(proj[..., :COLS_CONV], conv_w[l], conv_gn[l])
        y_rwkv = rwkv7_mixer(proj[..., COLS_CONV:], rwkv_mu[l], rwkv_w0[l], rwkv_w_up[l],
                             rwkv_a0[l], rwkv_a_up[l], rwkv_g_up[l], rwkv_k_k[l], rwkv_k_a[l],
                             rwkv_r_k[l], rwkv_ln_w[l], rwkv_ln_b[l])
        mix = jnp.concatenate([y_conv, y_rwkv], axis=-1) @ w_out[l]
        h = h + gt1[:, None, :] * mix
        u2 = modulate(rms_norm(h, norm2_g[l]), sh2, sc2)
        h = h + gt2[:, None, :] * moe_ffn(u2, router_w[l], router_b[l], exp_w1[l], exp_b1[l],
                                           exp_w2[l], exp_b2[l])
    return rms_norm(h, final_g)
```

```cpp
#include <hip/hip_runtime.h>
#include <cstdio>
#include <cstdint>

#ifndef MK_N_LAUNCHES
#define MK_N_LAUNCHES 1
#endif

#define LAS __attribute__((address_space(3)))
#define GAS __attribute__((address_space(1)))
typedef unsigned short bf16_t;
typedef short bf16x8 __attribute__((ext_vector_type(8)));
typedef float f32x4 __attribute__((ext_vector_type(4)));
typedef float f32x16 __attribute__((ext_vector_type(16)));
typedef float f32x2 __attribute__((ext_vector_type(2)));
typedef unsigned u32x4 __attribute__((ext_vector_type(4)));
typedef unsigned u32x2 __attribute__((ext_vector_type(2)));
typedef GAS unsigned gu32;
#define RLX_AGENT __ATOMIC_RELAXED, __HIP_MEMORY_SCOPE_AGENT
#define LDS_WAIT() asm volatile("s_waitcnt lgkmcnt(0)" ::: "memory")
#define VM_WAIT() asm volatile("s_waitcnt vmcnt(0)" ::: "memory")

constexpr int D = 1024, BATCH = 16, SEQ = 2048, M = BATCH * SEQ;
constexpr int NIN = 3328;
constexpr int COL_B = 0, COL_C = 512, COL_H = 1024, COL_R = 1536, COL_K = 2048, COL_V = 2560, COL_DW = 3072;
constexpr int NE = 32, LCAP = 32768;
constexpr int CL = 32, NCH = SEQ / CL;
constexpr int NBH = BATCH * 8;
constexpr float NORM_EPS = 1e-5f, GN_EPS = 64e-5f;
constexpr int CHB = 27648;
constexpr int CH_PL = 26624;

constexpr size_t MiB = 1u << 20;
constexpr size_t WS_CTL = 0, CTL_ZERO_BYTES = 64 * 1024;
constexpr size_t WS_MOD = 1 * MiB;
constexpr size_t WS_LORA = 2 * MiB;
constexpr size_t WS_WOUT = 3 * MiB;
constexpr size_t WS_WIN = 5 * MiB;
constexpr size_t WS_LIST = 12 * MiB;
constexpr size_t WS_GATE = 16 * MiB;
constexpr size_t WS_W1T = 17 * MiB;
constexpr size_t WS_W2T = 145 * MiB;
constexpr size_t WS_U = 209 * MiB;
constexpr size_t WS_YMIX = 273 * MiB;
constexpr size_t WS_PROJ = 337 * MiB;
constexpr size_t WS_CH = 545 * MiB;
constexpr size_t WS_OT = 761 * MiB;
constexpr size_t WS_G = 825 * MiB;
constexpr size_t WS_V = 857 * MiB;
constexpr size_t WS_BON = 889 * MiB;
constexpr size_t WS_ACT = 337 * MiB;
constexpr size_t WS_PAIR = 609 * MiB;
constexpr size_t WS_END = 890 * MiB;
constexpr int CW_TMO = 0;
constexpr int CW_CNT = 64;
constexpr int CW_BAR = 4096;

constexpr int RING_BYTES = 131072;
constexpr int MISC_OFF = 144 * 1024;
constexpr int LDS_BYTES = 147456;

__device__ __forceinline__ unsigned f2bf(float f) { unsigned u = __builtin_bit_cast(unsigned, f); return (u + 0x7fffu + ((u >> 16) & 1u)) >> 16; }
__device__ __forceinline__ unsigned pk2(float lo, float hi) { return f2bf(lo) | (f2bf(hi) << 16); }
__device__ __forceinline__ float bf2f(unsigned short h) { return __builtin_bit_cast(float, (unsigned)h << 16); }
__device__ __forceinline__ float bflo(unsigned w) { return __builtin_bit_cast(float, w << 16); }
__device__ __forceinline__ float bfhi(unsigned w) { return __builtin_bit_cast(float, w & 0xffff0000u); }
__device__ __forceinline__ float wave_sum(float v) {
#pragma unroll
    for (int o = 1; o < 64; o <<= 1) v += __shfl_xor(v, o);
    return v;
}
__device__ __forceinline__ float wave_max(float v) {
#pragma unroll
    for (int o = 1; o < 64; o <<= 1) v = fmaxf(v, __shfl_xor(v, o));
    return v;
}
__device__ __forceinline__ float fast_sigmoid(float x) { return __builtin_amdgcn_rcpf(1.0f + __expf(-x)); }
__device__ __forceinline__ bf16x8 pack8(float a0, float a1, float a2, float a3, float a4, float a5, float a6, float a7) {
    u32x4 w; w.x = pk2(a0, a1); w.y = pk2(a2, a3); w.z = pk2(a4, a5); w.w = pk2(a6, a7); return __builtin_bit_cast(bf16x8, w);
}

#define XB_TMO      128
#define XB_XCNT(j)  (256  + 64 * (j))
#define XB_XSUB(j)  (1280 + 64 * (j))
#define XB_XGEN(j)  (2304 + 64 * (j))
#define XB_TOP      3328
#define XB_TOPGEN   3392
#define XCD_BAR_WORDS 3456
#define XB_SPIN_CAP (1u << 20)
__device__ __forceinline__ unsigned xb_ld(unsigned* p)              { return __hip_atomic_load(p, __ATOMIC_RELAXED, __HIP_MEMORY_SCOPE_AGENT); }
__device__ __forceinline__ unsigned xb_add(unsigned* p, unsigned v) { return __hip_atomic_fetch_add(p, v, __ATOMIC_RELAXED, __HIP_MEMORY_SCOPE_AGENT); }
__device__ __forceinline__ unsigned xb_xcc_id() { return (unsigned)__builtin_amdgcn_s_getreg((3 << 11) | 20) & 0xFu; }
#define XB_SPIN(cond, bar) do { unsigned _sp = 0; while (cond) { __builtin_amdgcn_s_sleep(1); \
    if ((++_sp & 255u) == 0u) { if (xb_ld(&(bar)[XB_TMO])) break; if (_sp > XB_SPIN_CAP) { atomicAdd(&(bar)[XB_TMO], 1u); break; } } } } while (0)
struct XcdBarrier { unsigned* bar; unsigned x; volatile LAS unsigned* st; };
__device__ __forceinline__ XcdBarrier xcd_barrier_post(unsigned* bar, volatile LAS unsigned* st) {
    XcdBarrier b; b.bar = bar; b.x = xb_xcc_id(); b.st = st;
    if (threadIdx.x == 0) (void)xb_add(&bar[XB_XCNT(b.x)], 1u);
    return b;
}
__device__ __forceinline__ void xcd_barrier_complete(unsigned* bar, unsigned x, unsigned& nloc, unsigned& nx) {
    const unsigned G = gridDim.x * gridDim.y * gridDim.z;
    unsigned sum, cnt, mine, sp = 0u;
    for (;;) {
        sum = 0u; cnt = 0u; mine = 0u;
#pragma unroll
        for (unsigned j = 0; j < 16; ++j) { const unsigned c = xb_ld(&bar[XB_XCNT(j)]); sum += c; cnt += (c > 0u) ? 1u : 0u; mine = (j == x) ? c : mine; }
        if (sum == G) break;
        __builtin_amdgcn_s_sleep(1);
        if ((++sp & 255u) == 0u) { if (xb_ld(&bar[XB_TMO])) break; if (sp > XB_SPIN_CAP) { atomicAdd(&bar[XB_TMO], 1u); break; } }
    }
    nloc = mine > 0u ? mine : 1u; nx = cnt > 0u ? cnt : 1u;
}
__device__ __forceinline__ void xcd_barrier(const XcdBarrier& b) {
    asm volatile("s_waitcnt vmcnt(0)" ::: "memory");
    __syncthreads();
    if (threadIdx.x == 0) {
        unsigned* bar = b.bar;
        __builtin_amdgcn_s_waitcnt(0);
        unsigned nloc = b.st[0], nx = b.st[1];
        if (nloc == 0u) { xcd_barrier_complete(bar, b.x, nloc, nx); b.st[0] = nloc; b.st[1] = nx; }
        const unsigned old = xb_add(&bar[XB_XSUB(b.x)], 1u);
        const unsigned gen = old / nloc;
        if (old + 1u == (gen + 1u) * nloc) {
            __builtin_amdgcn_fence(__ATOMIC_RELEASE, "agent");
            asm volatile("s_waitcnt vmcnt(0)" ::: "memory");
            const unsigned og = xb_add(&bar[XB_TOP], 1u);
            const unsigned tg = og / nx;
            if (og + 1u == (tg + 1u) * nx) xb_add(&bar[XB_TOPGEN], 1u);
            else XB_SPIN(xb_ld(&bar[XB_TOPGEN]) == tg, bar);
            __builtin_amdgcn_fence(__ATOMIC_ACQUIRE, "agent");
            xb_add(&bar[XB_XGEN(b.x)], 1u);
            asm volatile("s_waitcnt vmcnt(0)" ::: "memory");
        } else {
            XB_SPIN(xb_ld(&bar[XB_XGEN(b.x)]) == gen, bar);
            __builtin_amdgcn_fence(__ATOMIC_ACQUIRE, "agent");
            asm volatile("s_waitcnt vmcnt(0)" ::: "memory");
        }
    }
    __syncthreads();
}

namespace pg8 {
constexpr int BM = 256, BK = 64, HALF = 128, HTB = HALF * BK * 2, NXCD = 8, WGM = 8;
__host__ __device__ __forceinline__ int lds_byte(int r, int c) { const int st = (r >> 4) * 2 + (c >> 5), rr = r & 15, cc = c & 31, ob = rr * 64 + cc * 2; return st * 1024 + (ob ^ (((ob >> 9) & 1) << 5)); }
__host__ __device__ __forceinline__ void stage_rc(int b, int& R, int& C) { const int st = b / 1024, sb = b % 1024, swz = sb ^ (((sb >> 9) & 1) << 5); R = (st >> 1) * 16 + swz / 64; C = (st & 1) * 32 + (swz % 64) / 2; }
__host__ __device__ __forceinline__ int perm32(int rho) { const int n = rho >> 4, i = rho & 15; return 8 * (i >> 2) + 4 * n + (i & 3); }
struct Unit { int pm, pn; };
__device__ __forceinline__ bool tile_order(int i, int G, int c, int nM, int nN, Unit& u) {
    const int nwg = nM * nN; const long L = (long)i * G + c; if (L >= nwg) return false;
    int wgid = (int)L; { const int q = nwg / NXCD, r = nwg % NXCD, xcd = wgid % NXCD, off = wgid / NXCD; wgid = (xcd < r ? xcd * (q + 1) : r * (q + 1) + (xcd - r) * q) + off; }
    const int nig = WGM * nN, gid = wgid / nig, fm = gid * WGM, gsz = (nM - fm) < WGM ? (nM - fm) : WGM;
    u.pm = fm + ((wgid % nig) % gsz); u.pn = (wgid % nig) / gsz; return true;
}
__device__ __forceinline__ unsigned cvt_pk_bf16(float lo, float hi) { unsigned r; asm volatile("v_cvt_pk_bf16_f32 %0, %1, %2" : "=v"(r) : "v"(lo), "v"(hi)); return r; }

template <class Epi, class Sched, bool GATHER, bool ALIGN_EPI>
__device__ __forceinline__ void gemm_phase(LAS unsigned char* lds, const int K, const Sched& S, const Epi& E) {
    const int tid = threadIdx.x, wid = __builtin_amdgcn_readfirstlane(tid >> 6), lane = tid & 63, wr = wid >> 2, wc = wid & 3, fr = lane & 15, fq = lane >> 4;
    const int nt = K / BK;
    unsigned voffA[2], voffB[2]; int rowA[2];
#pragma unroll
    for (int i = 0; i < 2; ++i) { int R, C; stage_rc(tid * 16 + i * 8192, R, C); const int Rb = Epi::PERM ? ((R & ~31) + perm32(R & 31)) : R;
        voffA[i] = (unsigned)(R * K + C) * 2u; voffB[i] = (unsigned)(Rb * K + C) * 2u; rowA[i] = R; if (GATHER) voffA[i] = (unsigned)C * 2u; }
    const size_t kstep = (size_t)(BK * 2);
    const size_t hstep = (size_t)HALF * K * 2;
    const unsigned ldsw = (unsigned)wid * 1024u;
    const int aoff = lds_byte(wr * 64 + fr, fq * 8), boff = lds_byte(wc * 32 + fr, fq * 8);
#define PG8_SA(b, h) (((b) * 2 + (h)) * HTB)
#define PG8_SB(b, h) ((4 + (b) * 2 + (h)) * HTB)
#define PG8_STAGE2(bufoff, gbase, o0, o1) do { \
        __builtin_amdgcn_global_load_lds((const unsigned*)((const char*)(gbase) + (o0)), (LAS unsigned*)(lds + (bufoff) + ldsw), 16, 0, 0); \
        __builtin_amdgcn_global_load_lds((const unsigned*)((const char*)(gbase) + (o1)), (LAS unsigned*)(lds + (bufoff) + ldsw + 8192), 16, 0, 0); } while (0)
#define PG8_STAGEB(bufoff, gbase) PG8_STAGE2(bufoff, gbase, voffB[0], voffB[1])
#define PG8_STAGEA(bufoff, kp, hh, OS) do { if (GATHER) PG8_STAGE2(bufoff, kp, OS[hh][0], OS[hh][1]); else PG8_STAGE2(bufoff, (kp) + (hh) * hstep, voffA[0], voffA[1]); } while (0)
#define PG8_LDA(dst, b, h) do { _Pragma("unroll") for (int m = 0; m < 4; ++m) _Pragma("unroll") for (int k = 0; k < 2; ++k) dst[m][k] = *(const LAS bf16x8*)(lds + PG8_SA(b, h) + aoff + m * 2048 + k * 1024); } while (0)
#define PG8_LDB(dst, b, h) do { _Pragma("unroll") for (int n = 0; n < 2; ++n) _Pragma("unroll") for (int k = 0; k < 2; ++k) dst[n][k] = *(const LAS bf16x8*)(lds + PG8_SB(b, h) + boff + n * 2048 + k * 1024); } while (0)
#define PG8_MMA(ai, bj, At, Bt) do { __builtin_amdgcn_s_setprio(1); _Pragma("unroll") for (int m = 0; m < 4; ++m) _Pragma("unroll") for (int n = 0; n < 2; ++n) _Pragma("unroll") for (int k = 0; k < 2; ++k) \
        acc[ai][bj][m][n] = __builtin_amdgcn_mfma_f32_16x16x32_bf16(Bt[n][k], At[m][k], acc[ai][bj][m][n], 0, 0, 0); __builtin_amdgcn_s_setprio(0); } while (0)
#define PG8_WAIT_V(n) asm volatile("s_waitcnt vmcnt(" #n ")" ::: "memory")
#define PG8_WAIT_L(n) asm volatile("s_waitcnt lgkmcnt(" #n ")" ::: "memory")
#define PG8_BAR __builtin_amdgcn_s_barrier()
#define PG8_SCHED __builtin_amdgcn_sched_barrier(0)
    Unit cur, nxt; int ui = 0;
    if (!S.next(0, cur)) return;
    f32x4 acc[2][2][4][2];
#pragma unroll
    for (int a = 0; a < 2; ++a)
#pragma unroll
        for (int b = 0; b < 2; ++b)
#pragma unroll
            for (int m = 0; m < 4; ++m)
#pragma unroll
                for (int n = 0; n < 2; ++n) acc[a][b][m][n] = (f32x4){0.f, 0.f, 0.f, 0.f};
    bf16x8 At[4][2], B0[2][2], B1[2][2];
    unsigned gC[2][2], gN[2][2];
    const char* cA = S.a_base(cur); const char* cB = S.b_base(cur);
    if (GATHER) { S.a_rows(cur, rowA, gC);
#pragma unroll
        for (int h = 0; h < 2; ++h)
#pragma unroll
            for (int i = 0; i < 2; ++i) gC[h][i] += voffA[i]; }
    PG8_STAGEB(PG8_SB(0, 0), cB); PG8_STAGEB(PG8_SB(0, 1), cB + hstep); PG8_STAGEA(PG8_SA(0, 0), cA, 0, gC); PG8_STAGEA(PG8_SA(0, 1), cA, 1, gC);
    if (wr == 1) PG8_BAR;
    PG8_WAIT_V(2); PG8_BAR;
    PG8_STAGEB(PG8_SB(1, 0), cB + kstep); PG8_STAGEA(PG8_SA(1, 0), cA + kstep, 0, gC); PG8_STAGEB(PG8_SB(1, 1), cB + hstep + kstep);
    PG8_WAIT_V(6); PG8_BAR;
    for (;;) {
        const bool has_next = S.next(ui + 1, nxt);
        const char* nA = has_next ? S.a_base(nxt) : cA; const char* nB = has_next ? S.b_base(nxt) : cB;
        if (GATHER) { if (has_next) { S.a_rows(nxt, rowA, gN);
#pragma unroll
                for (int h = 0; h < 2; ++h)
#pragma unroll
                    for (int i = 0; i < 2; ++i) gN[h][i] += voffA[i]; }
            else {
#pragma unroll
                for (int h = 0; h < 2; ++h)
#pragma unroll
                    for (int i = 0; i < 2; ++i) gN[h][i] = gC[h][i]; } }
        for (int t = 0; t < nt; t += 2) {
            const bool last = (t == nt - 2);
            const char* a1 = cA + (size_t)(t + 1) * kstep;
            const char* a2 = last ? nA : cA + (size_t)(t + 2) * kstep; const char* b2 = last ? nB : cB + (size_t)(t + 2) * kstep;
            const char* a3 = a2 + kstep; const char* b3 = b2 + kstep;
            unsigned g2[2][2];
            if (GATHER) {
#pragma unroll
                for (int h = 0; h < 2; ++h)
#pragma unroll
                    for (int i = 0; i < 2; ++i) g2[h][i] = last ? gN[h][i] : gC[h][i]; }
            PG8_LDB(B0, 0, 0); PG8_LDB(B1, 0, 1); PG8_SCHED; PG8_LDA(At, 0, 0); PG8_STAGEA(PG8_SA(1, 1), a1, 1, gC);
            PG8_WAIT_V(8); PG8_WAIT_L(0); PG8_BAR; PG8_MMA(0, 0, At, B0); PG8_MMA(0, 1, At, B1); PG8_BAR; PG8_SCHED;
            PG8_LDA(At, 0, 1); PG8_STAGEB(PG8_SB(0, 0), b2); PG8_STAGEB(PG8_SB(0, 1), b2 + hstep); PG8_STAGEA(PG8_SA(0, 0), a2, 0, g2);
            PG8_WAIT_V(8); PG8_WAIT_L(0); PG8_BAR; PG8_MMA(1, 0, At, B0); PG8_MMA(1, 1, At, B1); PG8_BAR; PG8_SCHED;
            PG8_LDB(B0, 1, 0); PG8_LDB(B1, 1, 1); PG8_SCHED; PG8_LDA(At, 1, 0); PG8_STAGEA(PG8_SA(0, 1), a2, 1, g2);
            PG8_WAIT_V(8); PG8_WAIT_L(0); PG8_BAR; PG8_MMA(0, 0, At, B0); PG8_MMA(0, 1, At, B1); PG8_BAR; PG8_SCHED;
            PG8_LDA(At, 1, 1); PG8_STAGEB(PG8_SB(1, 0), b3); PG8_STAGEB(PG8_SB(1, 1), b3 + hstep); PG8_STAGEA(PG8_SA(1, 0), a3, 0, g2);
            PG8_WAIT_V(8); PG8_WAIT_L(0); PG8_BAR; PG8_MMA(1, 0, At, B0); PG8_MMA(1, 1, At, B1); PG8_BAR; PG8_SCHED;
        }
        if constexpr (ALIGN_EPI) { if (wr == 0) PG8_BAR; }
        E(acc, cur, wr, wc, fr, fq);
        if (!has_next) break;
#pragma unroll
        for (int a = 0; a < 2; ++a)
#pragma unroll
            for (int b = 0; b < 2; ++b)
#pragma unroll
                for (int m = 0; m < 4; ++m)
#pragma unroll
                    for (int n = 0; n < 2; ++n) acc[a][b][m][n] = (f32x4){0.f, 0.f, 0.f, 0.f};
        cur = nxt; cA = nA; cB = nB; ++ui;
        if (GATHER) {
#pragma unroll
            for (int h = 0; h < 2; ++h)
#pragma unroll
                for (int i = 0; i < 2; ++i) gC[h][i] = gN[h][i]; }
        if constexpr (ALIGN_EPI) { if (wr == 1) PG8_BAR; }
    }
    PG8_WAIT_V(0);
    if constexpr (!ALIGN_EPI) { if (wr == 0) PG8_BAR; }
    PG8_BAR;
#undef PG8_SA
#undef PG8_SB
#undef PG8_STAGE2
#undef PG8_STAGEA
#undef PG8_STAGEB
#undef PG8_LDA
#undef PG8_LDB
#undef PG8_MMA
#undef PG8_WAIT_V
#undef PG8_WAIT_L
#undef PG8_BAR
#undef PG8_SCHED
}
}
using pg8::Unit;

struct DenseSched {
    const char* A; const char* Bt; int nM, nN, G, c; size_t tstep;
    __device__ __forceinline__ bool next(int i, Unit& u) const { return pg8::tile_order(i, G, c, nM, nN, u); }
    __device__ __forceinline__ const char* a_base(const Unit& u) const { return A + (size_t)u.pm * tstep; }
    __device__ __forceinline__ const char* b_base(const Unit& u) const { return Bt + (size_t)u.pn * tstep; }
    __device__ __forceinline__ void a_rows(const Unit&, const int (&)[2], unsigned (&)[2][2]) const {}
};
struct MoeSched {
    const char* A; const char* Wt; size_t estride; int nM, nN, G, c; size_t tstep;
    const volatile LAS int* bstart; const volatile LAS int* cnt; const int* list; int K2; bool gather;
    __device__ __forceinline__ int expert_of(int pm) const { int e = 0;
#pragma unroll 1
        for (int j = 1; j < NE; ++j) e += (bstart[j] <= pm) ? 1 : 0; return e; }
    __device__ __forceinline__ bool next(int i, Unit& u) const { return pg8::tile_order(i, G, c, nM, nN, u); }
    __device__ __forceinline__ const char* a_base(const Unit& u) const { return gather ? A : A + (size_t)u.pm * tstep; }
    __device__ __forceinline__ const char* b_base(const Unit& u) const { const int e = expert_of(u.pm); return Wt + (size_t)e * estride + (size_t)u.pn * tstep; }
    __device__ __forceinline__ void a_rows(const Unit& u, const int (&rowA)[2], unsigned (&o)[2][2]) const {
        const int e = expert_of(u.pm), rb = u.pm - bstart[e], n = cnt[e];
#pragma unroll
        for (int h = 0; h < 2; ++h)
#pragma unroll
            for (int i = 0; i < 2; ++i) { const int idx = rb * 256 + h * 128 + rowA[i]; int tok = 0; if (idx < n) tok = list[e * LCAP + idx] >> 2; o[h][i] = (unsigned)tok * (unsigned)K2; }
    }
};

struct EpiBf16 {
    static constexpr bool PERM = true;
    bf16_t* O; int ldc;
    __device__ __forceinline__ void operator()(const f32x4 (&acc)[2][2][4][2], const Unit& u, int wr, int wc, int fr, int fq) const {
        const int row0 = u.pm * 256 + wr * 64 + fr, col0 = u.pn * 256 + wc * 32 + 8 * fq;
#pragma unroll
        for (int ai = 0; ai < 2; ++ai)
#pragma unroll
            for (int m = 0; m < 4; ++m) { bf16_t* rowp = O + (size_t)(row0 + ai * 128 + m * 16) * ldc + col0;
#pragma unroll
                for (int bj = 0; bj < 2; ++bj) { const f32x4 v0 = acc[ai][bj][m][0], v1 = acc[ai][bj][m][1];
                    u32x4 w; w.x = pg8::cvt_pk_bf16(v0[0], v0[1]); w.y = pg8::cvt_pk_bf16(v0[2], v0[3]); w.z = pg8::cvt_pk_bf16(v1[0], v1[1]); w.w = pg8::cvt_pk_bf16(v1[2], v1[3]);
                    *(u32x4*)(rowp + bj * 128) = w; } }
    }
};
struct EpiResid {
    static constexpr bool PERM = false;
    const float* X; float* H; const float* mod;
    __device__ __forceinline__ void operator()(const f32x4 (&acc)[2][2][4][2], const Unit& u, int wr, int wc, int fr, int fq) const {
        const int b = (u.pm * 256) >> 11; const int col0 = u.pn * 256 + wc * 32 + 4 * fq;
        f32x4 gt[2][2];
#pragma unroll
        for (int bj = 0; bj < 2; ++bj)
#pragma unroll
            for (int n = 0; n < 2; ++n) gt[bj][n] = *(const f32x4*)(mod + b * 6144 + 2048 + col0 + bj * 128 + n * 16);
#pragma unroll
        for (int ai = 0; ai < 2; ++ai)
#pragma unroll
            for (int m = 0; m < 4; ++m) { const size_t off = (size_t)(u.pm * 256 + ai * 128 + wr * 64 + m * 16 + fr) * D + col0;
#pragma unroll
                for (int bj = 0; bj < 2; ++bj)
#pragma unroll
                    for (int n = 0; n < 2; ++n) { const f32x4 xv = *(const f32x4*)(X + off + bj * 128 + n * 16); *(f32x4*)(H + off + bj * 128 + n * 16) = xv + gt[bj][n] * acc[ai][bj][m][n]; } }
    }
};
struct EpiSwiglu {
    static constexpr bool PERM = true;
    bf16_t* ACT; const float* b1; const MoeSched* S;
    __device__ __forceinline__ void operator()(const f32x4 (&acc)[2][2][4][2], const Unit& u, int wr, int wc, int fr, int fq) const {
        const int e = S->expert_of(u.pm);
        const int row0 = u.pm * 256 + wr * 64 + fr, col0 = u.pn * 256 + wc * 32 + 8 * fq;
        f32x4 bv[2][2];
#pragma unroll
        for (int bj = 0; bj < 2; ++bj)
#pragma unroll
            for (int n = 0; n < 2; ++n) bv[bj][n] = *(const f32x4*)(b1 + (size_t)e * 2048 + col0 + bj * 128 + 4 * n);
#pragma unroll
        for (int ai = 0; ai < 2; ++ai)
#pragma unroll
            for (int m = 0; m < 4; ++m) { bf16_t* rowp = ACT + (size_t)(row0 + ai * 128 + m * 16) * 1024 + (col0 >> 1);
#pragma unroll
                for (int bj = 0; bj < 2; ++bj) { float a[4];
#pragma unroll
                    for (int n = 0; n < 2; ++n) { const f32x4 v = acc[ai][bj][m][n] + bv[bj][n];
#pragma unroll
                        for (int p = 0; p < 2; ++p) { const float g = fminf(v[2 * p], 7.0f), l = fminf(fmaxf(v[2 * p + 1], -7.0f), 7.0f);
                            a[2 * n + p] = g * fast_sigmoid(1.702f * g) * (l + 1.0f); } }
                    u32x2 w; w.x = pg8::cvt_pk_bf16(a[0], a[1]); w.y = pg8::cvt_pk_bf16(a[2], a[3]);
                    *(u32x2*)(rowp + bj * 64) = w; } }
    }
};
struct EpiPair {
    static constexpr bool PERM = true;
    bf16_t* PAIR; const float* b2; const float* gate; const MoeSched* S;
    __device__ __forceinline__ void operator()(const f32x4 (&acc)[2][2][4][2], const Unit& u, int wr, int wc, int fr, int fq) const {
        const int e = S->expert_of(u.pm), rb = u.pm - S->bstart[e], n_e = S->cnt[e];
        const int col0 = u.pn * 256 + wc * 32 + 8 * fq;
        f32x4 bv[2][2];
#pragma unroll
        for (int bj = 0; bj < 2; ++bj)
#pragma unroll
            for (int n = 0; n < 2; ++n) bv[bj][n] = *(const f32x4*)(b2 + (size_t)e * 1024 + col0 + bj * 128 + 4 * n);
#pragma unroll
        for (int ai = 0; ai < 2; ++ai)
#pragma unroll
            for (int m = 0; m < 4; ++m) { const int idx = rb * 256 + ai * 128 + wr * 64 + m * 16 + fr;
                if (idx < n_e) { const int pair = S->list[e * LCAP + idx]; const float g = gate[pair]; bf16_t* rowp = PAIR + (size_t)pair * 1024 + col0;
#pragma unroll
                    for (int bj = 0; bj < 2; ++bj) { const f32x4 v0 = (acc[ai][bj][m][0] + bv[bj][0]) * g, v1 = (acc[ai][bj][m][1] + bv[bj][1]) * g;
                        u32x4 w; w.x = pg8::cvt_pk_bf16(v0[0], v0[1]); w.y = pg8::cvt_pk_bf16(v0[2], v0[3]); w.z = pg8::cvt_pk_bf16(v1[0], v1[1]); w.w = pg8::cvt_pk_bf16(v1[2], v1[3]);
                        *(u32x4*)(rowp + bj * 128) = w; } } }
    }
};

struct Args { const float* in[28]; float* out; unsigned char* ws; int ph_lo, ph_hi; };
enum { I_X = 0, I_C, I_ADAW, I_ADAB, I_N1G, I_WIN, I_CONVW, I_CONVGN, I_MU, I_W0, I_WUP, I_A0, I_AUP, I_GUP, I_KK, I_KA, I_RK, I_LNW, I_LNB, I_WOUT, I_N2G, I_RW, I_RB, I_W1, I_B1, I_W2, I_B2, I_FG };
constexpr int NWAVES = 8;
constexpr int LDS_TOTAL = 163840;
constexpr int LDS_MISC = LDS_TOTAL - 512;

__device__ __forceinline__ void p0_mod_unit(const Args& a, int u, LAS unsigned char* lds, int tid) {
    LAS float* cact = (LAS float*)lds; LAS float* red = (LAS float*)(lds + 65536);
    const float* c = a.in[I_C];
    for (int i = tid; i < 16 * 1024; i += 512) { const float v = c[i]; cact[i] = v * fast_sigmoid(v); }
    __syncthreads();
    const int kq = tid >> 5, col = tid & 31;
    float acc[16];
#pragma unroll
    for (int b = 0; b < 16; ++b) acc[b] = 0.f;
    const float* w = a.in[I_ADAW] + (size_t)(kq * 64) * 6144 + u * 32 + col;
#pragma unroll 4
    for (int k = 0; k < 64; ++k) { const float wv = w[(size_t)k * 6144];
#pragma unroll
        for (int b = 0; b < 16; ++b) acc[b] += cact[b * 1024 + kq * 64 + k] * wv; }
#pragma unroll
    for (int b = 0; b < 16; ++b) red[(kq * 16 + b) * 32 + col] = acc[b];
    __syncthreads();
    { const int b = tid >> 5; float s = a.in[I_ADAB][u * 32 + col];
#pragma unroll
      for (int q = 0; q < 16; ++q) s += red[(q * 16 + b) * 32 + col];
      ((float*)(a.ws + WS_MOD))[b * 6144 + u * 32 + col] = s; }
    __syncthreads();
}
__device__ __forceinline__ void tr_item64(const float* W, int ldw, bf16_t* WT, int ldt, int k0, int n0, LAS float* scr, int lane) {
    const int kr = lane >> 4, c4 = lane & 15;
    f32x4 v[16];
#pragma unroll
    for (int i = 0; i < 16; ++i) v[i] = *(const GAS f32x4*)(W + (size_t)(k0 + 4 * i + kr) * ldw + n0 + 4 * c4);
#pragma unroll
    for (int i = 0; i < 16; ++i) { LAS float* s = scr + (4 * i + kr) * 65 + 4 * c4; s[0] = v[i][0]; s[1] = v[i][1]; s[2] = v[i][2]; s[3] = v[i][3]; }
    LDS_WAIT(); asm volatile("" ::: "memory");
    const int c = lane & 7;
#pragma unroll
    for (int j = 0; j < 8; ++j) { const int n = (lane >> 3) + 8 * j; const LAS float* s = scr + (8 * c) * 65 + n;
        u32x4 o; o.x = pk2(s[0], s[65]); o.y = pk2(s[130], s[195]); o.z = pk2(s[260], s[325]); o.w = pk2(s[390], s[455]);
        *(GAS u32x4*)(WT + (size_t)(n0 + n) * ldt + k0 + 8 * c) = o; }
    LDS_WAIT(); asm volatile("" ::: "memory");
}
__device__ __forceinline__ void tr_matrix_item(const float* W, int K, int N, bf16_t* WT, int item, LAS float* scr, int lane) {
    const int nb = N / 64; tr_item64(W, N, WT, K, (item / nb) * 64, (item % nb) * 64, scr, lane);
}
constexpr int TI_WIN = 16 * 52, TI_WOUT = 16 * 16, TI_UP = 8, TI_GUP = 16, TI_SMALL = TI_WIN + TI_WOUT + 2 * TI_UP + TI_GUP;
constexpr int TI_W1 = 16 * 32, TI_W2 = 16 * 16, TI_TOTAL = TI_SMALL + NE * (TI_W1 + TI_W2);
__device__ __forceinline__ void p0_phase(const Args& a, LAS unsigned char* lds, int tid, int wave, int lane, int vcu, int G) {
    if (blockIdx.x < 192) p0_mod_unit(a, blockIdx.x, lds, tid);
    LAS float* scr = (LAS float*)(lds + wave * 16640);
    unsigned char* ws = a.ws;
    bf16_t* lora = (bf16_t*)(ws + WS_LORA);
    const int gw = vcu * NWAVES + wave, NGW = G * NWAVES;
    for (int it = gw; it < TI_TOTAL; it += NGW) {
        int r = it;
        if (r < TI_WIN) { tr_matrix_item(a.in[I_WIN], 1024, NIN, (bf16_t*)(ws + WS_WIN), r, scr, lane); continue; } r -= TI_WIN;
        if (r < TI_WOUT) { tr_matrix_item(a.in[I_WOUT], 1024, 1024, (bf16_t*)(ws + WS_WOUT), r, scr, lane); continue; } r -= TI_WOUT;
        if (r < TI_UP) { tr_matrix_item(a.in[I_WUP], 64, 512, lora, r, scr, lane); continue; } r -= TI_UP;
        if (r < TI_UP) { tr_matrix_item(a.in[I_AUP], 64, 512, lora + 512 * 64, r, scr, lane); continue; } r -= TI_UP;
        if (r < TI_GUP) { tr_matrix_item(a.in[I_GUP], 128, 512, lora + 2 * 512 * 64, r, scr, lane); continue; } r -= TI_GUP;
        if (r < NE * TI_W1) { const int e = r / TI_W1; tr_matrix_item(a.in[I_W1] + (size_t)e * 1024 * 2048, 1024, 2048, (bf16_t*)(ws + WS_W1T) + (size_t)e * 2048 * 1024, r % TI_W1, scr, lane); continue; } r -= NE * TI_W1;
        { const int e = r / TI_W2; tr_matrix_item(a.in[I_W2] + (size_t)e * 1024 * 1024, 1024, 1024, (bf16_t*)(ws + WS_W2T) + (size_t)e * 1024 * 1024, r % TI_W2, scr, lane); }
    }
}

__device__ __forceinline__ void p1_phase(const Args& a, int wave, int lane, int vcu, int G) {
    const float* mod = (const float*)(a.ws + WS_MOD); bf16_t* U = (bf16_t*)(a.ws + WS_U);
    const int gw = vcu * NWAVES + wave, NGW = G * NWAVES;
    for (int row = gw; row < M; row += NGW) {
        const int b = row >> 11;
        const GAS f32x4* xr = (const GAS f32x4*)(a.in[I_X] + (size_t)row * D) + lane;
        f32x4 v[4]; float s = 0.f;
#pragma unroll
        for (int j = 0; j < 4; ++j) { v[j] = xr[64 * j]; s += (v[j][0] * v[j][0] + v[j][1] * v[j][1]) + (v[j][2] * v[j][2] + v[j][3] * v[j][3]); }
        const float inv = 1.0f / sqrtf(wave_sum(s) * (1.f / D) + NORM_EPS);
        GAS u32x2* o8 = (GAS u32x2*)(U + (size_t)row * D) + lane;
#pragma unroll
        for (int j = 0; j < 4; ++j) { const int col = 4 * lane + 256 * j;
            const f32x4 g = *(const f32x4*)(a.in[I_N1G] + col), sh = *(const f32x4*)(mod + b * 6144 + col), sc = *(const f32x4*)(mod + b * 6144 + 1024 + col);
            const f32x4 y = v[j] * inv * g * (sc + 1.0f) + sh;
            u32x2 w; w.x = pk2(y[0], y[1]); w.y = pk2(y[2], y[3]); o8[64 * j] = w; }
    }
}

__device__ __forceinline__ void p3_conv(const Args& a, int wave, int lane, int vcu, int G) {
    const bf16_t* P = (const bf16_t*)(a.ws + WS_PROJ); bf16_t* Y = (bf16_t*)(a.ws + WS_YMIX);
    const int gw = vcu * NWAVES + wave, NGW = G * NWAVES;
    const int c0 = 8 * lane;
    float w0[8], w1[8], w2[8], gn[8];
#pragma unroll
    for (int e = 0; e < 8; ++e) { w0[e] = a.in[I_CONVW][c0 + e]; w1[e] = a.in[I_CONVW][512 + c0 + e]; w2[e] = a.in[I_CONVW][1024 + c0 + e]; gn[e] = a.in[I_CONVGN][c0 + e]; }
    for (int row = gw; row < M; row += NGW) {
        const int t = row & (SEQ - 1);
        const bf16_t* pr = P + (size_t)row * NIN + c0;
        const u32x4 bg = *(const GAS u32x4*)(pr + COL_B), cg = *(const GAS u32x4*)(pr + COL_C), hg = *(const GAS u32x4*)(pr + COL_H);
        u32x4 c1 = (u32x4){0u, 0u, 0u, 0u}, h1 = c1, c2 = c1, h2 = c1;
        if (t >= 1) { c1 = *(const GAS u32x4*)(pr - NIN + COL_C); h1 = *(const GAS u32x4*)(pr - NIN + COL_H); }
        if (t >= 2) { c2 = *(const GAS u32x4*)(pr - 2 * NIN + COL_C); h2 = *(const GAS u32x4*)(pr - 2 * NIN + COL_H); }
        float y[8]; float ss = 0.f;
#pragma unroll
        for (int q = 0; q < 4; ++q) {
            const float u0l = bflo(cg[q]) * bflo(hg[q]), u0h = bfhi(cg[q]) * bfhi(hg[q]);
            const float u1l = bflo(c1[q]) * bflo(h1[q]), u1h = bfhi(c1[q]) * bfhi(h1[q]);
            const float u2l = bflo(c2[q]) * bflo(h2[q]), u2h = bfhi(c2[q]) * bfhi(h2[q]);
            const float yl = (w0[2 * q] * u2l + w1[2 * q] * u1l + w2[2 * q] * u0l) * bflo(bg[q]);
            const float yh = (w0[2 * q + 1] * u2h + w1[2 * q + 1] * u1h + w2[2 * q + 1] * u0h) * bfhi(bg[q]);
            y[2 * q] = yl; y[2 * q + 1] = yh; ss += yl * yl + yh * yh; }
        ss += __shfl_xor(ss, 1); ss += __shfl_xor(ss, 2); ss += __shfl_xor(ss, 4);
        const float rs = 1.0f / sqrtf(ss * (1.f / 64.f) + NORM_EPS);
        u32x4 o; o.x = pk2(y[0] * rs * gn[0], y[1] * rs * gn[1]); o.y = pk2(y[2] * rs * gn[2], y[3] * rs * gn[3]); o.z = pk2(y[4] * rs * gn[4], y[5] * rs * gn[5]); o.w = pk2(y[6] * rs * gn[6], y[7] * rs * gn[7]);
        *(GAS u32x4*)(Y + (size_t)row * D + c0) = o;
    }
}

__device__ __forceinline__ f32x16 zero16() { f32x16 z;
#pragma unroll
    for (int i = 0; i < 16; ++i) z[i] = 0.f; return z; }
__device__ __forceinline__ int tile_off(int t, int c) { return t * 128 + ((((c >> 3) ^ (t & 7))) << 4) + (c & 7) * 2; }
template <int KC> __device__ __forceinline__ void lora_mm(const LAS unsigned char* codes, int code_off, const bf16_t* WT, int h, int r32, int h2, f32x16 (&acc)[2]) {
    acc[0] = zero16(); acc[1] = zero16();
#pragma unroll
    for (int ks = 0; ks < KC / 16; ++ks) {
        const bf16x8 A = *(const LAS bf16x8*)(codes + r32 * 528 + (code_off + 16 * ks + 8 * h2) * 2);
#pragma unroll
        for (int ct = 0; ct < 2; ++ct) { const bf16x8 B = *(const GAS bf16x8*)(WT + (size_t)(h * 64 + 32 * ct + r32) * KC + 16 * ks + 8 * h2);
            acc[ct] = __builtin_amdgcn_mfma_f32_32x32x16_bf16(A, B, acc[ct], 0, 0, 0); }
    }
}
__device__ __forceinline__ void acc_to_cols(const f32x16 (&acc)[2], LAS float* SC, int lane, int r32, int h2, float (&x)[32]) {
#pragma unroll
    for (int ct = 0; ct < 2; ++ct)
#pragma unroll
        for (int q = 0; q < 4; ++q) *(LAS f32x4*)(SC + (32 * ct + r32) * 36 + 8 * q + 4 * h2) = (f32x4){acc[ct][4 * q], acc[ct][4 * q + 1], acc[ct][4 * q + 2], acc[ct][4 * q + 3]};
    LDS_WAIT(); asm volatile("" ::: "memory");
#pragma unroll
    for (int q = 0; q < 8; ++q) { const f32x4 v = *(const LAS f32x4*)(SC + lane * 36 + 4 * q); x[4 * q] = v[0]; x[4 * q + 1] = v[1]; x[4 * q + 2] = v[2]; x[4 * q + 3] = v[3]; }
    LDS_WAIT(); asm volatile("" ::: "memory");
}
__device__ __forceinline__ void st_frag(unsigned char* blk, int f, int lanepos, u32x4 v) { *(GAS u32x4*)(blk + f * 1024 + lanepos * 16) = v; }
__device__ __forceinline__ u32x4 tile_frag_pi(const LAS unsigned char* T, int t, int ks, int h2) {
    const u32x2 lo = *(const LAS u32x2*)(T + t * 128 + (((2 * ks) ^ (t & 7)) << 4) + 8 * h2);
    const u32x2 hi = *(const LAS u32x2*)(T + t * 128 + (((2 * ks + 1) ^ (t & 7)) << 4) + 8 * h2);
    return (u32x4){lo.x, lo.y, hi.x, hi.y};
}

__device__ __forceinline__ void p3_rwkv_group(const Args& a, int grp, LAS unsigned char* lds, int tid, int wave, int lane) {
    const int b = grp >> 6, ch = grp & 63, t0 = ch * CL; const size_t row0 = (size_t)b * SEQ + t0;
    const bf16_t* P = (const bf16_t*)(a.ws + WS_PROJ);
    LAS unsigned char* codes = lds + 131072;
    {
        const int t = tid >> 4, j0 = (tid & 15) * 16;
        const bf16_t* cur = P + (row0 + t) * NIN + COL_DW + j0;
        const u32x4 c0 = *(const GAS u32x4*)cur, c1 = *(const GAS u32x4*)(cur + 8);
        u32x4 p0 = (u32x4){0u, 0u, 0u, 0u}, p1 = p0;
        if (t0 + t > 0) { p0 = *(const GAS u32x4*)(cur - NIN); p1 = *(const GAS u32x4*)(cur - NIN + 8); }
        const float* mu = a.in[I_MU] + 1536 + j0;
        float o[16];
#pragma unroll
        for (int q = 0; q < 8; ++q) { const unsigned cw = q < 4 ? c0[q] : c1[q - 4], pw = q < 4 ? p0[q] : p1[q - 4];
            const float cl = bflo(cw), chh = bfhi(cw), pl = bflo(pw), ph = bfhi(pw);
            o[2 * q] = cl + (pl - cl) * mu[2 * q]; o[2 * q + 1] = chh + (ph - chh) * mu[2 * q + 1]; }
        if (j0 < 64) {
#pragma unroll
            for (int e = 0; e < 16; ++e) o[e] = 1.0f - 2.0f * __builtin_amdgcn_rcpf(1.0f + __expf(2.0f * o[e]));
        } else if (j0 >= 128) {
#pragma unroll
            for (int e = 0; e < 16; ++e) o[e] = fast_sigmoid(o[e]);
        }
        u32x4 w0, w1; w0.x = pk2(o[0], o[1]); w0.y = pk2(o[2], o[3]); w0.z = pk2(o[4], o[5]); w0.w = pk2(o[6], o[7]);
        w1.x = pk2(o[8], o[9]); w1.y = pk2(o[10], o[11]); w1.z = pk2(o[12], o[13]); w1.w = pk2(o[14], o[15]);
        *(LAS u32x4*)(codes + t * 528 + j0 * 2) = w0; *(LAS u32x4*)(codes + t * 528 + j0 * 2 + 16) = w1;
    }
    __syncthreads();
    const int h = wave, bh = b * 8 + h, hc = h * 64 + lane, r32 = lane & 31, h2 = lane >> 5;
    LAS unsigned char* wl = lds + wave * 16384;
    LAS float* SC = (LAS float*)wl;
    LAS unsigned char* T_A = wl, *T_B = wl + 4096, *T_K = wl + 8192, *T_R = wl + 12288;
    unsigned char* blk = a.ws + WS_CH + ((size_t)bh * NCH + ch) * CHB;
    const bf16_t* lora = (const bf16_t*)(a.ws + WS_LORA);
    f32x16 acc[2]; float x[32];
    const bf16_t* pr = P + row0 * NIN + COL_R + hc;
    unsigned short rr[8], rk_[8], rv[8];
#pragma unroll
    for (int i = 0; i < 8; ++i) { const bf16_t* p = pr + (size_t)i * NIN; rr[i] = p[0]; rk_[i] = p[512]; rv[i] = p[1024]; }
    lora_mm<128>(codes, 128, lora + 2 * 512 * 64, h, r32, h2, acc); acc_to_cols(acc, SC, lane, r32, h2, x);
    { bf16_t* Gp = (bf16_t*)(a.ws + WS_G) + ((size_t)bh * 64 + lane) * SEQ + t0;
#pragma unroll
      for (int q = 0; q < 4; ++q) { u32x4 w; w.x = pk2(x[8 * q], x[8 * q + 1]); w.y = pk2(x[8 * q + 2], x[8 * q + 3]); w.z = pk2(x[8 * q + 4], x[8 * q + 5]); w.w = pk2(x[8 * q + 6], x[8 * q + 7]); *(GAS u32x4*)(Gp + 8 * q) = w; } }
    float cum[32];
    lora_mm<64>(codes, 0, lora, h, r32, h2, acc); acc_to_cols(acc, SC, lane, r32, h2, x);
    { const float w0c = a.in[I_W0][hc]; float run = 0.f;
#pragma unroll
      for (int t = 0; t < 32; ++t) { run -= 0.6065306597f * fast_sigmoid(w0c + x[t]); cum[t] = run; } }
    lora_mm<64>(codes, 64, lora + 512 * 64, h, r32, h2, acc); acc_to_cols(acc, SC, lane, r32, h2, x);
    { const float a0c = a.in[I_A0][hc];
#pragma unroll
      for (int t = 0; t < 32; ++t) x[t] = fast_sigmoid(a0c + x[t]); }
    const float mur = a.in[I_MU][hc], muk = a.in[I_MU][512 + hc], muv = a.in[I_MU][1024 + hc];
    const float kkc = a.in[I_KK][hc], kac = a.in[I_KA][hc], rkc = a.in[I_RK][hc];
    float pr_r = 0.f, pr_k = 0.f, pr_v = 0.f;
    if (t0 > 0) { pr_r = bf2f(pr[-NIN]); pr_k = bf2f(pr[-NIN + 512]); pr_v = bf2f(pr[-NIN + 1024]); }
    unsigned vv2[16]; float bon = 0.f; float e_prev = 1.0f;
#pragma unroll
    for (int bi = 0; bi < 4; ++bi) {
        unsigned short nr[8], nk[8], nv[8];
        if (bi < 3) {
#pragma unroll
            for (int i = 0; i < 8; ++i) { const bf16_t* p = pr + (size_t)(8 * (bi + 1) + i) * NIN; nr[i] = p[0]; nk[i] = p[512]; nv[i] = p[1024]; }
        }
        asm volatile("" ::: "memory");
        float vprev = 0.f;
#pragma unroll
        for (int i = 0; i < 8; ++i) { const int t = 8 * bi + i;
            const float cr = bf2f(rr[i]), ck = bf2f(rk_[i]), cv = bf2f(rv[i]);
            const float r = cr + (pr_r - cr) * mur, k = ck + (pr_k - ck) * muk, v = cv + (pr_v - cv) * muv;
            pr_r = cr; pr_k = ck; pr_v = cv;
            const float kkr = k * kkc; const float nsq = wave_sum(kkr * kkr);
            const float kkn = kkr / fmaxf(sqrtf(nsq), 1e-12f);
            const float at = x[t];
            const float kp = k * (1.0f + (at - 1.0f) * kac);
            const float bs = wave_sum(r * kp * rkc);
            bon = (lane == t) ? bs : bon;
            const float e_cur = __expf(cum[t]), e_neg = __builtin_amdgcn_rcpf(e_cur);
            const float Ah = -kkn * e_prev, Bv = kkn * at * e_neg, Kv = kp * e_neg, Rh = r * e_cur;
            e_prev = e_cur;
            if (i & 1) vv2[t >> 1] = pk2(vprev, v); else vprev = v;
            const int to = tile_off(t, lane);
            *(LAS unsigned short*)(T_A + to) = (unsigned short)f2bf(Ah); *(LAS unsigned short*)(T_B + to) = (unsigned short)f2bf(Bv);
            *(LAS unsigned short*)(T_K + to) = (unsigned short)f2bf(Kv); *(LAS unsigned short*)(T_R + to) = (unsigned short)f2bf(Rh);
        }
        asm volatile("" ::: "memory");
        if (bi < 3) {
#pragma unroll
            for (int i = 0; i < 8; ++i) { rr[i] = nr[i]; rk_[i] = nk[i]; rv[i] = nv[i]; }
        }
    }
    { bf16_t* Vp = (bf16_t*)(a.ws + WS_V) + ((size_t)bh * 64 + lane) * SEQ + t0;
#pragma unroll
      for (int q = 0; q < 4; ++q) *(GAS u32x4*)(Vp + 8 * q) = (u32x4){vv2[4 * q], vv2[4 * q + 1], vv2[4 * q + 2], vv2[4 * q + 3]};
      if (lane < 32) ((float*)(a.ws + WS_BON))[(size_t)bh * SEQ + t0 + lane] = bon;
      *(GAS float*)(blk + CH_PL + lane * 4) = e_prev;
#pragma unroll
      for (int ks = 0; ks < 2; ++ks)
#pragma unroll
          for (int hh = 0; hh < 2; ++hh) { const int s0 = 16 * ks + 4 * hh, s1 = s0 + 8;
              st_frag(blk, 22 + 2 * h2 + ks, 32 * hh + r32, (u32x4){vv2[s0 >> 1], vv2[(s0 >> 1) + 1], vv2[s1 >> 1], vv2[(s1 >> 1) + 1]}); } }
    LDS_WAIT(); asm volatile("" ::: "memory");
    f32x16 ab = zero16(), ak = zero16(), rb = zero16(), rk = zero16();
#pragma unroll
    for (int ks = 0; ks < 4; ++ks) { const int fo = r32 * 128 + (((2 * ks + h2) ^ (r32 & 7)) << 4);
        const bf16x8 fa = *(const LAS bf16x8*)(T_A + fo), fb = *(const LAS bf16x8*)(T_B + fo), fk = *(const LAS bf16x8*)(T_K + fo), frr = *(const LAS bf16x8*)(T_R + fo);
        ab = __builtin_amdgcn_mfma_f32_32x32x16_bf16(fb, fa, ab, 0, 0, 0); ak = __builtin_amdgcn_mfma_f32_32x32x16_bf16(fk, fa, ak, 0, 0, 0);
        rb = __builtin_amdgcn_mfma_f32_32x32x16_bf16(fb, frr, rb, 0, 0, 0); rk = __builtin_amdgcn_mfma_f32_32x32x16_bf16(fk, frr, rk, 0, 0, 0); }
#pragma unroll
    for (int ks = 0; ks < 4; ++ks) st_frag(blk, 4 + ks, lane, tile_frag_pi(T_R, r32, ks, h2));
    { unsigned short tb[32], tk[32];
#pragma unroll
      for (int t = 0; t < 32; ++t) { const int to = tile_off(t, lane); tb[t] = *(const LAS unsigned short*)(T_B + to); tk[t] = *(const LAS unsigned short*)(T_K + to); }
#pragma unroll
      for (int ks = 0; ks < 2; ++ks)
#pragma unroll
          for (int hh = 0; hh < 2; ++hh) { const int s0 = 16 * ks + 4 * hh, s1 = s0 + 8; const int lp = 32 * hh + r32;
              u32x4 w; w.x = (unsigned)tb[s0] | ((unsigned)tb[s0 + 1] << 16); w.y = (unsigned)tb[s0 + 2] | ((unsigned)tb[s0 + 3] << 16); w.z = (unsigned)tb[s1] | ((unsigned)tb[s1 + 1] << 16); w.w = (unsigned)tb[s1 + 2] | ((unsigned)tb[s1 + 3] << 16);
              st_frag(blk, 14 + 4 * h2 + ks, lp, w);
              w.x = (unsigned)tk[s0] | ((unsigned)tk[s0 + 1] << 16); w.y = (unsigned)tk[s0 + 2] | ((unsigned)tk[s0 + 3] << 16); w.z = (unsigned)tk[s1] | ((unsigned)tk[s1 + 1] << 16); w.w = (unsigned)tk[s1 + 2] | ((unsigned)tk[s1 + 3] << 16);
              st_frag(blk, 14 + 4 * h2 + 2 + ks, lp, w); } }
    LDS_WAIT(); asm volatile("" ::: "memory");
#pragma unroll
    for (int ks = 0; ks < 2; ++ks) { float m[8], n[8];
#pragma unroll
        for (int j = 0; j < 8; ++j) { const int r = 8 * ks + j; const int s = (r & 3) + 8 * (r >> 2) + 4 * h2; m[j] = (s <= r32) ? rb[r] : 0.f; n[j] = (s <= r32) ? rk[r] : 0.f; }
        u32x4 w; w.x = pk2(m[0], m[1]); w.y = pk2(m[2], m[3]); w.z = pk2(m[4], m[5]); w.w = pk2(m[6], m[7]); st_frag(blk, 8 + ks, lane, w);
        w.x = pk2(n[0], n[1]); w.y = pk2(n[2], n[3]); w.z = pk2(n[4], n[5]); w.w = pk2(n[6], n[7]); st_frag(blk, 12 + ks, lane, w); }
    LAS float* F_AB = (LAS float*)T_B; LAS float* F_AK = (LAS float*)T_K;
#pragma unroll
    for (int q = 0; q < 4; ++q) { f32x4 u, w;
#pragma unroll
        for (int i = 0; i < 4; ++i) { const int s = 8 * q + 4 * h2 + i; u[i] = (s < r32) ? ab[4 * q + i] : 0.f; w[i] = (s < r32) ? ak[4 * q + i] : 0.f; }
        *(LAS f32x4*)(F_AB + r32 * 32 + 8 * q + 4 * h2) = u; *(LAS f32x4*)(F_AK + r32 * 32 + 8 * q + 4 * h2) = w; }
    LDS_WAIT(); asm volatile("" ::: "memory");
    float xs[32], m1[32];
#pragma unroll
    for (int t = 0; t < 32; ++t) { xs[t] = bf2f(*(const LAS unsigned short*)(T_A + tile_off(t, lane))); m1[t] = F_AK[t * 32 + r32]; }
    {
        f32x4 cfc[8], cfn[8];
        cfc[0] = *(const LAS f32x4*)(F_AB + 32);
#pragma unroll
        for (int t = 1; t < 32; ++t) {
            if (t < 31) {
#pragma unroll
                for (int q = 0; q < (t + 4) / 4; ++q) cfn[q] = *(const LAS f32x4*)(F_AB + (t + 1) * 32 + 4 * q);
            }
            asm volatile("" ::: "memory");
            float s1 = xs[t], s2 = m1[t];
#pragma unroll
            for (int q = 0; q < (t + 3) / 4; ++q) {
#pragma unroll
                for (int i = 0; i < 4; ++i) if (4 * q + i < t) { s1 += cfc[q][i] * xs[4 * q + i]; s2 += cfc[q][i] * m1[4 * q + i]; } }
            xs[t] = s1; m1[t] = s2;
            if (t < 31) {
#pragma unroll
                for (int q = 0; q < (t + 4) / 4; ++q) cfc[q] = cfn[q];
            }
            asm volatile("" : "+v"(xs[t]), "+v"(m1[t]));
        }
    }
    LDS_WAIT(); asm volatile("" ::: "memory");
    LAS unsigned char* T_M = T_A;
#pragma unroll
    for (int t = 0; t < 32; ++t) *(LAS unsigned short*)(T_R + tile_off(t, lane)) = (unsigned short)f2bf(xs[t]);
    if (lane < 32) {
#pragma unroll
        for (int t = 0; t < 32; ++t) *(LAS unsigned short*)(T_M + t * 64 + lane * 2) = (unsigned short)f2bf(m1[t]);
    }
    LDS_WAIT(); asm volatile("" ::: "memory");
#pragma unroll
    for (int ks = 0; ks < 4; ++ks) st_frag(blk, ks, lane, tile_frag_pi(T_R, r32, ks, h2));
#pragma unroll
    for (int ks = 0; ks < 2; ++ks) { const u32x2 lo = *(const LAS u32x2*)(T_M + r32 * 64 + (16 * ks + 4 * h2) * 2), hi = *(const LAS u32x2*)(T_M + r32 * 64 + (16 * ks + 8 + 4 * h2) * 2);
        st_frag(blk, 10 + ks, lane, (u32x4){lo.x, lo.y, hi.x, hi.y}); }
    LDS_WAIT(); asm volatile("" ::: "memory");
    __syncthreads();
}
__device__ __forceinline__ void p3_phase(const Args& a, LAS unsigned char* lds, int tid, int wave, int lane, int vcu, int G) {
    for (int grp = vcu; grp < BATCH * NCH; grp += G) p3_rwkv_group(a, grp, lds, tid, wave, lane);
    p3_conv(a, wave, lane, vcu, G);
}

__device__ __forceinline__ void p4_issue(const unsigned char* blkp, LAS unsigned char* slot, int nt, int lane) {
#pragma unroll
    for (int f = 0; f < 22; ++f) __builtin_amdgcn_global_load_lds((const unsigned*)(blkp + f * 1024 + lane * 16), (LAS unsigned*)(slot + f * 1024), 16, 0, 0);
#pragma unroll
    for (int f = 0; f < 2; ++f) __builtin_amdgcn_global_load_lds((const unsigned*)(blkp + (22 + 2 * nt + f) * 1024 + lane * 16), (LAS unsigned*)(slot + (22 + f) * 1024), 16, 0, 0);
    __builtin_amdgcn_global_load_lds((const unsigned*)(blkp + CH_PL + lane * 4), (LAS unsigned*)(slot + 24576), 4, 0, 0);
}
#define P4_FRAG(f) (*(const LAS bf16x8*)(base + (f) * 1024 + lane * 16))
__device__ __forceinline__ void p4_phase(const Args& a, LAS unsigned char* lds, int wave, int lane) {
    if (wave != 0) return;
    const int w = blockIdx.x; if (w >= 2 * NBH) return;
    const int bh = w >> 1, nt = w & 1, r32 = lane & 31, h2 = lane >> 5;
    const unsigned char* blk0 = a.ws + WS_CH + (size_t)bh * NCH * CHB;
    float* OT = (float*)(a.ws + WS_OT) + ((size_t)bh * 64 + 32 * nt + r32) * SEQ;
    f32x16 S0 = zero16(), S1 = zero16();
    p4_issue(blk0, lds, nt, lane);
    for (int ci = 0; ci < NCH; ++ci) {
        VM_WAIT();
        if (ci + 1 < NCH) p4_issue(blk0 + (size_t)(ci + 1) * CHB, lds + ((ci + 1) & 1) * 28672, nt, lane);
        const LAS unsigned char* base = lds + (ci & 1) * 28672;
        const bf16x8 sb00 = pack8(S0[0], S0[1], S0[2], S0[3], S0[4], S0[5], S0[6], S0[7]), sb01 = pack8(S0[8], S0[9], S0[10], S0[11], S0[12], S0[13], S0[14], S0[15]);
        const bf16x8 sb10 = pack8(S1[0], S1[1], S1[2], S1[3], S1[4], S1[5], S1[6], S1[7]), sb11 = pack8(S1[8], S1[9], S1[10], S1[11], S1[12], S1[13], S1[14], S1[15]);
        const bf16x8 vt0 = P4_FRAG(22), vt1 = P4_FRAG(23);
        f32x16 U = zero16();
        U = __builtin_amdgcn_mfma_f32_32x32x16_bf16(P4_FRAG(0), sb00, U, 0, 0, 0); U = __builtin_amdgcn_mfma_f32_32x32x16_bf16(P4_FRAG(1), sb01, U, 0, 0, 0);
        U = __builtin_amdgcn_mfma_f32_32x32x16_bf16(P4_FRAG(2), sb10, U, 0, 0, 0); U = __builtin_amdgcn_mfma_f32_32x32x16_bf16(P4_FRAG(3), sb11, U, 0, 0, 0);
        U = __builtin_amdgcn_mfma_f32_32x32x16_bf16(P4_FRAG(10), vt0, U, 0, 0, 0); U = __builtin_amdgcn_mfma_f32_32x32x16_bf16(P4_FRAG(11), vt1, U, 0, 0, 0);
        f32x16 O = zero16();
        O = __builtin_amdgcn_mfma_f32_32x32x16_bf16(P4_FRAG(4), sb00, O, 0, 0, 0); O = __builtin_amdgcn_mfma_f32_32x32x16_bf16(P4_FRAG(5), sb01, O, 0, 0, 0);
        O = __builtin_amdgcn_mfma_f32_32x32x16_bf16(P4_FRAG(6), sb10, O, 0, 0, 0); O = __builtin_amdgcn_mfma_f32_32x32x16_bf16(P4_FRAG(7), sb11, O, 0, 0, 0);
        O = __builtin_amdgcn_mfma_f32_32x32x16_bf16(P4_FRAG(12), vt0, O, 0, 0, 0); O = __builtin_amdgcn_mfma_f32_32x32x16_bf16(P4_FRAG(13), vt1, O, 0, 0, 0);
        const bf16x8 ub0 = pack8(U[0], U[1], U[2], U[3], U[4], U[5], U[6], U[7]), ub1 = pack8(U[8], U[9], U[10], U[11], U[12], U[13], U[14], U[15]);
        O = __builtin_amdgcn_mfma_f32_32x32x16_bf16(P4_FRAG(8), ub0, O, 0, 0, 0); O = __builtin_amdgcn_mfma_f32_32x32x16_bf16(P4_FRAG(9), ub1, O, 0, 0, 0);
        S0 = __builtin_amdgcn_mfma_f32_32x32x16_bf16(P4_FRAG(14), ub0, S0, 0, 0, 0); S0 = __builtin_amdgcn_mfma_f32_32x32x16_bf16(P4_FRAG(15), ub1, S0, 0, 0, 0);
        S0 = __builtin_amdgcn_mfma_f32_32x32x16_bf16(P4_FRAG(16), vt0, S0, 0, 0, 0); S0 = __builtin_amdgcn_mfma_f32_32x32x16_bf16(P4_FRAG(17), vt1, S0, 0, 0, 0);
        S1 = __builtin_amdgcn_mfma_f32_32x32x16_bf16(P4_FRAG(18), ub0, S1, 0, 0, 0); S1 = __builtin_amdgcn_mfma_f32_32x32x16_bf16(P4_FRAG(19), ub1, S1, 0, 0, 0);
        S1 = __builtin_amdgcn_mfma_f32_32x32x16_bf16(P4_FRAG(20), vt0, S1, 0, 0, 0); S1 = __builtin_amdgcn_mfma_f32_32x32x16_bf16(P4_FRAG(21), vt1, S1, 0, 0, 0);
#pragma unroll
        for (int q = 0; q < 4; ++q) { const f32x4 p0 = *(const LAS f32x4*)(base + 24576 + (8 * q + 4 * h2) * 4), p1 = *(const LAS f32x4*)(base + 24576 + (32 + 8 * q + 4 * h2) * 4);
#pragma unroll
            for (int i = 0; i < 4; ++i) { S0[4 * q + i] *= p0[i]; S1[4 * q + i] *= p1[i]; }
            *(GAS f32x4*)(OT + ci * CL + 8 * q + 4 * h2) = (f32x4){O[4 * q], O[4 * q + 1], O[4 * q + 2], O[4 * q + 3]}; }
        LDS_WAIT();
    }
    VM_WAIT();
}

__device__ __forceinline__ void p5_phase(const Args& a, int wave, int lane, int vcu, int G) {
    const int gw = vcu * NWAVES + wave, NGW = G * NWAVES;
    const float* OT = (const float*)(a.ws + WS_OT); const bf16_t* Gb = (const bf16_t*)(a.ws + WS_G); const bf16_t* Vb = (const bf16_t*)(a.ws + WS_V);
    const float* BON = (const float*)(a.ws + WS_BON); bf16_t* Y = (bf16_t*)(a.ws + WS_YMIX);
    for (int un = gw; un < NBH * (SEQ / 64); un += NGW) {
        const int bh = un >> 5, tb = un & 31, t = tb * 64 + lane, b = bh >> 3, h = bh & 7;
        const size_t base = (size_t)bh * 64 * SEQ + t;
        const float o0 = OT[base]; float s = 0.f, q = 0.f;
#pragma unroll 16
        for (int nv = 0; nv < 64; ++nv) { const float d = OT[base + (size_t)nv * SEQ] - o0; s += d; q += d * d; }
        const float md = s * (1.f / 64.f), mean = o0 + md;
        const float rstd = 1.0f / sqrtf(fmaxf(q * (1.f / 64.f) - md * md, 0.f) + GN_EPS);
        const float bon = BON[(size_t)bh * SEQ + t];
        bf16_t* yp = Y + ((size_t)b * SEQ + t) * D + 512 + h * 64;
#pragma unroll 1
        for (int g8 = 0; g8 < 8; ++g8) { float y[8];
#pragma unroll
            for (int e = 0; e < 8; ++e) { const int nv = 8 * g8 + e; const float ov = OT[base + (size_t)nv * SEQ], v = bf2f(Vb[base + (size_t)nv * SEQ]), g = bf2f(Gb[base + (size_t)nv * SEQ]);
                y[e] = ((ov - mean) * rstd * a.in[I_LNW][h * 64 + nv] + a.in[I_LNB][h * 64 + nv] + bon * v) * g; }
            u32x4 w; w.x = pk2(y[0], y[1]); w.y = pk2(y[2], y[3]); w.z = pk2(y[4], y[5]); w.w = pk2(y[6], y[7]);
            *(GAS u32x4*)(yp + 8 * g8) = w; }
    }
}

constexpr int RW_LD = 1028;
__device__ __forceinline__ void p7_phase(const Args& a, LAS unsigned char* lds, int tid, int wave, int lane) {
    LAS float* RWT = (LAS float*)lds;
    LAS int* cntL = (LAS int*)(lds + 32 * RW_LD * 4);
    LAS int* baseL = cntL + 32;
    LAS int* rec = baseL + 32;
    const float* mod = (const float*)(a.ws + WS_MOD); bf16_t* U = (bf16_t*)(a.ws + WS_U);
    const float* H = a.out;
    for (int i = tid; i < 32 * 1024 / 4; i += 512) { const f32x4 v = *(const GAS f32x4*)(a.in[I_RW] + 4 * i); const int col = (4 * i) >> 5, ex = (4 * i) & 31;
#pragma unroll
        for (int e = 0; e < 4; ++e) RWT[(ex + e) * RW_LD + col] = v[e]; }
    if (tid < 32) cntL[tid] = 0;
    __syncthreads();
    const int rbase = blockIdx.x * 128 + wave * 16;
    const float rbias = a.in[I_RB][lane >> 1];
    for (int i = 0; i < 16; ++i) {
        const int row = rbase + i, b = row >> 11;
        const GAS f32x4* hr = (const GAS f32x4*)(H + (size_t)row * D) + lane;
        f32x4 v[4]; float s = 0.f;
#pragma unroll
        for (int j = 0; j < 4; ++j) { v[j] = hr[64 * j]; s += (v[j][0] * v[j][0] + v[j][1] * v[j][1]) + (v[j][2] * v[j][2] + v[j][3] * v[j][3]); }
        const float inv = 1.0f / sqrtf(wave_sum(s) * (1.f / D) + NORM_EPS);
        GAS u32x2* o8 = (GAS u32x2*)(U + (size_t)row * D) + lane;
#pragma unroll
        for (int j = 0; j < 4; ++j) { const int col = 4 * lane + 256 * j;
            const f32x4 g = *(const f32x4*)(a.in[I_N2G] + col), sh = *(const f32x4*)(mod + b * 6144 + 3072 + col), sc = *(const f32x4*)(mod + b * 6144 + 4096 + col);
            v[j] = v[j] * inv * g * (sc + 1.0f) + sh;
            u32x2 w; w.x = pk2(v[j][0], v[j][1]); w.y = pk2(v[j][2], v[j][3]); o8[64 * j] = w; }
        float lg[32];
#pragma unroll
        for (int ex = 0; ex < 32; ++ex) { float acc = 0.f;
#pragma unroll
            for (int j = 0; j < 4; ++j) { const f32x4 w = *(const LAS f32x4*)(RWT + ex * RW_LD + 4 * lane + 256 * j); acc += (v[j][0] * w[0] + v[j][1] * w[1]) + (v[j][2] * w[2] + v[j][3] * w[3]); }
            lg[ex] = acc; }
#pragma unroll
        for (int k = 0; k < 16; ++k) { const bool up = (lane & 32) != 0; const float send = up ? lg[k] : lg[k + 16]; const float keep = up ? lg[k + 16] : lg[k]; lg[k] = keep + __shfl_xor(send, 32); }
#pragma unroll
        for (int k = 0; k < 8; ++k) { const bool up = (lane & 16) != 0; const float send = up ? lg[k] : lg[k + 8]; const float keep = up ? lg[k + 8] : lg[k]; lg[k] = keep + __shfl_xor(send, 16); }
#pragma unroll
        for (int k = 0; k < 4; ++k) { const bool up = (lane & 8) != 0; const float send = up ? lg[k] : lg[k + 4]; const float keep = up ? lg[k + 4] : lg[k]; lg[k] = keep + __shfl_xor(send, 8); }
#pragma unroll
        for (int k = 0; k < 2; ++k) { const bool up = (lane & 4) != 0; const float send = up ? lg[k] : lg[k + 2]; const float keep = up ? lg[k + 2] : lg[k]; lg[k] = keep + __shfl_xor(send, 4); }
        { const bool up = (lane & 2) != 0; const float send = up ? lg[0] : lg[1]; const float keep = up ? lg[1] : lg[0]; lg[0] = keep + __shfl_xor(send, 2); }
        float val = lg[0] + __shfl_xor(lg[0], 1) + rbias;
        int ek[4]; float lk[4];
#pragma unroll
        for (int k = 0; k < 4; ++k) { const float m = wave_max(val); const unsigned long long bal = __ballot(val == m); const int fl = (int)__builtin_ctzll(bal);
            ek[k] = fl >> 1; lk[k] = m; if ((lane >> 1) == ek[k]) val = -INFINITY; }
        const float e1 = __expf(lk[1] - lk[0]), e2 = __expf(lk[2] - lk[0]), e3 = __expf(lk[3] - lk[0]); const float rs = 1.0f / (1.0f + e1 + e2 + e3);
        if (lane < 4) { const int e = lane == 0 ? ek[0] : lane == 1 ? ek[1] : lane == 2 ? ek[2] : ek[3];
            const float g = (lane == 0 ? 1.0f : lane == 1 ? e1 : lane == 2 ? e2 : e3) * rs;
            const int pos = atomicAdd((int*)&cntL[e], 1);
            LAS int* r = rec + ((wave * 16 + i) * 4 + lane) * 3; r[0] = e; r[1] = pos; r[2] = __builtin_bit_cast(int, g); }
    }
    __syncthreads();
    if (tid < 32) baseL[tid] = atomicAdd((int*)(a.ws + WS_CTL) + CW_CNT + tid, cntL[tid]);
    __syncthreads();
    { const LAS int* r = rec + tid * 3; const int e = r[0], slot = baseL[e] + r[1]; const int pair = (blockIdx.x * 128 + (tid >> 2)) * 4 + (tid & 3);
      ((int*)(a.ws + WS_LIST))[e * LCAP + slot] = pair; ((int*)(a.ws + WS_GATE))[pair] = r[2]; }
}

__device__ __forceinline__ void p10_phase(const Args& a, int wave, int lane, int vcu, int G) {
    const float* mod = (const float*)(a.ws + WS_MOD); const bf16_t* PAIR = (const bf16_t*)(a.ws + WS_PAIR);
    const int gw = vcu * NWAVES + wave, NGW = G * NWAVES;
    for (int row = gw; row < M; row += NGW) {
        const int b = row >> 11;
        GAS f32x4* hr = (GAS f32x4*)(a.out + (size_t)row * D) + lane;
        const GAS u32x2* pp = (const GAS u32x2*)(PAIR + (size_t)row * 4 * D) + lane;
        f32x4 v[4]; float s = 0.f;
#pragma unroll
        for (int j = 0; j < 4; ++j) { const int col = 4 * lane + 256 * j; v[j] = hr[64 * j];
            f32x4 y = (f32x4){0.f, 0.f, 0.f, 0.f};
#pragma unroll
            for (int k = 0; k < 4; ++k) { const u32x2 w = pp[k * 256 + 64 * j]; y += (f32x4){bflo(w.x), bfhi(w.x), bflo(w.y), bfhi(w.y)}; }
            const f32x4 gt = *(const f32x4*)(mod + b * 6144 + 5120 + col);
            v[j] += gt * y; s += (v[j][0] * v[j][0] + v[j][1] * v[j][1]) + (v[j][2] * v[j][2] + v[j][3] * v[j][3]); }
        const float inv = 1.0f / sqrtf(wave_sum(s) * (1.f / D) + NORM_EPS);
#pragma unroll
        for (int j = 0; j < 4; ++j) { const f32x4 g = *(const f32x4*)(a.in[I_FG] + 4 * lane + 256 * j); hr[64 * j] = v[j] * inv * g; }
    }
}

constexpr int N_PHASES = 11;
__global__ void __launch_bounds__(NWAVES * 64, 2) hymba_fwd(Args a) {
    extern __shared__ __attribute__((aligned(16))) unsigned char lds_raw[];
    LAS unsigned char* lds = (LAS unsigned char*)lds_raw;
    volatile LAS unsigned* MISC = (volatile LAS unsigned*)(lds + LDS_MISC);
    const int tid = threadIdx.x, lane = tid & 63, wave = __builtin_amdgcn_readfirstlane(tid >> 6);
    const int G = gridDim.x; const int bx = blockIdx.x; const int vcu = (G % 8 == 0) ? (bx % 8) * (G / 8) + bx / 8 : bx;
    gu32* ctl = (gu32*)(a.ws + WS_CTL);
    if (tid < 128) MISC[tid] = 0u;
    __syncthreads();
    XcdBarrier bar; bar.bar = (unsigned*)(ctl + CW_BAR); bar.x = 0; bar.st = nullptr;
    if (MK_N_LAUNCHES == 1) bar = xcd_barrier_post((unsigned*)(ctl + CW_BAR), MISC + 8);
    const int lo = a.ph_lo, hi = a.ph_hi;
#ifndef PH_MASK
#define PH_MASK 0x7ff
#endif
#define IN(k) (((PH_MASK >> (k)) & 1) && lo <= (k) && (k) < hi)
#define SEAM(k) do { if (IN(k) && IN((k) + 1)) xcd_barrier(bar); } while (0)
    if (IN(0)) { p0_phase(a, lds, tid, wave, lane, vcu, G); } SEAM(0);
    if (IN(1)) { p1_phase(a, wave, lane, vcu, G); } SEAM(1);
    if (IN(2)) {
        DenseSched S{(const char*)(a.ws + WS_U), (const char*)(a.ws + WS_WIN), M / 256, NIN / 256, G, bx, (size_t)256 * 1024 * 2};
        EpiBf16 E{(bf16_t*)(a.ws + WS_PROJ), NIN};
        pg8::gemm_phase<EpiBf16, DenseSched, false, true>(lds, 1024, S, E);
    } SEAM(2);
    if (IN(3)) { p3_phase(a, lds, tid, wave, lane, vcu, G); } SEAM(3);
    if (IN(4)) { p4_phase(a, lds, wave, lane); } SEAM(4);
    if (IN(5)) { p5_phase(a, wave, lane, vcu, G); } SEAM(5);
    if (IN(6)) {
        DenseSched S{(const char*)(a.ws + WS_YMIX), (const char*)(a.ws + WS_WOUT), M / 256, D / 256, G, bx, (size_t)256 * 1024 * 2};
        EpiResid E{a.in[I_X], a.out, (const float*)(a.ws + WS_MOD)};
        pg8::gemm_phase<EpiResid, DenseSched, false, true>(lds, 1024, S, E);
    } SEAM(6);
    if (IN(7)) { p7_phase(a, lds, tid, wave, lane); } SEAM(7);
    volatile LAS int* bstart = (volatile LAS int*)(lds + LDS_MISC + 128);
    volatile LAS int* ecnt = bstart + 40;
    if (IN(8) || IN(9)) {
        if (tid == 0) { int s = 0; for (int e = 0; e < NE; ++e) { const int c = (int)__hip_atomic_load(ctl + CW_CNT + e, RLX_AGENT); ecnt[e] = c; bstart[e] = s; s += (c + 255) >> 8; } bstart[NE] = s; }
        __syncthreads();
    }
    if (IN(8)) {
        MoeSched S{(const char*)(a.ws + WS_U), (const char*)(a.ws + WS_W1T), (size_t)2048 * 1024 * 2, bstart[NE], 8, G, bx, (size_t)256 * 1024 * 2, bstart, ecnt, (const int*)(a.ws + WS_LIST), 2048, true};
        EpiSwiglu E{(bf16_t*)(a.ws + WS_ACT), a.in[I_B1], &S};
        pg8::gemm_phase<EpiSwiglu, MoeSched, true, true>(lds, 1024, S, E);
    } SEAM(8);
    if (IN(9)) {
        MoeSched S{(const char*)(a.ws + WS_ACT), (const char*)(a.ws + WS_W2T), (size_t)1024 * 1024 * 2, bstart[NE], 4, G, bx, (size_t)256 * 1024 * 2, bstart, ecnt, (const int*)(a.ws + WS_LIST), 2048, false};
        EpiPair E{(bf16_t*)(a.ws + WS_PAIR), a.in[I_B2], (const float*)(a.ws + WS_GATE), &S};
        pg8::gemm_phase<EpiPair, MoeSched, false, true>(lds, 1024, S, E);
    } SEAM(9);
    if (IN(10)) { p10_phase(a, wave, lane, vcu, G); }
#undef IN
#undef SEAM
}

extern "C" void kernel_launch(void* const* d_in, const int* in_sizes, int n_in, void* d_out, int out_size, void* d_ws, size_t ws_size, hipStream_t stream) {
    static int grid = 0;
    if (grid == 0) {
        if (n_in != 28 || in_sizes[0] != M * D || out_size != M * D || ws_size < WS_END) { fprintf(stderr, "kernel_launch: unexpected shapes / workspace (n_in %d, ws %zu)\n", n_in, ws_size); grid = -1; return; }
        int dev = 0, cus = 0;
        if (hipGetDevice(&dev) != hipSuccess || hipDeviceGetAttribute(&cus, hipDeviceAttributeMultiprocessorCount, dev) != hipSuccess) { grid = -1; return; }
        if (hipFuncSetAttribute((const void*)hymba_fwd, hipFuncAttributeMaxDynamicSharedMemorySize, LDS_TOTAL) != hipSuccess) { fprintf(stderr, "kernel_launch: hipFuncSetAttribute failed\n"); grid = -1; return; }
        (void)hipGetLastError();
        grid = cus;
        if (grid != 256) fprintf(stderr, "kernel_launch: %d CUs (built for 256)\n", grid);
    }
    if (grid < 0) return;
    if (hipMemsetAsync((char*)d_ws + WS_CTL, 0, CTL_ZERO_BYTES, stream) != hipSuccess) return;
    Args a{};
    for (int i = 0; i < 28; ++i) a.in[i] = (const float*)d_in[i];
    a.out = (float*)d_out; a.ws = (unsigned char*)d_ws;
#if MK_N_LAUNCHES == 1
    a.ph_lo = 0; a.ph_hi = N_PHASES;
    hipLaunchKernelGGL(hymba_fwd, dim3(grid), dim3(NWAVES * 64), LDS_TOTAL, stream, a);
#else
    for (int p = 0; p < N_PHASES; ++p) { a.ph_lo = p; a.ph_hi = p + 1; hipLaunchKernelGGL(hymba_fwd, dim3(grid), dim3(NWAVES * 64), LDS_TOTAL, stream, a); }
#endif
}
```

```cpp
#include <hip/hip_runtime.h>
#include <cstdio>
#include <cstdint>

#ifndef MK_N_LAUNCHES
#define MK_N_LAUNCHES 1
#endif

#define LAS __attribute__((address_space(3)))
#define GAS __attribute__((address_space(1)))
typedef unsigned short bf16_t;
typedef short bf16x8 __attribute__((ext_vector_type(8)));
typedef float f32x4 __attribute__((ext_vector_type(4)));
typedef float f32x16 __attribute__((ext_vector_type(16)));
typedef float f32x2 __attribute__((ext_vector_type(2)));
typedef unsigned u32x4 __attribute__((ext_vector_type(4)));
typedef unsigned u32x2 __attribute__((ext_vector_type(2)));
typedef GAS unsigned gu32;
#define RLX_AGENT __ATOMIC_RELAXED, __HIP_MEMORY_SCOPE_AGENT
#define LDS_WAIT() asm volatile("s_waitcnt lgkmcnt(0)" ::: "memory")
#define VM_WAIT() asm volatile("s_waitcnt vmcnt(0)" ::: "memory")

constexpr int D = 1024, BATCH = 16, SEQ = 2048, M = BATCH * SEQ;
constexpr int NIN = 3328;
constexpr int COL_B = 0, COL_C = 512, COL_H = 1024, COL_R = 1536, COL_K = 2048, COL_V = 2560, COL_DW = 3072;
constexpr int NE = 32, LCAP = 32768;
constexpr int CL = 32, NCH = SEQ / CL;
constexpr int NBH = BATCH * 8;
constexpr float NORM_EPS = 1e-5f, GN_EPS = 64e-5f;
constexpr int CHB = 27648;
constexpr int CH_PL = 26624;

constexpr size_t MiB = 1u << 20;
constexpr size_t WS_CTL = 0, CTL_ZERO_BYTES = 64 * 1024;
constexpr size_t WS_MOD = 1 * MiB;
constexpr size_t WS_LORA = 2 * MiB;
constexpr size_t WS_WOUT = 3 * MiB;
constexpr size_t WS_WIN = 5 * MiB;
constexpr size_t WS_LIST = 12 * MiB;
constexpr size_t WS_GATE = 16 * MiB;
constexpr size_t WS_W1T = 17 * MiB;
constexpr size_t WS_W2T = 145 * MiB;
constexpr size_t WS_U = 209 * MiB;
constexpr size_t WS_YMIX = 273 * MiB;
constexpr size_t WS_PROJ = 337 * MiB;
constexpr size_t WS_CH = 545 * MiB;
constexpr size_t WS_OT = 761 * MiB;
constexpr size_t WS_G = 825 * MiB;
constexpr size_t WS_V = 857 * MiB;
constexpr size_t WS_BON = 889 * MiB;
constexpr size_t WS_ACT = 337 * MiB;
constexpr size_t WS_PAIR = 609 * MiB;
constexpr size_t WS_END = 890 * MiB;
constexpr int CW_TMO = 0;
constexpr int CW_CNT = 64;
constexpr int CW_BAR = 4096;

constexpr int RING_BYTES = 131072;
constexpr int MISC_OFF = 144 * 1024;
constexpr int LDS_BYTES = 147456;

__device__ __forceinline__ unsigned f2bf(float f) { unsigned u = __builtin_bit_cast(unsigned, f); return (u + 0x7fffu + ((u >> 16) & 1u)) >> 16; }
__device__ __forceinline__ unsigned pk2(float lo, float hi) { return f2bf(lo) | (f2bf(hi) << 16); }
__device__ __forceinline__ float bf2f(unsigned short h) { return __builtin_bit_cast(float, (unsigned)h << 16); }
__device__ __forceinline__ float bflo(unsigned w) { return __builtin_bit_cast(float, w << 16); }
__device__ __forceinline__ float bfhi(unsigned w) { return __builtin_bit_cast(float, w & 0xffff0000u); }
#define DPP_QP1 0xB1
#define DPP_QP2 0x4E
#define DPP_HMIR 0x141
#define DPP_MIR 0x140
#define DPP_BC15 0x142
#define DPP_BC31 0x143
#define dpp_f(old, v, ctrl, rmask) __builtin_bit_cast(float, __builtin_amdgcn_update_dpp(__builtin_bit_cast(int, (float)(old)), __builtin_bit_cast(int, (float)(v)), ctrl, rmask, 0xf, false))
__device__ __forceinline__ float wave_sum(float v) {
    v += dpp_f(0.f, v, DPP_QP1, 0xf); v += dpp_f(0.f, v, DPP_QP2, 0xf); v += dpp_f(0.f, v, DPP_HMIR, 0xf); v += dpp_f(0.f, v, DPP_MIR, 0xf);
    v += dpp_f(0.f, v, DPP_BC15, 0xa); v += dpp_f(0.f, v, DPP_BC31, 0xc);
    return __builtin_bit_cast(float, __builtin_amdgcn_readlane(__builtin_bit_cast(int, v), 63));
}
__device__ __forceinline__ float wave_max(float v) {
    const float ninf = -INFINITY;
    v = fmaxf(v, dpp_f(ninf, v, DPP_QP1, 0xf)); v = fmaxf(v, dpp_f(ninf, v, DPP_QP2, 0xf)); v = fmaxf(v, dpp_f(ninf, v, DPP_HMIR, 0xf)); v = fmaxf(v, dpp_f(ninf, v, DPP_MIR, 0xf));
    v = fmaxf(v, dpp_f(ninf, v, DPP_BC15, 0xa)); v = fmaxf(v, dpp_f(ninf, v, DPP_BC31, 0xc));
    return __builtin_bit_cast(float, __builtin_amdgcn_readlane(__builtin_bit_cast(int, v), 63));
}
__device__ __forceinline__ float fast_sigmoid(float x) { return __builtin_amdgcn_rcpf(1.0f + __expf(-x)); }
__device__ __forceinline__ bf16x8 pack8(float a0, float a1, float a2, float a3, float a4, float a5, float a6, float a7) {
    u32x4 w; w.x = pk2(a0, a1); w.y = pk2(a2, a3); w.z = pk2(a4, a5); w.w = pk2(a6, a7); return __builtin_bit_cast(bf16x8, w);
}

#define XB_TMO      128
#define XB_XCNT(j)  (256  + 64 * (j))
#define XB_XSUB(j)  (1280 + 64 * (j))
#define XB_XGEN(j)  (2304 + 64 * (j))
#define XB_TOP      3328
#define XB_TOPGEN   3392
#define XCD_BAR_WORDS 3456
#define XB_SPIN_CAP (1u << 20)
__device__ __forceinline__ unsigned xb_ld(unsigned* p)              { return __hip_atomic_load(p, __ATOMIC_RELAXED, __HIP_MEMORY_SCOPE_AGENT); }
__device__ __forceinline__ unsigned xb_add(unsigned* p, unsigned v) { return __hip_atomic_fetch_add(p, v, __ATOMIC_RELAXED, __HIP_MEMORY_SCOPE_AGENT); }
__device__ __forceinline__ unsigned xb_xcc_id() { return (unsigned)__builtin_amdgcn_s_getreg((3 << 11) | 20) & 0xFu; }
#define XB_SPIN(cond, bar) do { unsigned _sp = 0; while (cond) { __builtin_amdgcn_s_sleep(1); \
    if ((++_sp & 255u) == 0u) { if (xb_ld(&(bar)[XB_TMO])) break; if (_sp > XB_SPIN_CAP) { atomicAdd(&(bar)[XB_TMO], 1u); break; } } } } while (0)
struct XcdBarrier { unsigned* bar; unsigned x; volatile LAS unsigned* st; };
__device__ __forceinline__ XcdBarrier xcd_barrier_post(unsigned* bar, volatile LAS unsigned* st) {
    XcdBarrier b; b.bar = bar; b.x = xb_xcc_id(); b.st = st;
    if (threadIdx.x == 0) (void)xb_add(&bar[XB_XCNT(b.x)], 1u);
    return b;
}
__device__ __forceinline__ void xcd_barrier_complete(unsigned* bar, unsigned x, unsigned& nloc, unsigned& nx) {
    const unsigned G = gridDim.x * gridDim.y * gridDim.z;
    unsigned sum, cnt, mine, sp = 0u;
    for (;;) {
        sum = 0u; cnt = 0u; mine = 0u;
#pragma unroll
        for (unsigned j = 0; j < 16; ++j) { const unsigned c = xb_ld(&bar[XB_XCNT(j)]); sum += c; cnt += (c > 0u) ? 1u : 0u; mine = (j == x) ? c : mine; }
        if (sum == G) break;
        __builtin_amdgcn_s_sleep(1);
        if ((++sp & 255u) == 0u) { if (xb_ld(&bar[XB_TMO])) break; if (sp > XB_SPIN_CAP) { atomicAdd(&bar[XB_TMO], 1u); break; } }
    }
    nloc = mine > 0u ? mine : 1u; nx = cnt > 0u ? cnt : 1u;
}
__device__ __forceinline__ void xcd_barrier(const XcdBarrier& b) {
    asm volatile("s_waitcnt vmcnt(0)" ::: "memory");
    __syncthreads();
    if (threadIdx.x == 0) {
        unsigned* bar = b.bar;
        __builtin_amdgcn_s_waitcnt(0);
        unsigned nloc = b.st[0], nx = b.st[1];
        if (nloc == 0u) { xcd_barrier_complete(bar, b.x, nloc, nx); b.st[0] = nloc; b.st[1] = nx; }
        const unsigned old = xb_add(&bar[XB_XSUB(b.x)], 1u);
        const unsigned gen = old / nloc;
        if (old + 1u == (gen + 1u) * nloc) {
            __builtin_amdgcn_fence(__ATOMIC_RELEASE, "agent");
            asm volatile("s_waitcnt vmcnt(0)" ::: "memory");
            const unsigned og = xb_add(&bar[XB_TOP], 1u);
            const unsigned tg = og / nx;
            if (og + 1u == (tg + 1u) * nx) xb_add(&bar[XB_TOPGEN], 1u);
            else XB_SPIN(xb_ld(&bar[XB_TOPGEN]) == tg, bar);
            __builtin_amdgcn_fence(__ATOMIC_ACQUIRE, "agent");
            xb_add(&bar[XB_XGEN(b.x)], 1u);
            asm volatile("s_waitcnt vmcnt(0)" ::: "memory");
        } else {
            XB_SPIN(xb_ld(&bar[XB_XGEN(b.x)]) == gen, bar);
            __builtin_amdgcn_fence(__ATOMIC_ACQUIRE, "agent");
            asm volatile("s_waitcnt vmcnt(0)" ::: "memory");
        }
    }
    __syncthreads();
}

namespace pg8 {
constexpr int BM = 256, BK = 64, HALF = 128, HTB = HALF * BK * 2, NXCD = 8, WGM = 8;
__host__ __device__ __forceinline__ int lds_byte(int r, int c) { const int st = (r >> 4) * 2 + (c >> 5), rr = r & 15, cc = c & 31, ob = rr * 64 + cc * 2; return st * 1024 + (ob ^ (((ob >> 9) & 1) << 5)); }
__host__ __device__ __forceinline__ void stage_rc(int b, int& R, int& C) { const int st = b / 1024, sb = b % 1024, swz = sb ^ (((sb >> 9) & 1) << 5); R = (st >> 1) * 16 + swz / 64; C = (st & 1) * 32 + (swz % 64) / 2; }
__host__ __device__ __forceinline__ int perm32(int rho) { const int n = rho >> 4, i = rho & 15; return 8 * (i >> 2) + 4 * n + (i & 3); }
struct Unit { int pm, pn; };
__device__ __forceinline__ bool tile_order(int i, int G, int c, int nM, int nN, Unit& u) {
    const int nwg = nM * nN; const long L = (long)i * G + c; if (L >= nwg) return false;
    int wgid = (int)L; { const int q = nwg / NXCD, r = nwg % NXCD, xcd = wgid % NXCD, off = wgid / NXCD; wgid = (xcd < r ? xcd * (q + 1) : r * (q + 1) + (xcd - r) * q) + off; }
    const int nig = WGM * nN, gid = wgid / nig, fm = gid * WGM, gsz = (nM - fm) < WGM ? (nM - fm) : WGM;
    u.pm = fm + ((wgid % nig) % gsz); u.pn = (wgid % nig) / gsz; return true;
}
__device__ __forceinline__ unsigned cvt_pk_bf16(float lo, float hi) { unsigned r; asm volatile("v_cvt_pk_bf16_f32 %0, %1, %2" : "=v"(r) : "v"(lo), "v"(hi)); return r; }

template <class Epi, class Sched, bool GATHER, bool ALIGN_EPI>
__device__ __forceinline__ void gemm_phase(LAS unsigned char* lds, const int K, const Sched& S, const Epi& E) {
    const int tid = threadIdx.x, wid = __builtin_amdgcn_readfirstlane(tid >> 6), lane = tid & 63, wr = wid >> 2, wc = wid & 3, fr = lane & 15, fq = lane >> 4;
    const int nt = K / BK;
    unsigned voffA[2], voffB[2]; int rowA[2];
#pragma unroll
    for (int i = 0; i < 2; ++i) { int R, C; stage_rc(tid * 16 + i * 8192, R, C); const int Rb = Epi::PERM ? ((R & ~31) + perm32(R & 31)) : R;
        voffA[i] = (unsigned)(R * K + C) * 2u; voffB[i] = (unsigned)(Rb * K + C) * 2u; rowA[i] = R; if (GATHER) voffA[i] = (unsigned)C * 2u; }
    const size_t kstep = (size_t)(BK * 2);
    const size_t hstep = (size_t)HALF * K * 2;
    const unsigned ldsw = (unsigned)wid * 1024u;
    const int aoff = lds_byte(wr * 64 + fr, fq * 8), boff = lds_byte(wc * 32 + fr, fq * 8);
#define PG8_SA(b, h) (((b) * 2 + (h)) * HTB)
#define PG8_SB(b, h) ((4 + (b) * 2 + (h)) * HTB)
#define PG8_STAGE2(bufoff, gbase, o0, o1) do { \
        __builtin_amdgcn_global_load_lds((const unsigned*)((const char*)(gbase) + (o0)), (LAS unsigned*)(lds + (bufoff) + ldsw), 16, 0, 0); \
        __builtin_amdgcn_global_load_lds((const unsigned*)((const char*)(gbase) + (o1)), (LAS unsigned*)(lds + (bufoff) + ldsw + 8192), 16, 0, 0); } while (0)
#define PG8_STAGEB(bufoff, gbase) PG8_STAGE2(bufoff, gbase, voffB[0], voffB[1])
#define PG8_STAGEA(bufoff, kp, hh, OS) do { if (GATHER) PG8_STAGE2(bufoff, kp, OS[hh][0], OS[hh][1]); else PG8_STAGE2(bufoff, (kp) + (hh) * hstep, voffA[0], voffA[1]); } while (0)
#define PG8_LDA(dst, b, h) do { _Pragma("unroll") for (int m = 0; m < 4; ++m) _Pragma("unroll") for (int k = 0; k < 2; ++k) dst[m][k] = *(const LAS bf16x8*)(lds + PG8_SA(b, h) + aoff + m * 2048 + k * 1024); } while (0)
#define PG8_LDB(dst, b, h) do { _Pragma("unroll") for (int n = 0; n < 2; ++n) _Pragma("unroll") for (int k = 0; k < 2; ++k) dst[n][k] = *(const LAS bf16x8*)(lds + PG8_SB(b, h) + boff + n * 2048 + k * 1024); } while (0)
#define PG8_MMA(ai, bj, At, Bt) do { __builtin_amdgcn_s_setprio(1); _Pragma("unroll") for (int m = 0; m < 4; ++m) _Pragma("unroll") for (int n = 0; n < 2; ++n) _Pragma("unroll") for (int k = 0; k < 2; ++k) \
        acc[ai][bj][m][n] = __builtin_amdgcn_mfma_f32_16x16x32_bf16(Bt[n][k], At[m][k], acc[ai][bj][m][n], 0, 0, 0); __builtin_amdgcn_s_setprio(0); } while (0)
#define PG8_WAIT_V(n) asm volatile("s_waitcnt vmcnt(" #n ")" ::: "memory")
#define PG8_WAIT_L(n) asm volatile("s_waitcnt lgkmcnt(" #n ")" ::: "memory")
#define PG8_BAR __builtin_amdgcn_s_barrier()
#define PG8_SCHED __builtin_amdgcn_sched_barrier(0)
    Unit cur, nxt; int ui = 0;
    if (!S.next(0, cur)) return;
    f32x4 acc[2][2][4][2];
#pragma unroll
    for (int a = 0; a < 2; ++a)
#pragma unroll
        for (int b = 0; b < 2; ++b)
#pragma unroll
            for (int m = 0; m < 4; ++m)
#pragma unroll
                for (int n = 0; n < 2; ++n) acc[a][b][m][n] = (f32x4){0.f, 0.f, 0.f, 0.f};
    bf16x8 At[4][2], B0[2][2], B1[2][2];
    unsigned gC[2][2], gN[2][2];
    const char* cA = S.a_base(cur); const char* cB = S.b_base(cur);
    if (GATHER) { S.a_rows(cur, rowA, gC);
#pragma unroll
        for (int h = 0; h < 2; ++h)
#pragma unroll
            for (int i = 0; i < 2; ++i) gC[h][i] += voffA[i]; }
    PG8_STAGEB(PG8_SB(0, 0), cB); PG8_STAGEB(PG8_SB(0, 1), cB + hstep); PG8_STAGEA(PG8_SA(0, 0), cA, 0, gC); PG8_STAGEA(PG8_SA(0, 1), cA, 1, gC);
    if (wr == 1) PG8_BAR;
    PG8_WAIT_V(2); PG8_BAR;
    PG8_STAGEB(PG8_SB(1, 0), cB + kstep); PG8_STAGEA(PG8_SA(1, 0), cA + kstep, 0, gC); PG8_STAGEB(PG8_SB(1, 1), cB + hstep + kstep);
    PG8_WAIT_V(6); PG8_BAR;
    for (;;) {
        const bool has_next = S.next(ui + 1, nxt);
        const char* nA = has_next ? S.a_base(nxt) : cA; const char* nB = has_next ? S.b_base(nxt) : cB;
        if (GATHER) { if (has_next) { S.a_rows(nxt, rowA, gN);
#pragma unroll
                for (int h = 0; h < 2; ++h)
#pragma unroll
                    for (int i = 0; i < 2; ++i) gN[h][i] += voffA[i]; }
            else {
#pragma unroll
                for (int h = 0; h < 2; ++h)
#pragma unroll
                    for (int i = 0; i < 2; ++i) gN[h][i] = gC[h][i]; } }
        for (int t = 0; t < nt; t += 2) {
            const bool last = (t == nt - 2);
            const char* a1 = cA + (size_t)(t + 1) * kstep;
            const char* a2 = last ? nA : cA + (size_t)(t + 2) * kstep; const char* b2 = last ? nB : cB + (size_t)(t + 2) * kstep;
            const char* a3 = a2 + kstep; const char* b3 = b2 + kstep;
            unsigned g2[2][2];
            if (GATHER) {
#pragma unroll
                for (int h = 0; h < 2; ++h)
#pragma unroll
                    for (int i = 0; i < 2; ++i) g2[h][i] = last ? gN[h][i] : gC[h][i]; }
            PG8_LDB(B0, 0, 0); PG8_LDB(B1, 0, 1); PG8_SCHED; PG8_LDA(At, 0, 0); PG8_STAGEA(PG8_SA(1, 1), a1, 1, gC);
            PG8_WAIT_V(8); PG8_WAIT_L(0); PG8_BAR; PG8_MMA(0, 0, At, B0); PG8_MMA(0, 1, At, B1); PG8_BAR; PG8_SCHED;
            PG8_LDA(At, 0, 1); PG8_STAGEB(PG8_SB(0, 0), b2); PG8_STAGEB(PG8_SB(0, 1), b2 + hstep); PG8_STAGEA(PG8_SA(0, 0), a2, 0, g2);
            PG8_WAIT_V(8); PG8_WAIT_L(0); PG8_BAR; PG8_MMA(1, 0, At, B0); PG8_MMA(1, 1, At, B1); PG8_BAR; PG8_SCHED;
            PG8_LDB(B0, 1, 0); PG8_LDB(B1, 1, 1); PG8_SCHED; PG8_LDA(At, 1, 0); PG8_STAGEA(PG8_SA(0, 1), a2, 1, g2);
            PG8_WAIT_V(8); PG8_WAIT_L(0); PG8_BAR; PG8_MMA(0, 0, At, B0); PG8_MMA(0, 1, At, B1); PG8_BAR; PG8_SCHED;
            PG8_LDA(At, 1, 1); PG8_STAGEB(PG8_SB(1, 0), b3); PG8_STAGEB(PG8_SB(1, 1), b3 + hstep); PG8_STAGEA(PG8_SA(1, 0), a3, 0, g2);
            PG8_WAIT_V(8); PG8_WAIT_L(0); PG8_BAR; PG8_MMA(1, 0, At, B0); PG8_MMA(1, 1, At, B1); PG8_BAR; PG8_SCHED;
        }
        if constexpr (ALIGN_EPI) { if (wr == 0) PG8_BAR; }
        E(acc, cur, wr, wc, fr, fq);
        if (!has_next) break;
#pragma unroll
        for (int a = 0; a < 2; ++a)
#pragma unroll
            for (int b = 0; b < 2; ++b)
#pragma unroll
                for (int m = 0; m < 4; ++m)
#pragma unroll
                    for (int n = 0; n < 2; ++n) acc[a][b][m][n] = (f32x4){0.f, 0.f, 0.f, 0.f};
        cur = nxt; cA = nA; cB = nB; ++ui;
        if (GATHER) {
#pragma unroll
            for (int h = 0; h < 2; ++h)
#pragma unroll
                for (int i = 0; i < 2; ++i) gC[h][i] = gN[h][i]; }
        if constexpr (ALIGN_EPI) { if (wr == 1) PG8_BAR; }
    }
    PG8_WAIT_V(0);
    if constexpr (!ALIGN_EPI) { if (wr == 0) PG8_BAR; }
    PG8_BAR;
#undef PG8_SA
#undef PG8_SB
#undef PG8_STAGE2
#undef PG8_STAGEA
#undef PG8_STAGEB
#undef PG8_LDA
#undef PG8_LDB
#undef PG8_MMA
#undef PG8_WAIT_V
#undef PG8_WAIT_L
#undef PG8_BAR
#undef PG8_SCHED
}
}
using pg8::Unit;

struct DenseSched {
    const char* A; const char* Bt; int nM, nN, G, c; size_t tstep;
    __device__ __forceinline__ bool next(int i, Unit& u) const { return pg8::tile_order(i, G, c, nM, nN, u); }
    __device__ __forceinline__ const char* a_base(const Unit& u) const { return A + (size_t)u.pm * tstep; }
    __device__ __forceinline__ const char* b_base(const Unit& u) const { return Bt + (size_t)u.pn * tstep; }
    __device__ __forceinline__ void a_rows(const Unit&, const int (&)[2], unsigned (&)[2][2]) const {}
};
struct MoeSched {
    const char* A; const char* Wt; size_t estride; int nM, nN, G, c; size_t tstep;
    const volatile LAS int* bstart; const volatile LAS int* cnt; const int* list; int K2; bool gather;
    const volatile LAS unsigned char* blk_e;
    __device__ __forceinline__ int expert_of(int pm) const { return (int)blk_e[pm]; }
    __device__ __forceinline__ bool next(int i, Unit& u) const { return pg8::tile_order(i, G, c, nM, nN, u); }
    __device__ __forceinline__ const char* a_base(const Unit& u) const { return gather ? A : A + (size_t)u.pm * tstep; }
    __device__ __forceinline__ const char* b_base(const Unit& u) const { const int e = expert_of(u.pm); return Wt + (size_t)e * estride + (size_t)u.pn * tstep; }
    __device__ __forceinline__ void a_rows(const Unit& u, const int (&rowA)[2], unsigned (&o)[2][2]) const {
        const int e = expert_of(u.pm), rb = u.pm - bstart[e], n = cnt[e];
#pragma unroll
        for (int h = 0; h < 2; ++h)
#pragma unroll
            for (int i = 0; i < 2; ++i) { const int idx = rb * 256 + h * 128 + rowA[i]; int tok = 0; if (idx < n) tok = list[e * LCAP + idx] >> 2; o[h][i] = (unsigned)tok * (unsigned)K2; }
    }
};

struct EpiBf16 {
    static constexpr bool PERM = true;
    bf16_t* O; int ldc;
    __device__ __forceinline__ void operator()(const f32x4 (&acc)[2][2][4][2], const Unit& u, int wr, int wc, int fr, int fq) const {
        const int row0 = u.pm * 256 + wr * 64 + fr, col0 = u.pn * 256 + wc * 32 + 8 * fq;
#pragma unroll
        for (int ai = 0; ai < 2; ++ai)
#pragma unroll
            for (int m = 0; m < 4; ++m) { bf16_t* rowp = O + (size_t)(row0 + ai * 128 + m * 16) * ldc + col0;
#pragma unroll
                for (int bj = 0; bj < 2; ++bj) { const f32x4 v0 = acc[ai][bj][m][0], v1 = acc[ai][bj][m][1];
                    u32x4 w; w.x = pg8::cvt_pk_bf16(v0[0], v0[1]); w.y = pg8::cvt_pk_bf16(v0[2], v0[3]); w.z = pg8::cvt_pk_bf16(v1[0], v1[1]); w.w = pg8::cvt_pk_bf16(v1[2], v1[3]);
                    *(u32x4*)(rowp + bj * 128) = w; } }
    }
};
struct EpiResid {
    static constexpr bool PERM = false;
    const float* X; float* H; const float* mod;
    __device__ __forceinline__ void operator()(const f32x4 (&acc)[2][2][4][2], const Unit& u, int wr, int wc, int fr, int fq) const {
        const int b = (u.pm * 256) >> 11; const int col0 = u.pn * 256 + wc * 32 + 4 * fq;
        f32x4 gt[2][2];
#pragma unroll
        for (int bj = 0; bj < 2; ++bj)
#pragma unroll
            for (int n = 0; n < 2; ++n) gt[bj][n] = *(const f32x4*)(mod + b * 6144 + 2048 + col0 + bj * 128 + n * 16);
#pragma unroll
        for (int ai = 0; ai < 2; ++ai)
#pragma unroll
            for (int m = 0; m < 4; ++m) { const size_t off = (size_t)(u.pm * 256 + ai * 128 + wr * 64 + m * 16 + fr) * D + col0;
#pragma unroll
                for (int bj = 0; bj < 2; ++bj)
#pragma unroll
                    for (int n = 0; n < 2; ++n) { const f32x4 xv = *(const f32x4*)(X + off + bj * 128 + n * 16); *(f32x4*)(H + off + bj * 128 + n * 16) = xv + gt[bj][n] * acc[ai][bj][m][n]; } }
    }
};
struct EpiSwiglu {
    static constexpr bool PERM = true;
    bf16_t* ACT; const float* b1; const MoeSched* S;
    __device__ __forceinline__ void operator()(const f32x4 (&acc)[2][2][4][2], const Unit& u, int wr, int wc, int fr, int fq) const {
        const int e = S->expert_of(u.pm);
        const int row0 = u.pm * 256 + wr * 64 + fr, col0 = u.pn * 256 + wc * 32 + 8 * fq;
        f32x4 bv[2][2];
#pragma unroll
        for (int bj = 0; bj < 2; ++bj)
#pragma unroll
            for (int n = 0; n < 2; ++n) bv[bj][n] = *(const f32x4*)(b1 + (size_t)e * 2048 + col0 + bj * 128 + 4 * n);
#pragma unroll
        for (int ai = 0; ai < 2; ++ai)
#pragma unroll
            for (int m = 0; m < 4; ++m) { bf16_t* rowp = ACT + (size_t)(row0 + ai * 128 + m * 16) * 1024 + (col0 >> 1);
#pragma unroll
                for (int bj = 0; bj < 2; ++bj) { float a[4];
#pragma unroll
                    for (int n = 0; n < 2; ++n) { const f32x4 v = acc[ai][bj][m][n] + bv[bj][n];
#pragma unroll
                        for (int p = 0; p < 2; ++p) { const float g = fminf(v[2 * p], 7.0f), l = fminf(fmaxf(v[2 * p + 1], -7.0f), 7.0f);
                            a[2 * n + p] = g * fast_sigmoid(1.702f * g) * (l + 1.0f); } }
                    u32x2 w; w.x = pg8::cvt_pk_bf16(a[0], a[1]); w.y = pg8::cvt_pk_bf16(a[2], a[3]);
                    *(u32x2*)(rowp + bj * 64) = w; } }
    }
};
struct EpiPair {
    static constexpr bool PERM = true;
    bf16_t* PAIR; const float* b2; const float* gate; const MoeSched* S;
    __device__ __forceinline__ void operator()(const f32x4 (&acc)[2][2][4][2], const Unit& u, int wr, int wc, int fr, int fq) const {
        const int e = S->expert_of(u.pm), rb = u.pm - S->bstart[e], n_e = S->cnt[e];
        const int col0 = u.pn * 256 + wc * 32 + 8 * fq;
        f32x4 bv[2][2];
#pragma unroll
        for (int bj = 0; bj < 2; ++bj)
#pragma unroll
            for (int n = 0; n < 2; ++n) bv[bj][n] = *(const f32x4*)(b2 + (size_t)e * 1024 + col0 + bj * 128 + 4 * n);
#pragma unroll
        for (int ai = 0; ai < 2; ++ai)
#pragma unroll
            for (int m = 0; m < 4; ++m) { const int idx = rb * 256 + ai * 128 + wr * 64 + m * 16 + fr;
                if (idx < n_e) { const int pair = S->list[e * LCAP + idx]; const float g = gate[pair]; bf16_t* rowp = PAIR + (size_t)pair * 1024 + col0;
#pragma unroll
                    for (int bj = 0; bj < 2; ++bj) { const f32x4 v0 = (acc[ai][bj][m][0] + bv[bj][0]) * g, v1 = (acc[ai][bj][m][1] + bv[bj][1]) * g;
                        u32x4 w; w.x = pg8::cvt_pk_bf16(v0[0], v0[1]); w.y = pg8::cvt_pk_bf16(v0[2], v0[3]); w.z = pg8::cvt_pk_bf16(v1[0], v1[1]); w.w = pg8::cvt_pk_bf16(v1[2], v1[3]);
                        *(u32x4*)(rowp + bj * 128) = w; } } }
    }
};

struct Args { const float* in[28]; float* out; unsigned char* ws; int ph_lo, ph_hi; };
enum { I_X = 0, I_C, I_ADAW, I_ADAB, I_N1G, I_WIN, I_CONVW, I_CONVGN, I_MU, I_W0, I_WUP, I_A0, I_AUP, I_GUP, I_KK, I_KA, I_RK, I_LNW, I_LNB, I_WOUT, I_N2G, I_RW, I_RB, I_W1, I_B1, I_W2, I_B2, I_FG };
constexpr int NWAVES = 8;
constexpr int LDS_TOTAL = 163840;
constexpr int LDS_MISC = LDS_TOTAL - 512;

__device__ __forceinline__ void p0_mod_unit(const Args& a, int u, LAS unsigned char* lds, int tid) {
    LAS float* cact = (LAS float*)lds; LAS float* red = (LAS float*)(lds + 65536);
    const float* c = a.in[I_C];
    for (int i = tid; i < 16 * 1024; i += 512) { const float v = c[i]; cact[i] = v * fast_sigmoid(v); }
    __syncthreads();
    const int kq = tid >> 5, col = tid & 31;
    float acc[16];
#pragma unroll
    for (int b = 0; b < 16; ++b) acc[b] = 0.f;
    const float* w = a.in[I_ADAW] + (size_t)(kq * 64) * 6144 + u * 32 + col;
#pragma unroll 4
    for (int k = 0; k < 64; ++k) { const float wv = w[(size_t)k * 6144];
#pragma unroll
        for (int b = 0; b < 16; ++b) acc[b] += cact[b * 1024 + kq * 64 + k] * wv; }
#pragma unroll
    for (int b = 0; b < 16; ++b) red[(kq * 16 + b) * 32 + col] = acc[b];
    __syncthreads();
    { const int b = tid >> 5; float s = a.in[I_ADAB][u * 32 + col];
#pragma unroll
      for (int q = 0; q < 16; ++q) s += red[(q * 16 + b) * 32 + col];
      ((float*)(a.ws + WS_MOD))[b * 6144 + u * 32 + col] = s; }
    __syncthreads();
}
__device__ __forceinline__ void tr_item64(const float* W, int ldw, bf16_t* WT, int ldt, int k0, int n0, LAS float* scr, int lane) {
    const int kr = lane >> 4, c4 = lane & 15;
    f32x4 v[16];
#pragma unroll
    for (int i = 0; i < 16; ++i) v[i] = *(const GAS f32x4*)(W + (size_t)(k0 + 4 * i + kr) * ldw + n0 + 4 * c4);
#pragma unroll
    for (int i = 0; i < 16; ++i) { LAS float* s = scr + (4 * i + kr) * 65 + 4 * c4; s[0] = v[i][0]; s[1] = v[i][1]; s[2] = v[i][2]; s[3] = v[i][3]; }
    LDS_WAIT(); asm volatile("" ::: "memory");
    const int c = lane & 7;
#pragma unroll
    for (int j = 0; j < 8; ++j) { const int n = (lane >> 3) + 8 * j; const LAS float* s = scr + (8 * c) * 65 + n;
        u32x4 o; o.x = pk2(s[0], s[65]); o.y = pk2(s[130], s[195]); o.z = pk2(s[260], s[325]); o.w = pk2(s[390], s[455]);
        *(GAS u32x4*)(WT + (size_t)(n0 + n) * ldt + k0 + 8 * c) = o; }
    LDS_WAIT(); asm volatile("" ::: "memory");
}
__device__ __forceinline__ void tr_matrix_item(const float* W, int K, int N, bf16_t* WT, int item, LAS float* scr, int lane) {
    const int nb = N / 64; tr_item64(W, N, WT, K, (item / nb) * 64, (item % nb) * 64, scr, lane);
}
constexpr int TI_WIN = 16 * 52, TI_WOUT = 16 * 16, TI_UP = 8, TI_GUP = 16, TI_SMALL = TI_WIN + TI_WOUT + 2 * TI_UP + TI_GUP;
constexpr int TI_W1 = 16 * 32, TI_W2 = 16 * 16, TI_TOTAL = TI_SMALL + NE * (TI_W1 + TI_W2);
__device__ __forceinline__ void p0_phase(const Args& a, LAS unsigned char* lds, int tid, int wave, int lane, int vcu, int G) {
    if (blockIdx.x < 192) p0_mod_unit(a, blockIdx.x, lds, tid);
    LAS float* scr = (LAS float*)(lds + wave * 16640);
    unsigned char* ws = a.ws;
    bf16_t* lora = (bf16_t*)(ws + WS_LORA);
    const int gw = vcu * NWAVES + wave, NGW = G * NWAVES;
    for (int it = gw; it < TI_SMALL; it += NGW) {
        int r = it;
        if (r < TI_WIN) { tr_matrix_item(a.in[I_WIN], 1024, NIN, (bf16_t*)(ws + WS_WIN), r, scr, lane); continue; } r -= TI_WIN;
        if (r < TI_WOUT) { tr_matrix_item(a.in[I_WOUT], 1024, 1024, (bf16_t*)(ws + WS_WOUT), r, scr, lane); continue; } r -= TI_WOUT;
        if (r < TI_UP) { tr_matrix_item(a.in[I_WUP], 64, 512, lora, r, scr, lane); continue; } r -= TI_UP;
        if (r < TI_UP) { tr_matrix_item(a.in[I_AUP], 64, 512, lora + 512 * 64, r, scr, lane); continue; } r -= TI_UP;
        tr_matrix_item(a.in[I_GUP], 128, 512, lora + 2 * 512 * 64, r, scr, lane);
    }
}
__device__ __forceinline__ void expert_transposes(const Args& a, LAS float* scr, int gw, int NGW, int lane) {
    unsigned char* ws = a.ws;
    for (int r = gw; r < NE * (TI_W1 + TI_W2); r += NGW) {
        if (r < NE * TI_W1) { const int e = r / TI_W1; tr_matrix_item(a.in[I_W1] + (size_t)e * 1024 * 2048, 1024, 2048, (bf16_t*)(ws + WS_W1T) + (size_t)e * 2048 * 1024, r % TI_W1, scr, lane); }
        else { const int q = r - NE * TI_W1; const int e = q / TI_W2; tr_matrix_item(a.in[I_W2] + (size_t)e * 1024 * 1024, 1024, 1024, (bf16_t*)(ws + WS_W2T) + (size_t)e * 1024 * 1024, q % TI_W2, scr, lane); }
    }
}

__device__ __forceinline__ void p1_phase(const Args& a, int wave, int lane, int vcu, int G) {
    const float* mod = (const float*)(a.ws + WS_MOD); bf16_t* U = (bf16_t*)(a.ws + WS_U);
    const int gw = vcu * NWAVES + wave, NGW = G * NWAVES;
    for (int row = gw; row < M; row += NGW) {
        const int b = row >> 11;
        const GAS f32x4* xr = (const GAS f32x4*)(a.in[I_X] + (size_t)row * D) + lane;
        f32x4 v[4]; float s = 0.f;
#pragma unroll
        for (int j = 0; j < 4; ++j) { v[j] = xr[64 * j]; s += (v[j][0] * v[j][0] + v[j][1] * v[j][1]) + (v[j][2] * v[j][2] + v[j][3] * v[j][3]); }
        const float inv = 1.0f / sqrtf(wave_sum(s) * (1.f / D) + NORM_EPS);
        GAS u32x2* o8 = (GAS u32x2*)(U + (size_t)row * D) + lane;
#pragma unroll
        for (int j = 0; j < 4; ++j) { const int col = 4 * lane + 256 * j;
            const f32x4 g = *(const f32x4*)(a.in[I_N1G] + col), sh = *(const f32x4*)(mod + b * 6144 + col), sc = *(const f32x4*)(mod + b * 6144 + 1024 + col);
            const f32x4 y = v[j] * inv * g * (sc + 1.0f) + sh;
            u32x2 w; w.x = pk2(y[0], y[1]); w.y = pk2(y[2], y[3]); o8[64 * j] = w; }
    }
}

__device__ __forceinline__ void p3_conv(const Args& a, int wave, int lane, int vcu, int G) {
    const bf16_t* P = (const bf16_t*)(a.ws + WS_PROJ); bf16_t* Y = (bf16_t*)(a.ws + WS_YMIX);
    const int gw = vcu * NWAVES + wave, NGW = G * NWAVES;
    const int c0 = 8 * lane;
    float w0[8], w1[8], w2[8], gn[8];
#pragma unroll
    for (int e = 0; e < 8; ++e) { w0[e] = a.in[I_CONVW][c0 + e]; w1[e] = a.in[I_CONVW][512 + c0 + e]; w2[e] = a.in[I_CONVW][1024 + c0 + e]; gn[e] = a.in[I_CONVGN][c0 + e]; }
    for (int row = gw; row < M; row += NGW) {
        const int t = row & (SEQ - 1);
        const bf16_t* pr = P + (size_t)row * NIN + c0;
        const u32x4 bg = *(const GAS u32x4*)(pr + COL_B), cg = *(const GAS u32x4*)(pr + COL_C), hg = *(const GAS u32x4*)(pr + COL_H);
        u32x4 c1 = (u32x4){0u, 0u, 0u, 0u}, h1 = c1, c2 = c1, h2 = c1;
        if (t >= 1) { c1 = *(const GAS u32x4*)(pr - NIN + COL_C); h1 = *(const GAS u32x4*)(pr - NIN + COL_H); }
        if (t >= 2) { c2 = *(const GAS u32x4*)(pr - 2 * NIN + COL_C); h2 = *(const GAS u32x4*)(pr - 2 * NIN + COL_H); }
        float y[8]; float ss = 0.f;
#pragma unroll
        for (int q = 0; q < 4; ++q) {
            const float u0l = bflo(cg[q]) * bflo(hg[q]), u0h = bfhi(cg[q]) * bfhi(hg[q]);
            const float u1l = bflo(c1[q]) * bflo(h1[q]), u1h = bfhi(c1[q]) * bfhi(h1[q]);
            const float u2l = bflo(c2[q]) * bflo(h2[q]), u2h = bfhi(c2[q]) * bfhi(h2[q]);
            const float yl = (w0[2 * q] * u2l + w1[2 * q] * u1l + w2[2 * q] * u0l) * bflo(bg[q]);
            const float yh = (w0[2 * q + 1] * u2h + w1[2 * q + 1] * u1h + w2[2 * q + 1] * u0h) * bfhi(bg[q]);
            y[2 * q] = yl; y[2 * q + 1] = yh; ss += yl * yl + yh * yh; }
        ss += __shfl_xor(ss, 1); ss += __shfl_xor(ss, 2); ss += __shfl_xor(ss, 4);
        const float rs = 1.0f / sqrtf(ss * (1.f / 64.f) + NORM_EPS);
        u32x4 o; o.x = pk2(y[0] * rs * gn[0], y[1] * rs * gn[1]); o.y = pk2(y[2] * rs * gn[2], y[3] * rs * gn[3]); o.z = pk2(y[4] * rs * gn[4], y[5] * rs * gn[5]); o.w = pk2(y[6] * rs * gn[6], y[7] * rs * gn[7]);
        *(GAS u32x4*)(Y + (size_t)row * D + c0) = o;
    }
}

__device__ __forceinline__ f32x16 zero16() { f32x16 z;
#pragma unroll
    for (int i = 0; i < 16; ++i) z[i] = 0.f; return z; }
__device__ __forceinline__ int tile_off(int t, int c) { return t * 128 + ((((c >> 3) ^ (t & 7))) << 4) + (c & 7) * 2; }
template <int KC> __device__ __forceinline__ void lora_mm(const LAS unsigned char* codes, int code_off, const bf16_t* WT, int h, int r32, int h2, f32x16 (&acc)[2]) {
    acc[0] = zero16(); acc[1] = zero16();
#pragma unroll
    for (int ks = 0; ks < KC / 16; ++ks) {
        const bf16x8 A = *(const LAS bf16x8*)(codes + r32 * 528 + (code_off + 16 * ks + 8 * h2) * 2);
#pragma unroll
        for (int ct = 0; ct < 2; ++ct) { const bf16x8 B = *(const GAS bf16x8*)(WT + (size_t)(h * 64 + 32 * ct + r32) * KC + 16 * ks + 8 * h2);
            acc[ct] = __builtin_amdgcn_mfma_f32_32x32x16_bf16(A, B, acc[ct], 0, 0, 0); }
    }
}
__device__ __forceinline__ void acc_to_cols(const f32x16 (&acc)[2], LAS float* SC, int lane, int r32, int h2, float (&x)[32]) {
#pragma unroll
    for (int ct = 0; ct < 2; ++ct)
#pragma unroll
        for (int q = 0; q < 4; ++q) *(LAS f32x4*)(SC + (32 * ct + r32) * 36 + 8 * q + 4 * h2) = (f32x4){acc[ct][4 * q], acc[ct][4 * q + 1], acc[ct][4 * q + 2], acc[ct][4 * q + 3]};
    LDS_WAIT(); asm volatile("" ::: "memory");
#pragma unroll
    for (int q = 0; q < 8; ++q) { const f32x4 v = *(const LAS f32x4*)(SC + lane * 36 + 4 * q); x[4 * q] = v[0]; x[4 * q + 1] = v[1]; x[4 * q + 2] = v[2]; x[4 * q + 3] = v[3]; }
    LDS_WAIT(); asm volatile("" ::: "memory");
}
__device__ __forceinline__ void st_frag(unsigned char* blk, int f, int lanepos, u32x4 v) { *(GAS u32x4*)(blk + f * 1024 + lanepos * 16) = v; }
__device__ __forceinline__ u32x4 tile_frag_pi(const LAS unsigned char* T, int t, int ks, int h2) {
    const u32x2 lo = *(const LAS u32x2*)(T + t * 128 + (((2 * ks) ^ (t & 7)) << 4) + 8 * h2);
    const u32x2 hi = *(const LAS u32x2*)(T + t * 128 + (((2 * ks + 1) ^ (t & 7)) << 4) + 8 * h2);
    return (u32x4){lo.x, lo.y, hi.x, hi.y};
}

__device__ __forceinline__ void p3_rwkv_group(const Args& a, int grp, LAS unsigned char* lds, int tid, int wave, int lane) {
    const int b = grp >> 6, ch = grp & 63, t0 = ch * CL; const size_t row0 = (size_t)b * SEQ + t0;
    const bf16_t* P = (const bf16_t*)(a.ws + WS_PROJ);
    LAS unsigned char* codes = lds + 131072;
    {
        const int t = tid >> 4, j0 = (tid & 15) * 16;
        const bf16_t* cur = P + (row0 + t) * NIN + COL_DW + j0;
        const u32x4 c0 = *(const GAS u32x4*)cur, c1 = *(const GAS u32x4*)(cur + 8);
        u32x4 p0 = (u32x4){0u, 0u, 0u, 0u}, p1 = p0;
        if (t0 + t > 0) { p0 = *(const GAS u32x4*)(cur - NIN); p1 = *(const GAS u32x4*)(cur - NIN + 8); }
        const float* mu = a.in[I_MU] + 1536 + j0;
        float o[16];
#pragma unroll
        for (int q = 0; q < 8; ++q) { const unsigned cw = q < 4 ? c0[q] : c1[q - 4], pw = q < 4 ? p0[q] : p1[q - 4];
            const float cl = bflo(cw), chh = bfhi(cw), pl = bflo(pw), ph = bfhi(pw);
            o[2 * q] = cl + (pl - cl) * mu[2 * q]; o[2 * q + 1] = chh + (ph - chh) * mu[2 * q + 1]; }
        if (j0 < 64) {
#pragma unroll
            for (int e = 0; e < 16; ++e) o[e] = 1.0f - 2.0f * __builtin_amdgcn_rcpf(1.0f + __expf(2.0f * o[e]));
        } else if (j0 >= 128) {
#pragma unroll
            for (int e = 0; e < 16; ++e) o[e] = fast_sigmoid(o[e]);
        }
        u32x4 w0, w1; w0.x = pk2(o[0], o[1]); w0.y = pk2(o[2], o[3]); w0.z = pk2(o[4], o[5]); w0.w = pk2(o[6], o[7]);
        w1.x = pk2(o[8], o[9]); w1.y = pk2(o[10], o[11]); w1.z = pk2(o[12], o[13]); w1.w = pk2(o[14], o[15]);
        *(LAS u32x4*)(codes + t * 528 + j0 * 2) = w0; *(LAS u32x4*)(codes + t * 528 + j0 * 2 + 16) = w1;
    }
    __syncthreads();
    const int h = wave, bh = b * 8 + h, hc = h * 64 + lane, r32 = lane & 31, h2 = lane >> 5;
    LAS unsigned char* wl = lds + wave * 16384;
    LAS float* SC = (LAS float*)wl;
    LAS unsigned char* T_A = wl, *T_B = wl + 4096, *T_K = wl + 8192, *T_R = wl + 12288;
    unsigned char* blk = a.ws + WS_CH + ((size_t)bh * NCH + ch) * CHB;
    const bf16_t* lora = (const bf16_t*)(a.ws + WS_LORA);
    f32x16 acc[2]; float x[32];
    const bf16_t* pr = P + row0 * NIN + COL_R + hc;
    unsigned short rr[8], rk_[8], rv[8];
#pragma unroll
    for (int i = 0; i < 8; ++i) { const bf16_t* p = pr + (size_t)i * NIN; rr[i] = p[0]; rk_[i] = p[512]; rv[i] = p[1024]; }
    lora_mm<128>(codes, 128, lora + 2 * 512 * 64, h, r32, h2, acc); acc_to_cols(acc, SC, lane, r32, h2, x);
    { bf16_t* Gp = (bf16_t*)(a.ws + WS_G) + ((size_t)bh * 64 + lane) * SEQ + t0;
#pragma unroll
      for (int q = 0; q < 4; ++q) { u32x4 w; w.x = pk2(x[8 * q], x[8 * q + 1]); w.y = pk2(x[8 * q + 2], x[8 * q + 3]); w.z = pk2(x[8 * q + 4], x[8 * q + 5]); w.w = pk2(x[8 * q + 6], x[8 * q + 7]); *(GAS u32x4*)(Gp + 8 * q) = w; } }
    float cum[32];
    lora_mm<64>(codes, 0, lora, h, r32, h2, acc); acc_to_cols(acc, SC, lane, r32, h2, x);
    { const float w0c = a.in[I_W0][hc]; float run = 0.f;
#pragma unroll
      for (int t = 0; t < 32; ++t) { run -= 0.6065306597f * fast_sigmoid(w0c + x[t]); cum[t] = run; } }
    lora_mm<64>(codes, 64, lora + 512 * 64, h, r32, h2, acc); acc_to_cols(acc, SC, lane, r32, h2, x);
    { const float a0c = a.in[I_A0][hc];
#pragma unroll
      for (int t = 0; t < 32; ++t) x[t] = fast_sigmoid(a0c + x[t]); }
    const float mur = a.in[I_MU][hc], muk = a.in[I_MU][512 + hc], muv = a.in[I_MU][1024 + hc];
    const float kkc = a.in[I_KK][hc], kac = a.in[I_KA][hc], rkc = a.in[I_RK][hc];
    float pr_r = 0.f, pr_k = 0.f, pr_v = 0.f;
    if (t0 > 0) { pr_r = bf2f(pr[-NIN]); pr_k = bf2f(pr[-NIN + 512]); pr_v = bf2f(pr[-NIN + 1024]); }
    unsigned vv2[16]; float bon = 0.f; float e_prev = 1.0f;
#pragma unroll
    for (int bi = 0; bi < 4; ++bi) {
        unsigned short nr[8], nk[8], nv[8];
        if (bi < 3) {
#pragma unroll
            for (int i = 0; i < 8; ++i) { const bf16_t* p = pr + (size_t)(8 * (bi + 1) + i) * NIN; nr[i] = p[0]; nk[i] = p[512]; nv[i] = p[1024]; }
        }
        asm volatile("" ::: "memory");
        float vprev = 0.f;
#pragma unroll
        for (int i = 0; i < 8; ++i) { const int t = 8 * bi + i;
            const float cr = bf2f(rr[i]), ck = bf2f(rk_[i]), cv = bf2f(rv[i]);
            const float r = cr + (pr_r - cr) * mur, k = ck + (pr_k - ck) * muk, v = cv + (pr_v - cv) * muv;
            pr_r = cr; pr_k = ck; pr_v = cv;
            const float kkr = k * kkc; const float nsq = wave_sum(kkr * kkr);
            const float kkn = kkr * __builtin_amdgcn_rsqf(fmaxf(nsq, 1e-24f));
            const float at = x[t];
            const float kp = k * (1.0f + (at - 1.0f) * kac);
            const float bs = wave_sum(r * kp * rkc);
            bon = (lane == t) ? bs : bon;
            const float e_cur = __expf(cum[t]), e_neg = __builtin_amdgcn_rcpf(e_cur);
            const float Ah = -kkn * e_prev, Bv = kkn * at * e_neg, Kv = kp * e_neg, Rh = r * e_cur;
            e_prev = e_cur;
            if (i & 1) vv2[t >> 1] = pk2(vprev, v); else vprev = v;
            const int to = tile_off(t, lane);
            *(LAS unsigned short*)(T_A + to) = (unsigned short)f2bf(Ah); *(LAS unsigned short*)(T_B + to) = (unsigned short)f2bf(Bv);
            *(LAS unsigned short*)(T_K + to) = (unsigned short)f2bf(Kv); *(LAS unsigned short*)(T_R + to) = (unsigned short)f2bf(Rh);
        }
        asm volatile("" ::: "memory");
        if (bi < 3) {
#pragma unroll
            for (int i = 0; i < 8; ++i) { rr[i] = nr[i]; rk_[i] = nk[i]; rv[i] = nv[i]; }
        }
    }
    { bf16_t* Vp = (bf16_t*)(a.ws + WS_V) + ((size_t)bh * 64 + lane) * SEQ + t0;
#pragma unroll
      for (int q = 0; q < 4; ++q) *(GAS u32x4*)(Vp + 8 * q) = (u32x4){vv2[4 * q], vv2[4 * q + 1], vv2[4 * q + 2], vv2[4 * q + 3]};
      if (lane < 32) ((float*)(a.ws + WS_BON))[(size_t)bh * SEQ + t0 + lane] = bon;
      *(GAS float*)(blk + CH_PL + lane * 4) = e_prev;
#pragma unroll
      for (int ks = 0; ks < 2; ++ks)
#pragma unroll
          for (int hh = 0; hh < 2; ++hh) { const int s0 = 16 * ks + 4 * hh, s1 = s0 + 8;
              st_frag(blk, 22 + 2 * h2 + ks, 32 * hh + r32, (u32x4){vv2[s0 >> 1], vv2[(s0 >> 1) + 1], vv2[s1 >> 1], vv2[(s1 >> 1) + 1]}); } }
    LDS_WAIT(); asm volatile("" ::: "memory");
    f32x16 ab = zero16(), ak = zero16(), rb = zero16(), rk = zero16();
#pragma unroll
    for (int ks = 0; ks < 4; ++ks) { const int fo = r32 * 128 + (((2 * ks + h2) ^ (r32 & 7)) << 4);
        const bf16x8 fa = *(const LAS bf16x8*)(T_A + fo), fb = *(const LAS bf16x8*)(T_B + fo), fk = *(const LAS bf16x8*)(T_K + fo), frr = *(const LAS bf16x8*)(T_R + fo);
        ab = __builtin_amdgcn_mfma_f32_32x32x16_bf16(fb, fa, ab, 0, 0, 0); ak = __builtin_amdgcn_mfma_f32_32x32x16_bf16(fk, fa, ak, 0, 0, 0);
        rb = __builtin_amdgcn_mfma_f32_32x32x16_bf16(fb, frr, rb, 0, 0, 0); rk = __builtin_amdgcn_mfma_f32_32x32x16_bf16(fk, frr, rk, 0, 0, 0); }
#pragma unroll
    for (int ks = 0; ks < 4; ++ks) st_frag(blk, 4 + ks, lane, tile_frag_pi(T_R, r32, ks, h2));
    { unsigned short tb[32], tk[32];
#pragma unroll
      for (int t = 0; t < 32; ++t) { const int to = tile_off(t, lane); tb[t] = *(const LAS unsigned short*)(T_B + to); tk[t] = *(const LAS unsigned short*)(T_K + to); }
#pragma unroll
      for (int ks = 0; ks < 2; ++ks)
#pragma unroll
          for (int hh = 0; hh < 2; ++hh) { const int s0 = 16 * ks + 4 * hh, s1 = s0 + 8; const int lp = 32 * hh + r32;
              u32x4 w; w.x = (unsigned)tb[s0] | ((unsigned)tb[s0 + 1] << 16); w.y = (unsigned)tb[s0 + 2] | ((unsigned)tb[s0 + 3] << 16); w.z = (unsigned)tb[s1] | ((unsigned)tb[s1 + 1] << 16); w.w = (unsigned)tb[s1 + 2] | ((unsigned)tb[s1 + 3] << 16);
              st_frag(blk, 14 + 4 * h2 + ks, lp, w);
              w.x = (unsigned)tk[s0] | ((unsigned)tk[s0 + 1] << 16); w.y = (unsigned)tk[s0 + 2] | ((unsigned)tk[s0 + 3] << 16); w.z = (unsigned)tk[s1] | ((unsigned)tk[s1 + 1] << 16); w.w = (unsigned)tk[s1 + 2] | ((unsigned)tk[s1 + 3] << 16);
              st_frag(blk, 14 + 4 * h2 + 2 + ks, lp, w); } }
    LDS_WAIT(); asm volatile("" ::: "memory");
#pragma unroll
    for (int ks = 0; ks < 2; ++ks) { float m[8], n[8];
#pragma unroll
        for (int j = 0; j < 8; ++j) { const int r = 8 * ks + j; const int s = (r & 3) + 8 * (r >> 2) + 4 * h2; m[j] = (s <= r32) ? rb[r] : 0.f; n[j] = (s <= r32) ? rk[r] : 0.f; }
        u32x4 w; w.x = pk2(m[0], m[1]); w.y = pk2(m[2], m[3]); w.z = pk2(m[4], m[5]); w.w = pk2(m[6], m[7]); st_frag(blk, 8 + ks, lane, w);
        w.x = pk2(n[0], n[1]); w.y = pk2(n[2], n[3]); w.z = pk2(n[4], n[5]); w.w = pk2(n[6], n[7]); st_frag(blk, 12 + ks, lane, w); }
    LAS float* F_AB = (LAS float*)T_B; LAS float* F_AK = (LAS float*)T_K;
#pragma unroll
    for (int q = 0; q < 4; ++q) { f32x4 u, w;
#pragma unroll
        for (int i = 0; i < 4; ++i) { const int s = 8 * q + 4 * h2 + i; u[i] = (s < r32) ? ab[4 * q + i] : 0.f; w[i] = (s < r32) ? ak[4 * q + i] : 0.f; }
        *(LAS f32x4*)(F_AB + r32 * 32 + 8 * q + 4 * h2) = u; *(LAS f32x4*)(F_AK + r32 * 32 + 8 * q + 4 * h2) = w; }
    LDS_WAIT(); asm volatile("" ::: "memory");
    float xs[32], m1[32];
#pragma unroll
    for (int t = 0; t < 32; ++t) { xs[t] = bf2f(*(const LAS unsigned short*)(T_A + tile_off(t, lane))); m1[t] = F_AK[t * 32 + r32]; }
    {
        f32x4 cfc[8], cfn[8];
        cfc[0] = *(const LAS f32x4*)(F_AB + 32);
#pragma unroll
        for (int t = 1; t < 32; ++t) {
            if (t < 31) {
#pragma unroll
                for (int q = 0; q < (t + 4) / 4; ++q) cfn[q] = *(const LAS f32x4*)(F_AB + (t + 1) * 32 + 4 * q);
            }
            asm volatile("" ::: "memory");
            float s1 = xs[t], s2 = m1[t];
#pragma unroll
            for (int q = 0; q < (t + 3) / 4; ++q) {
#pragma unroll
                for (int i = 0; i < 4; ++i) if (4 * q + i < t) { s1 += cfc[q][i] * xs[4 * q + i]; s2 += cfc[q][i] * m1[4 * q + i]; } }
            xs[t] = s1; m1[t] = s2;
            if (t < 31) {
#pragma unroll
                for (int q = 0; q < (t + 4) / 4; ++q) cfc[q] = cfn[q];
            }
            asm volatile("" : "+v"(xs[t]), "+v"(m1[t]));
        }
    }
    LDS_WAIT(); asm volatile("" ::: "memory");
    LAS unsigned char* T_M = T_A;
#pragma unroll
    for (int t = 0; t < 32; ++t) *(LAS unsigned short*)(T_R + tile_off(t, lane)) = (unsigned short)f2bf(xs[t]);
    if (lane < 32) {
#pragma unroll
        for (int t = 0; t < 32; ++t) *(LAS unsigned short*)(T_M + t * 64 + lane * 2) = (unsigned short)f2bf(m1[t]);
    }
    LDS_WAIT(); asm volatile("" ::: "memory");
#pragma unroll
    for (int ks = 0; ks < 4; ++ks) st_frag(blk, ks, lane, tile_frag_pi(T_R, r32, ks, h2));
#pragma unroll
    for (int ks = 0; ks < 2; ++ks) { const u32x2 lo = *(const LAS u32x2*)(T_M + r32 * 64 + (16 * ks + 4 * h2) * 2), hi = *(const LAS u32x2*)(T_M + r32 * 64 + (16 * ks + 8 + 4 * h2) * 2);
        st_frag(blk, 10 + ks, lane, (u32x4){lo.x, lo.y, hi.x, hi.y}); }
    LDS_WAIT(); asm volatile("" ::: "memory");
    __syncthreads();
}
__device__ __forceinline__ void p3_phase(const Args& a, LAS unsigned char* lds, int tid, int wave, int lane, int vcu, int G) {
    for (int grp = vcu; grp < BATCH * NCH; grp += G) p3_rwkv_group(a, grp, lds, tid, wave, lane);
    p3_conv(a, wave, lane, vcu, G);
}

__device__ __forceinline__ void p4_issue(const unsigned char* blkp, LAS unsigned char* slot, int nt, int lane) {
#pragma unroll
    for (int f = 0; f < 22; ++f) __builtin_amdgcn_global_load_lds((const unsigned*)(blkp + f * 1024 + lane * 16), (LAS unsigned*)(slot + f * 1024), 16, 0, 0);
#pragma unroll
    for (int f = 0; f < 2; ++f) __builtin_amdgcn_global_load_lds((const unsigned*)(blkp + (22 + 2 * nt + f) * 1024 + lane * 16), (LAS unsigned*)(slot + (22 + f) * 1024), 16, 0, 0);
    __builtin_amdgcn_global_load_lds((const unsigned*)(blkp + CH_PL + lane * 4), (LAS unsigned*)(slot + 24576), 4, 0, 0);
}
#define P4_FRAG(f) (*(const LAS bf16x8*)(base + (f) * 1024 + lane * 16))
__device__ __forceinline__ void p4_phase(const Args& a, LAS unsigned char* lds, int wave, int lane, int vcu, int G) {
    if (wave >= 2) { expert_transposes(a, (LAS float*)(lds + 57344 + (wave - 2) * 16640), vcu * 6 + (wave - 2), G * 6, lane); return; }
    if (wave != 0) return;
    const int w = blockIdx.x; if (w >= 2 * NBH) return;
    const int bh = w >> 1, nt = w & 1, r32 = lane & 31, h2 = lane >> 5;
    const unsigned char* blk0 = a.ws + WS_CH + (size_t)bh * NCH * CHB;
    float* OT = (float*)(a.ws + WS_OT) + ((size_t)bh * 64 + 32 * nt + r32) * SEQ;
    f32x16 S0 = zero16(), S1 = zero16();
    p4_issue(blk0, lds, nt, lane);
    for (int ci = 0; ci < NCH; ++ci) {
        VM_WAIT();
        if (ci + 1 < NCH) p4_issue(blk0 + (size_t)(ci + 1) * CHB, lds + ((ci + 1) & 1) * 28672, nt, lane);
        const LAS unsigned char* base = lds + (ci & 1) * 28672;
        const bf16x8 sb00 = pack8(S0[0], S0[1], S0[2], S0[3], S0[4], S0[5], S0[6], S0[7]), sb01 = pack8(S0[8], S0[9], S0[10], S0[11], S0[12], S0[13], S0[14], S0[15]);
        const bf16x8 sb10 = pack8(S1[0], S1[1], S1[2], S1[3], S1[4], S1[5], S1[6], S1[7]), sb11 = pack8(S1[8], S1[9], S1[10], S1[11], S1[12], S1[13], S1[14], S1[15]);
        const bf16x8 vt0 = P4_FRAG(22), vt1 = P4_FRAG(23);
        f32x16 U = zero16();
        U = __builtin_amdgcn_mfma_f32_32x32x16_bf16(P4_FRAG(0), sb00, U, 0, 0, 0); U = __builtin_amdgcn_mfma_f32_32x32x16_bf16(P4_FRAG(1), sb01, U, 0, 0, 0);
        U = __builtin_amdgcn_mfma_f32_32x32x16_bf16(P4_FRAG(2), sb10, U, 0, 0, 0); U = __builtin_amdgcn_mfma_f32_32x32x16_bf16(P4_FRAG(3), sb11, U, 0, 0, 0);
        U = __builtin_amdgcn_mfma_f32_32x32x16_bf16(P4_FRAG(10), vt0, U, 0, 0, 0); U = __builtin_amdgcn_mfma_f32_32x32x16_bf16(P4_FRAG(11), vt1, U, 0, 0, 0);
        f32x16 O = zero16();
        O = __builtin_amdgcn_mfma_f32_32x32x16_bf16(P4_FRAG(4), sb00, O, 0, 0, 0); O = __builtin_amdgcn_mfma_f32_32x32x16_bf16(P4_FRAG(5), sb01, O, 0, 0, 0);
        O = __builtin_amdgcn_mfma_f32_32x32x16_bf16(P4_FRAG(6), sb10, O, 0, 0, 0); O = __builtin_amdgcn_mfma_f32_32x32x16_bf16(P4_FRAG(7), sb11, O, 0, 0, 0);
        O = __builtin_amdgcn_mfma_f32_32x32x16_bf16(P4_FRAG(12), vt0, O, 0, 0, 0); O = __builtin_amdgcn_mfma_f32_32x32x16_bf16(P4_FRAG(13), vt1, O, 0, 0, 0);
        const bf16x8 ub0 = pack8(U[0], U[1], U[2], U[3], U[4], U[5], U[6], U[7]), ub1 = pack8(U[8], U[9], U[10], U[11], U[12], U[13], U[14], U[15]);
        O = __builtin_amdgcn_mfma_f32_32x32x16_bf16(P4_FRAG(8), ub0, O, 0, 0, 0); O = __builtin_amdgcn_mfma_f32_32x32x16_bf16(P4_FRAG(9), ub1, O, 0, 0, 0);
        S0 = __builtin_amdgcn_mfma_f32_32x32x16_bf16(P4_FRAG(14), ub0, S0, 0, 0, 0); S0 = __builtin_amdgcn_mfma_f32_32x32x16_bf16(P4_FRAG(15), ub1, S0, 0, 0, 0);
        S0 = __builtin_amdgcn_mfma_f32_32x32x16_bf16(P4_FRAG(16), vt0, S0, 0, 0, 0); S0 = __builtin_amdgcn_mfma_f32_32x32x16_bf16(P4_FRAG(17), vt1, S0, 0, 0, 0);
        S1 = __builtin_amdgcn_mfma_f32_32x32x16_bf16(P4_FRAG(18), ub0, S1, 0, 0, 0); S1 = __builtin_amdgcn_mfma_f32_32x32x16_bf16(P4_FRAG(19), ub1, S1, 0, 0, 0);
        S1 = __builtin_amdgcn_mfma_f32_32x32x16_bf16(P4_FRAG(20), vt0, S1, 0, 0, 0); S1 = __builtin_amdgcn_mfma_f32_32x32x16_bf16(P4_FRAG(21), vt1, S1, 0, 0, 0);
#pragma unroll
        for (int q = 0; q < 4; ++q) { const f32x4 p0 = *(const LAS f32x4*)(base + 24576 + (8 * q + 4 * h2) * 4), p1 = *(const LAS f32x4*)(base + 24576 + (32 + 8 * q + 4 * h2) * 4);
#pragma unroll
            for (int i = 0; i < 4; ++i) { S0[4 * q + i] *= p0[i]; S1[4 * q + i] *= p1[i]; }
            *(GAS f32x4*)(OT + ci * CL + 8 * q + 4 * h2) = (f32x4){O[4 * q], O[4 * q + 1], O[4 * q + 2], O[4 * q + 3]}; }
        LDS_WAIT();
    }
    VM_WAIT();
}

__device__ __forceinline__ void p5_phase(const Args& a, int wave, int lane, int vcu, int G) {
    const int gw = vcu * NWAVES + wave, NGW = G * NWAVES;
    const float* OT = (const float*)(a.ws + WS_OT); const bf16_t* Gb = (const bf16_t*)(a.ws + WS_G); const bf16_t* Vb = (const bf16_t*)(a.ws + WS_V);
    const float* BON = (const float*)(a.ws + WS_BON); bf16_t* Y = (bf16_t*)(a.ws + WS_YMIX);
    for (int un = gw; un < NBH * (SEQ / 64); un += NGW) {
        const int bh = un >> 5, tb = un & 31, t = tb * 64 + lane, b = bh >> 3, h = bh & 7;
        const size_t base = (size_t)bh * 64 * SEQ + t;
        const float o0 = OT[base]; float s = 0.f, q = 0.f;
#pragma unroll 16
        for (int nv = 0; nv < 64; ++nv) { const float d = OT[base + (size_t)nv * SEQ] - o0; s += d; q += d * d; }
        const float md = s * (1.f / 64.f), mean = o0 + md;
        const float rstd = 1.0f / sqrtf(fmaxf(q * (1.f / 64.f) - md * md, 0.f) + GN_EPS);
        const float bon = BON[(size_t)bh * SEQ + t];
        bf16_t* yp = Y + ((size_t)b * SEQ + t) * D + 512 + h * 64;
#pragma unroll 1
        for (int g8 = 0; g8 < 8; ++g8) { float y[8];
#pragma unroll
            for (int e = 0; e < 8; ++e) { const int nv = 8 * g8 + e; const float ov = OT[base + (size_t)nv * SEQ], v = bf2f(Vb[base + (size_t)nv * SEQ]), g = bf2f(Gb[base + (size_t)nv * SEQ]);
                y[e] = ((ov - mean) * rstd * a.in[I_LNW][h * 64 + nv] + a.in[I_LNB][h * 64 + nv] + bon * v) * g; }
            u32x4 w; w.x = pk2(y[0], y[1]); w.y = pk2(y[2], y[3]); w.z = pk2(y[4], y[5]); w.w = pk2(y[6], y[7]);
            *(GAS u32x4*)(yp + 8 * g8) = w; }
    }
}

constexpr int RW_LD = 1028;
__device__ __forceinline__ void p7_phase(const Args& a, LAS unsigned char* lds, int tid, int wave, int lane) {
    LAS float* RWT = (LAS float*)lds;
    LAS int* cntL = (LAS int*)(lds + 32 * RW_LD * 4);
    LAS int* baseL = cntL + 32;
    LAS int* rec = baseL + 32;
    const float* mod = (const float*)(a.ws + WS_MOD); bf16_t* U = (bf16_t*)(a.ws + WS_U);
    const float* H = a.out;
    for (int i = tid; i < 32 * 1024 / 4; i += 512) { const f32x4 v = *(const GAS f32x4*)(a.in[I_RW] + 4 * i); const int col = (4 * i) >> 5, ex = (4 * i) & 31;
#pragma unroll
        for (int e = 0; e < 4; ++e) RWT[(ex + e) * RW_LD + col] = v[e]; }
    if (tid < 32) cntL[tid] = 0;
    __syncthreads();
    const int rbase = blockIdx.x * 128 + wave * 16;
    const float rbias = a.in[I_RB][lane >> 1];
    for (int i = 0; i < 16; ++i) {
        const int row = rbase + i, b = row >> 11;
        const GAS f32x4* hr = (const GAS f32x4*)(H + (size_t)row * D) + lane;
        f32x4 v[4]; float s = 0.f;
#pragma unroll
        for (int j = 0; j < 4; ++j) { v[j] = hr[64 * j]; s += (v[j][0] * v[j][0] + v[j][1] * v[j][1]) + (v[j][2] * v[j][2] + v[j][3] * v[j][3]); }
        const float inv = 1.0f / sqrtf(wave_sum(s) * (1.f / D) + NORM_EPS);
        GAS u32x2* o8 = (GAS u32x2*)(U + (size_t)row * D) + lane;
#pragma unroll
        for (int j = 0; j < 4; ++j) { const int col = 4 * lane + 256 * j;
            const f32x4 g = *(const f32x4*)(a.in[I_N2G] + col), sh = *(const f32x4*)(mod + b * 6144 + 3072 + col), sc = *(const f32x4*)(mod + b * 6144 + 4096 + col);
            v[j] = v[j] * inv * g * (sc + 1.0f) + sh;
            u32x2 w; w.x = pk2(v[j][0], v[j][1]); w.y = pk2(v[j][2], v[j][3]); o8[64 * j] = w; }
        float lg[32];
#pragma unroll
        for (int ex = 0; ex < 32; ++ex) { float acc = 0.f; if ((ex & 3) == 0) asm volatile("" ::: "memory");
#pragma unroll
            for (int j = 0; j < 4; ++j) { const f32x4 w = *(const LAS f32x4*)(RWT + ex * RW_LD + 4 * lane + 256 * j); acc += (v[j][0] * w[0] + v[j][1] * w[1]) + (v[j][2] * w[2] + v[j][3] * w[3]); }
            lg[ex] = acc; }
#pragma unroll
        for (int k = 0; k < 16; ++k) { const bool up = (lane & 32) != 0; const float send = up ? lg[k] : lg[k + 16]; const float keep = up ? lg[k + 16] : lg[k]; lg[k] = keep + __shfl_xor(send, 32); }
#pragma unroll
        for (int k = 0; k < 8; ++k) { const bool up = (lane & 16) != 0; const float send = up ? lg[k] : lg[k + 8]; const float keep = up ? lg[k + 8] : lg[k]; lg[k] = keep + __shfl_xor(send, 16); }
#pragma unroll
        for (int k = 0; k < 4; ++k) { const bool up = (lane & 8) != 0; const float send = up ? lg[k] : lg[k + 4]; const float keep = up ? lg[k + 4] : lg[k]; lg[k] = keep + __shfl_xor(send, 8); }
#pragma unroll
        for (int k = 0; k < 2; ++k) { const bool up = (lane & 4) != 0; const float send = up ? lg[k] : lg[k + 2]; const float keep = up ? lg[k + 2] : lg[k]; lg[k] = keep + __shfl_xor(send, 4); }
        { const bool up = (lane & 2) != 0; const float send = up ? lg[0] : lg[1]; const float keep = up ? lg[1] : lg[0]; lg[0] = keep + __shfl_xor(send, 2); }
        float val = lg[0] + __shfl_xor(lg[0], 1) + rbias;
        int ek[4]; float lk[4];
#pragma unroll
        for (int k = 0; k < 4; ++k) { const float m = wave_max(val); const unsigned long long bal = __ballot(val == m); const int fl = (int)__builtin_ctzll(bal);
            ek[k] = fl >> 1; lk[k] = m; if ((lane >> 1) == ek[k]) val = -INFINITY; }
        const float e1 = __expf(lk[1] - lk[0]), e2 = __expf(lk[2] - lk[0]), e3 = __expf(lk[3] - lk[0]); const float rs = 1.0f / (1.0f + e1 + e2 + e3);
        if (lane < 4) { const int e = lane == 0 ? ek[0] : lane == 1 ? ek[1] : lane == 2 ? ek[2] : ek[3];
            const float g = (lane == 0 ? 1.0f : lane == 1 ? e1 : lane == 2 ? e2 : e3) * rs;
            const int pos = atomicAdd((int*)&cntL[e], 1);
            LAS int* r = rec + ((wave * 16 + i) * 4 + lane) * 3; r[0] = e; r[1] = pos; r[2] = __builtin_bit_cast(int, g); }
    }
    __syncthreads();
    if (tid < 32) baseL[tid] = atomicAdd((int*)(a.ws + WS_CTL) + CW_CNT + tid, cntL[tid]);
    __syncthreads();
    { const LAS int* r = rec + tid * 3; const int e = r[0], slot = baseL[e] + r[1]; const int pair = (blockIdx.x * 128 + (tid >> 2)) * 4 + (tid & 3);
      ((int*)(a.ws + WS_LIST))[e * LCAP + slot] = pair; ((int*)(a.ws + WS_GATE))[pair] = r[2]; }
}

__device__ __forceinline__ void p10_phase(const Args& a, int wave, int lane, int vcu, int G) {
    const float* mod = (const float*)(a.ws + WS_MOD); const bf16_t* PAIR = (const bf16_t*)(a.ws + WS_PAIR);
    const int gw = vcu * NWAVES + wave, NGW = G * NWAVES;
    for (int row = gw; row < M; row += NGW) {
        const int b = row >> 11;
        GAS f32x4* hr = (GAS f32x4*)(a.out + (size_t)row * D) + lane;
        const GAS u32x2* pp = (const GAS u32x2*)(PAIR + (size_t)row * 4 * D) + lane;
        f32x4 v[4]; float s = 0.f;
#pragma unroll
        for (int j = 0; j < 4; ++j) { const int col = 4 * lane + 256 * j; v[j] = hr[64 * j];
            f32x4 y = (f32x4){0.f, 0.f, 0.f, 0.f};
#pragma unroll
            for (int k = 0; k < 4; ++k) { const u32x2 w = pp[k * 256 + 64 * j]; y += (f32x4){bflo(w.x), bfhi(w.x), bflo(w.y), bfhi(w.y)}; }
            const f32x4 gt = *(const f32x4*)(mod + b * 6144 + 5120 + col);
            v[j] += gt * y; s += (v[j][0] * v[j][0] + v[j][1] * v[j][1]) + (v[j][2] * v[j][2] + v[j][3] * v[j][3]); }
        const float inv = 1.0f / sqrtf(wave_sum(s) * (1.f / D) + NORM_EPS);
#pragma unroll
        for (int j = 0; j < 4; ++j) { const f32x4 g = *(const f32x4*)(a.in[I_FG] + 4 * lane + 256 * j); hr[64 * j] = v[j] * inv * g; }
    }
}

constexpr int N_PHASES = 11;
__global__ void __launch_bounds__(NWAVES * 64, 2) hymba_fwd(Args a) {
    extern __shared__ __attribute__((aligned(16))) unsigned char lds_raw[];
    LAS unsigned char* lds = (LAS unsigned char*)lds_raw;
    volatile LAS unsigned* MISC = (volatile LAS unsigned*)(lds + LDS_MISC);
    const int tid = threadIdx.x, lane = tid & 63, wave = __builtin_amdgcn_readfirstlane(tid >> 6);
    const int G = gridDim.x; const int bx = blockIdx.x; const int vcu = (G % 8 == 0) ? (bx % 8) * (G / 8) + bx / 8 : bx;
    gu32* ctl = (gu32*)(a.ws + WS_CTL);
    if (tid < 128) MISC[tid] = 0u;
    __syncthreads();
    XcdBarrier bar; bar.bar = (unsigned*)(ctl + CW_BAR); bar.x = 0; bar.st = nullptr;
    if (MK_N_LAUNCHES == 1) bar = xcd_barrier_post((unsigned*)(ctl + CW_BAR), MISC + 8);
    const int lo = a.ph_lo, hi = a.ph_hi;
#ifndef PH_MASK
#define PH_MASK 0x7ff
#endif
#define IN(k) (((PH_MASK >> (k)) & 1) && lo <= (k) && (k) < hi)
#ifndef PROBE_DUP
#define PROBE_DUP -1
#endif
#define SEAM(k) do { if (IN(k) && IN((k) + 1)) xcd_barrier(bar); } while (0)
    if (IN(0)) { p0_phase(a, lds, tid, wave, lane, vcu, G); }
#if PROBE_DUP == 0
    __syncthreads();
    if (IN(0)) { p0_phase(a, lds, tid, wave, lane, vcu, G); }
#endif
    SEAM(0);
    if (IN(1)) { p1_phase(a, wave, lane, vcu, G); }
#if PROBE_DUP == 1
    if (IN(1)) { p1_phase(a, wave, lane, vcu, G); }
#endif
    SEAM(1);
    if (IN(2)) {
        DenseSched S{(const char*)(a.ws + WS_U), (const char*)(a.ws + WS_WIN), M / 256, NIN / 256, G, bx, (size_t)256 * 1024 * 2};
        EpiBf16 E{(bf16_t*)(a.ws + WS_PROJ), NIN};
        pg8::gemm_phase<EpiBf16, DenseSched, false, true>(lds, 1024, S, E);
    }
#if PROBE_DUP == 2
    if (IN(2)) {
        DenseSched S{(const char*)(a.ws + WS_U), (const char*)(a.ws + WS_WIN), M / 256, NIN / 256, G, bx, (size_t)256 * 1024 * 2};
        EpiBf16 E{(bf16_t*)(a.ws + WS_PROJ), NIN};
        pg8::gemm_phase<EpiBf16, DenseSched, false, true>(lds, 1024, S, E);
    }
#endif
    SEAM(2);
    if (IN(3)) { p3_phase(a, lds, tid, wave, lane, vcu, G); }
#if PROBE_DUP == 3
    if (IN(3)) { p3_phase(a, lds, tid, wave, lane, vcu, G); }
#endif
    SEAM(3);
    if (IN(4)) { p4_phase(a, lds, wave, lane, vcu, G); }
#if PROBE_DUP == 4
    if (IN(4)) { p4_phase(a, lds, wave, lane, vcu, G); }
#endif
    SEAM(4);
    if (IN(5)) { p5_phase(a, wave, lane, vcu, G); }
#if PROBE_DUP == 5
    if (IN(5)) { p5_phase(a, wave, lane, vcu, G); }
#endif
    SEAM(5);
    if (IN(6)) {
        DenseSched S{(const char*)(a.ws + WS_YMIX), (const char*)(a.ws + WS_WOUT), M / 256, D / 256, G, bx, (size_t)256 * 1024 * 2};
        EpiResid E{a.in[I_X], a.out, (const float*)(a.ws + WS_MOD)};
        pg8::gemm_phase<EpiResid, DenseSched, false, true>(lds, 1024, S, E);
    }
#if PROBE_DUP == 6
    if (IN(6)) {
        DenseSched S{(const char*)(a.ws + WS_YMIX), (const char*)(a.ws + WS_WOUT), M / 256, D / 256, G, bx, (size_t)256 * 1024 * 2};
        EpiResid E{a.in[I_X], a.out, (const float*)(a.ws + WS_MOD)};
        pg8::gemm_phase<EpiResid, DenseSched, false, true>(lds, 1024, S, E);
    }
#endif
    SEAM(6);
    if (IN(7)) { p7_phase(a, lds, tid, wave, lane); }
#if PROBE_DUP == 7
    if (IN(7)) { p7_phase(a, lds, tid, wave, lane); }
#endif
    SEAM(7);
    volatile LAS int* bstart = (volatile LAS int*)(lds + LDS_MISC + 128);
    volatile LAS int* ecnt = bstart + 40;
    volatile LAS unsigned char* blk_e = (volatile LAS unsigned char*)(lds + LDS_MISC - 1024);
    if (IN(8) || IN(9)) {
        if (tid == 0) { int s = 0; for (int e = 0; e < NE; ++e) { const int c = (int)__hip_atomic_load(ctl + CW_CNT + e, RLX_AGENT); ecnt[e] = c; bstart[e] = s; s += (c + 255) >> 8; } bstart[NE] = s; }
        __syncthreads();
        for (int pm = tid; pm < bstart[NE]; pm += NWAVES * 64) { int e = 0; for (int j = 1; j < NE; ++j) e += (bstart[j] <= pm) ? 1 : 0; blk_e[pm] = (unsigned char)e; }
        __syncthreads();
    }
    if (IN(8)) {
        MoeSched S{(const char*)(a.ws + WS_U), (const char*)(a.ws + WS_W1T), (size_t)2048 * 1024 * 2, bstart[NE], 8, G, bx, (size_t)256 * 1024 * 2, bstart, ecnt, (const int*)(a.ws + WS_LIST), 2048, true, blk_e};
        EpiSwiglu E{(bf16_t*)(a.ws + WS_ACT), a.in[I_B1], &S};
        pg8::gemm_phase<EpiSwiglu, MoeSched, true, true>(lds, 1024, S, E);
    }
#if PROBE_DUP == 8
    if (IN(8)) {
        MoeSched S{(const char*)(a.ws + WS_U), (const char*)(a.ws + WS_W1T), (size_t)2048 * 1024 * 2, bstart[NE], 8, G, bx, (size_t)256 * 1024 * 2, bstart, ecnt, (const int*)(a.ws + WS_LIST), 2048, true, blk_e};
        EpiSwiglu E{(bf16_t*)(a.ws + WS_ACT), a.in[I_B1], &S};
        pg8::gemm_phase<EpiSwiglu, MoeSched, true, true>(lds, 1024, S, E);
    }
#endif
    SEAM(8);
    if (IN(9)) {
        MoeSched S{(const char*)(a.ws + WS_ACT), (const char*)(a.ws + WS_W2T), (size_t)1024 * 1024 * 2, bstart[NE], 4, G, bx, (size_t)256 * 1024 * 2, bstart, ecnt, (const int*)(a.ws + WS_LIST), 2048, false, blk_e};
        EpiPair E{(bf16_t*)(a.ws + WS_PAIR), a.in[I_B2], (const float*)(a.ws + WS_GATE), &S};
        pg8::gemm_phase<EpiPair, MoeSched, false, true>(lds, 1024, S, E);
    }
#if PROBE_DUP == 9
    if (IN(9)) {
        MoeSched S{(const char*)(a.ws + WS_ACT), (const char*)(a.ws + WS_W2T), (size_t)1024 * 1024 * 2, bstart[NE], 4, G, bx, (size_t)256 * 1024 * 2, bstart, ecnt, (const int*)(a.ws + WS_LIST), 2048, false, blk_e};
        EpiPair E{(bf16_t*)(a.ws + WS_PAIR), a.in[I_B2], (const float*)(a.ws + WS_GATE), &S};
        pg8::gemm_phase<EpiPair, MoeSched, false, true>(lds, 1024, S, E);
    }
#endif
    SEAM(9);
    if (IN(10)) { p10_phase(a, wave, lane, vcu, G); }
#if PROBE_DUP == 10
    if (IN(10)) { p10_phase(a, wave, lane, vcu, G); }
#endif
#undef IN
#undef SEAM
}

extern "C" void kernel_launch(void* const* d_in, const int* in_sizes, int n_in, void* d_out, int out_size, void* d_ws, size_t ws_size, hipStream_t stream) {
    static int grid = 0;
    if (grid == 0) {
        if (n_in != 28 || in_sizes[0] != M * D || out_size != M * D || ws_size < WS_END) { fprintf(stderr, "kernel_launch: unexpected shapes / workspace (n_in %d, ws %zu)\n", n_in, ws_size); grid = -1; return; }
        int dev = 0, cus = 0;
        if (hipGetDevice(&dev) != hipSuccess || hipDeviceGetAttribute(&cus, hipDeviceAttributeMultiprocessorCount, dev) != hipSuccess) { grid = -1; return; }
        if (hipFuncSetAttribute((const void*)hymba_fwd, hipFuncAttributeMaxDynamicSharedMemorySize, LDS_TOTAL) != hipSuccess) { fprintf(stderr, "kernel_launch: hipFuncSetAttribute failed\n"); grid = -1; return; }
        (void)hipGetLastError();
        grid = cus;
        if (grid != 256) fprintf(stderr, "kernel_launch: %d CUs (built for 256)\n", grid);
    }
    if (grid < 0) return;
    if (hipMemsetAsync((char*)d_ws + WS_CTL, 0, CTL_ZERO_BYTES, stream) != hipSuccess) return;
    Args a{};
    for (int i = 0; i < 28; ++i) a.in[i] = (const float*)d_in[i];
    a.out = (float*)d_out; a.ws = (unsigned char*)d_ws;
#if MK_N_LAUNCHES == 1
    a.ph_lo = 0; a.ph_hi = N_PHASES;
    hipLaunchKernelGGL(hymba_fwd, dim3(grid), dim3(NWAVES * 64), LDS_TOTAL, stream, a);
#else
    for (int p = 0; p < N_PHASES; ++p) { a.ph_lo = p; a.ph_hi = p + 1; hipLaunchKernelGGL(hymba_fwd, dim3(grid), dim3(NWAVES * 64), LDS_TOTAL, stream, a); }
#endif
}
```

```cpp
#include <hip/hip_runtime.h>
#include <cstdio>
#include <cstdint>

#ifndef MK_N_LAUNCHES
#define MK_N_LAUNCHES 1
#endif

#ifndef FP8_G3
#define FP8_G3 1
#endif
#ifndef FP8_G4
#define FP8_G4 1
#endif
#define LAS __attribute__((address_space(3)))
#define GAS __attribute__((address_space(1)))
typedef unsigned short bf16_t;
typedef short bf16x8 __attribute__((ext_vector_type(8)));
typedef float f32x4 __attribute__((ext_vector_type(4)));
typedef float f32x16 __attribute__((ext_vector_type(16)));
typedef float f32x2 __attribute__((ext_vector_type(2)));
typedef unsigned u32x4 __attribute__((ext_vector_type(4)));
typedef int v8i __attribute__((ext_vector_type(8)));
typedef unsigned u32x2 __attribute__((ext_vector_type(2)));
typedef GAS unsigned gu32;
#define RLX_AGENT __ATOMIC_RELAXED, __HIP_MEMORY_SCOPE_AGENT
#define LDS_WAIT() asm volatile("s_waitcnt lgkmcnt(0)" ::: "memory")
#define VM_WAIT() asm volatile("s_waitcnt vmcnt(0)" ::: "memory")

constexpr int D = 1024, BATCH = 16, SEQ = 2048, M = BATCH * SEQ;
constexpr int NIN = 3328;
constexpr int COL_B = 0, COL_C = 512, COL_H = 1024, COL_R = 1536, COL_K = 2048, COL_V = 2560, COL_DW = 3072;
constexpr int NE = 32, LCAP = 32768;
constexpr int CL = 32, NCH = SEQ / CL;
constexpr int NBH = BATCH * 8;
constexpr float NORM_EPS = 1e-5f, GN_EPS = 64e-5f;
constexpr int CHB = 27648;
constexpr int CH_PL = 26624;

constexpr size_t MiB = 1u << 20;
constexpr size_t WS_CTL = 0, CTL_ZERO_BYTES = 64 * 1024;
constexpr size_t WS_MOD = 1 * MiB;
constexpr size_t WS_LORA = 2 * MiB;
constexpr size_t WS_RWH = 2 * MiB + 512 * 1024;
constexpr size_t WS_WOUT = 3 * MiB;
constexpr size_t WS_WIN = 5 * MiB;
constexpr size_t WS_LIST = 12 * MiB;
constexpr size_t WS_GATE = 16 * MiB;
constexpr size_t WS_W1T = 17 * MiB;
constexpr size_t WS_W2T = 145 * MiB;
constexpr size_t WS_U = 209 * MiB;
constexpr size_t WS_YMIX = 273 * MiB;
constexpr size_t WS_PROJ = 337 * MiB;
constexpr size_t WS_CH = 545 * MiB;
constexpr size_t WS_OT = 761 * MiB;
constexpr size_t WS_G = 825 * MiB;
constexpr size_t WS_V = 857 * MiB;
constexpr size_t WS_BON = 889 * MiB;
constexpr size_t WS_ACT = 337 * MiB;
constexpr size_t WS_PAIR = 609 * MiB;
constexpr size_t WS_RSS = 890 * MiB;
constexpr size_t WS_END = 892 * MiB;
constexpr int CW_TMO = 0;
constexpr int CW_CNT = 64;
constexpr int CW_BAR = 4096;

constexpr int RING_BYTES = 131072;
constexpr int MISC_OFF = 144 * 1024;
constexpr int LDS_BYTES = 147456;

__device__ __forceinline__ unsigned f2bf(float f) { unsigned u = __builtin_bit_cast(unsigned, f); return (u + 0x7fffu + ((u >> 16) & 1u)) >> 16; }
__device__ __forceinline__ unsigned pk2(float lo, float hi) { return f2bf(lo) | (f2bf(hi) << 16); }
__device__ __forceinline__ unsigned pk4_fp8(float a, float b, float c, float d) {
    int r = __builtin_amdgcn_cvt_pk_fp8_f32(a, b, 0, false); r = __builtin_amdgcn_cvt_pk_fp8_f32(c, d, r, true); return (unsigned)r; }
__device__ __forceinline__ float bf2f(unsigned short h) { return __builtin_bit_cast(float, (unsigned)h << 16); }
__device__ __forceinline__ float bflo(unsigned w) { return __builtin_bit_cast(float, w << 16); }
__device__ __forceinline__ float bfhi(unsigned w) { return __builtin_bit_cast(float, w & 0xffff0000u); }
#define DPP_QP1 0xB1
#define DPP_QP2 0x4E
#define DPP_HMIR 0x141
#define DPP_MIR 0x140
#define DPP_BC15 0x142
#define DPP_BC31 0x143
#define dpp_f(old, v, ctrl, rmask) __builtin_bit_cast(float, __builtin_amdgcn_update_dpp(__builtin_bit_cast(int, (float)(old)), __builtin_bit_cast(int, (float)(v)), ctrl, rmask, 0xf, false))
__device__ __forceinline__ float wave_sum(float v) {
    v += dpp_f(0.f, v, DPP_QP1, 0xf); v += dpp_f(0.f, v, DPP_QP2, 0xf); v += dpp_f(0.f, v, DPP_HMIR, 0xf); v += dpp_f(0.f, v, DPP_MIR, 0xf);
    v += dpp_f(0.f, v, DPP_BC15, 0xa); v += dpp_f(0.f, v, DPP_BC31, 0xc);
    return __builtin_bit_cast(float, __builtin_amdgcn_readlane(__builtin_bit_cast(int, v), 63));
}
__device__ __forceinline__ float wave_max(float v) {
    const float ninf = -INFINITY;
    v = fmaxf(v, dpp_f(ninf, v, DPP_QP1, 0xf)); v = fmaxf(v, dpp_f(ninf, v, DPP_QP2, 0xf)); v = fmaxf(v, dpp_f(ninf, v, DPP_HMIR, 0xf)); v = fmaxf(v, dpp_f(ninf, v, DPP_MIR, 0xf));
    v = fmaxf(v, dpp_f(ninf, v, DPP_BC15, 0xa)); v = fmaxf(v, dpp_f(ninf, v, DPP_BC31, 0xc));
    return __builtin_bit_cast(float, __builtin_amdgcn_readlane(__builtin_bit_cast(int, v), 63));
}
__device__ __forceinline__ float fast_sigmoid(float x) { return __builtin_amdgcn_rcpf(1.0f + __expf(-x)); }
__device__ __forceinline__ bf16x8 pack8(float a0, float a1, float a2, float a3, float a4, float a5, float a6, float a7) {
    u32x4 w; w.x = pk2(a0, a1); w.y = pk2(a2, a3); w.z = pk2(a4, a5); w.w = pk2(a6, a7); return __builtin_bit_cast(bf16x8, w);
}

#define XB_TMO      128
#define XB_XCNT(j)  (256  + 64 * (j))
#define XB_XSUB(j)  (1280 + 64 * (j))
#define XB_XGEN(j)  (2304 + 64 * (j))
#define XB_TOP      3328
#define XB_TOPGEN   3392
#define XCD_BAR_WORDS 3456
#define XB_SPIN_CAP (1u << 20)
__device__ __forceinline__ unsigned xb_ld(unsigned* p)              { return __hip_atomic_load(p, __ATOMIC_RELAXED, __HIP_MEMORY_SCOPE_AGENT); }
__device__ __forceinline__ unsigned xb_add(unsigned* p, unsigned v) { return __hip_atomic_fetch_add(p, v, __ATOMIC_RELAXED, __HIP_MEMORY_SCOPE_AGENT); }
__device__ __forceinline__ unsigned xb_xcc_id() { return (unsigned)__builtin_amdgcn_s_getreg((3 << 11) | 20) & 0xFu; }
#define XB_SPIN(cond, bar) do { unsigned _sp = 0; while (cond) { __builtin_amdgcn_s_sleep(1); \
    if ((++_sp & 255u) == 0u) { if (xb_ld(&(bar)[XB_TMO])) break; if (_sp > XB_SPIN_CAP) { atomicAdd(&(bar)[XB_TMO], 1u); break; } } } } while (0)
struct XcdBarrier { unsigned* bar; unsigned x; volatile LAS unsigned* st; };
__device__ __forceinline__ XcdBarrier xcd_barrier_post(unsigned* bar, volatile LAS unsigned* st) {
    XcdBarrier b; b.bar = bar; b.x = xb_xcc_id(); b.st = st;
    if (threadIdx.x == 0) (void)xb_add(&bar[XB_XCNT(b.x)], 1u);
    return b;
}
__device__ __forceinline__ void xcd_barrier_complete(unsigned* bar, unsigned x, unsigned& nloc, unsigned& nx) {
    const unsigned G = gridDim.x * gridDim.y * gridDim.z;
    unsigned sum, cnt, mine, sp = 0u;
    for (;;) {
        sum = 0u; cnt = 0u; mine = 0u;
#pragma unroll
        for (unsigned j = 0; j < 16; ++j) { const unsigned c = xb_ld(&bar[XB_XCNT(j)]); sum += c; cnt += (c > 0u) ? 1u : 0u; mine = (j == x) ? c : mine; }
        if (sum == G) break;
        __builtin_amdgcn_s_sleep(1);
        if ((++sp & 255u) == 0u) { if (xb_ld(&bar[XB_TMO])) break; if (sp > XB_SPIN_CAP) { atomicAdd(&bar[XB_TMO], 1u); break; } }
    }
    nloc = mine > 0u ? mine : 1u; nx = cnt > 0u ? cnt : 1u;
}
__device__ __forceinline__ void xcd_barrier(const XcdBarrier& b) {
    asm volatile("s_waitcnt vmcnt(0)" ::: "memory");
    __syncthreads();
    if (threadIdx.x == 0) {
        unsigned* bar = b.bar;
        __builtin_amdgcn_s_waitcnt(0);
        unsigned nloc = b.st[0], nx = b.st[1];
        if (nloc == 0u) { xcd_barrier_complete(bar, b.x, nloc, nx); b.st[0] = nloc; b.st[1] = nx; }
        const unsigned old = xb_add(&bar[XB_XSUB(b.x)], 1u);
        const unsigned gen = old / nloc;
        if (old + 1u == (gen + 1u) * nloc) {
            __builtin_amdgcn_fence(__ATOMIC_RELEASE, "agent");
            asm volatile("s_waitcnt vmcnt(0)" ::: "memory");
            const unsigned og = xb_add(&bar[XB_TOP], 1u);
            const unsigned tg = og / nx;
            if (og + 1u == (tg + 1u) * nx) xb_add(&bar[XB_TOPGEN], 1u);
            else XB_SPIN(xb_ld(&bar[XB_TOPGEN]) == tg, bar);
            __builtin_amdgcn_fence(__ATOMIC_ACQUIRE, "agent");
            xb_add(&bar[XB_XGEN(b.x)], 1u);
            asm volatile("s_waitcnt vmcnt(0)" ::: "memory");
        } else {
            XB_SPIN(xb_ld(&bar[XB_XGEN(b.x)]) == gen, bar);
            __builtin_amdgcn_fence(__ATOMIC_ACQUIRE, "agent");
            asm volatile("s_waitcnt vmcnt(0)" ::: "memory");
        }
    }
    __syncthreads();
}

namespace pg8 {
constexpr int BM = 256, BK = 64, HALF = 128, HTB = HALF * BK * 2, NXCD = 8, WGM = 8;
__host__ __device__ __forceinline__ int lds_byte(int r, int c) { const int st = (r >> 4) * 2 + (c >> 5), rr = r & 15, cc = c & 31, ob = rr * 64 + cc * 2; return st * 1024 + (ob ^ (((ob >> 9) & 1) << 5)); }
__host__ __device__ __forceinline__ void stage_rc(int b, int& R, int& C) { const int st = b / 1024, sb = b % 1024, swz = sb ^ (((sb >> 9) & 1) << 5); R = (st >> 1) * 16 + swz / 64; C = (st & 1) * 32 + (swz % 64) / 2; }
__host__ __device__ __forceinline__ int perm32(int rho) { const int n = rho >> 4, i = rho & 15; return 8 * (i >> 2) + 4 * n + (i & 3); }
struct Unit { int pm, pn; };
__device__ __forceinline__ bool tile_order(int i, int G, int c, int nM, int nN, Unit& u) {
    const int nwg = nM * nN; const long L = (long)i * G + c; if (L >= nwg) return false;
    int wgid = (int)L; { const int q = nwg / NXCD, r = nwg % NXCD, xcd = wgid % NXCD, off = wgid / NXCD; wgid = (xcd < r ? xcd * (q + 1) : r * (q + 1) + (xcd - r) * q) + off; }
    const int nig = WGM * nN, gid = wgid / nig, fm = gid * WGM, gsz = (nM - fm) < WGM ? (nM - fm) : WGM;
    u.pm = fm + ((wgid % nig) % gsz); u.pn = (wgid % nig) / gsz; return true;
}
__device__ __forceinline__ unsigned cvt_pk_bf16(float lo, float hi) { unsigned r; asm volatile("v_cvt_pk_bf16_f32 %0, %1, %2" : "=v"(r) : "v"(lo), "v"(hi)); return r; }

template <class Epi, class Sched, bool GATHER, bool ALIGN_EPI, bool FP8 = false>
__device__ __forceinline__ void gemm_phase(LAS unsigned char* lds, const int K, const Sched& S, const Epi& E) {
    const int tid = threadIdx.x, wid = __builtin_amdgcn_readfirstlane(tid >> 6), lane = tid & 63, wr = wid >> 2, wc = wid & 3, fr = lane & 15, fq = lane >> 4;
    int nt = K / BK; asm volatile("" : "+s"(nt));
    unsigned voffA[2], voffB[2]; int rowA[2];
#pragma unroll
    for (int i = 0; i < 2; ++i) { int R, C; stage_rc(tid * 16 + i * 8192, R, C); const int Rb = Epi::PERM ? ((R & ~31) + perm32(R & 31)) : R;
        voffA[i] = (unsigned)(R * K + C) * 2u; voffB[i] = (unsigned)(Rb * K + C) * 2u; rowA[i] = R; if (GATHER) voffA[i] = (unsigned)C * 2u; }
    const size_t kstep = (size_t)(BK * 2);
    const size_t hstep = (size_t)HALF * K * 2;
    const unsigned ldsw = (unsigned)wid * 1024u;
    const int aoff = lds_byte(wr * 64 + fr, fq * 8), boff = lds_byte(wc * 32 + fr, fq * 8);
    const int sw8 = (fq >> 1) * 1024 + fr * 64 + ((((fq & 1) ^ (fr >> 3))) << 5);
    const int aoff8 = wr * 8192 + sw8, boff8 = wc * 4096 + sw8;
#define PG8_SA(b, h) (((b) * 2 + (h)) * HTB)
#define PG8_SB(b, h) ((4 + (b) * 2 + (h)) * HTB)
#define PG8_STAGE2(bufoff, gbase, o0, o1) do { \
        __builtin_amdgcn_global_load_lds((const unsigned*)((const char*)(gbase) + (o0)), (LAS unsigned*)(lds + (bufoff) + ldsw), 16, 0, 0); \
        __builtin_amdgcn_global_load_lds((const unsigned*)((const char*)(gbase) + (o1)), (LAS unsigned*)(lds + (bufoff) + ldsw + 8192), 16, 0, 0); } while (0)
#define PG8_STAGEB(bufoff, gbase) PG8_STAGE2(bufoff, gbase, voffB[0], voffB[1])
#define PG8_STAGEA(bufoff, kp, hh, OS) do { if (GATHER) PG8_STAGE2(bufoff, kp, OS[hh][0], OS[hh][1]); else PG8_STAGE2(bufoff, (kp) + (hh) * hstep, voffA[0], voffA[1]); } while (0)
#define PG8_LDA(dst, b, h) do { _Pragma("unroll") for (int m = 0; m < 4; ++m) _Pragma("unroll") for (int k = 0; k < 2; ++k) dst[m][k] = *(const LAS bf16x8*)(lds + PG8_SA(b, h) + aoff + m * 2048 + k * 1024); } while (0)
#define PG8_LDB(dst, b, h) do { _Pragma("unroll") for (int n = 0; n < 2; ++n) _Pragma("unroll") for (int k = 0; k < 2; ++k) dst[n][k] = *(const LAS bf16x8*)(lds + PG8_SB(b, h) + boff + n * 2048 + k * 1024); } while (0)
#define PG8_MMA(ai, bj, At, Bt) do { __builtin_amdgcn_s_setprio(1); _Pragma("unroll") for (int m = 0; m < 4; ++m) _Pragma("unroll") for (int n = 0; n < 2; ++n) _Pragma("unroll") for (int k = 0; k < 2; ++k) \
        acc[ai][bj][m][n] = __builtin_amdgcn_mfma_f32_16x16x32_bf16(Bt[n][k], At[m][k], acc[ai][bj][m][n], 0, 0, 0); __builtin_amdgcn_s_setprio(0); } while (0)
#define PG8_LDA8(dst, b, h) do { _Pragma("unroll") for (int m = 0; m < 4; ++m) { const u32x4 _x = *(const LAS u32x4*)(lds + PG8_SA(b, h) + aoff8 + m * 2048), _y = *(const LAS u32x4*)(lds + PG8_SA(b, h) + aoff8 + m * 2048 + 16); \
        dst[m] = (v8i){(int)_x.x, (int)_x.y, (int)_x.z, (int)_x.w, (int)_y.x, (int)_y.y, (int)_y.z, (int)_y.w}; } } while (0)
#define PG8_LDB8(dst, b, h) do { _Pragma("unroll") for (int n = 0; n < 2; ++n) { const u32x4 _x = *(const LAS u32x4*)(lds + PG8_SB(b, h) + boff8 + n * 2048), _y = *(const LAS u32x4*)(lds + PG8_SB(b, h) + boff8 + n * 2048 + 16); \
        dst[n] = (v8i){(int)_x.x, (int)_x.y, (int)_x.z, (int)_x.w, (int)_y.x, (int)_y.y, (int)_y.z, (int)_y.w}; } } while (0)
#define PG8_MMA8(ai, bj, At, Bt) do { __builtin_amdgcn_s_setprio(1); asm volatile("s_nop 1" ::: "memory"); _Pragma("unroll") for (int m = 0; m < 4; ++m) _Pragma("unroll") for (int n = 0; n < 2; ++n) \
        asm volatile("v_mfma_f32_16x16x128_f8f6f4 %0, %1, %2, %0" : "+v"(acc[ai][bj][m][n]) : "v"(Bt[n]), "v"(At[m])); __builtin_amdgcn_s_setprio(0); } while (0)
#define PG8_WAIT_V(n) asm volatile("s_waitcnt vmcnt(" #n ")" ::: "memory")
#define PG8_WAIT_L(n) asm volatile("s_waitcnt lgkmcnt(" #n ")" ::: "memory")
#define PG8_BAR __builtin_amdgcn_s_barrier()
#define PG8_SCHED __builtin_amdgcn_sched_barrier(0)
    Unit cur, nxt; int ui = 0;
    if (!S.next(0, cur)) return;
    f32x4 acc[2][2][4][2];
#pragma unroll
    for (int a = 0; a < 2; ++a)
#pragma unroll
        for (int b = 0; b < 2; ++b)
#pragma unroll
            for (int m = 0; m < 4; ++m)
#pragma unroll
                for (int n = 0; n < 2; ++n) acc[a][b][m][n] = (f32x4){0.f, 0.f, 0.f, 0.f};
    bf16x8 At[4][2], B0[2][2], B1[2][2];
    v8i At8[4], B08[2], B18[2];
    unsigned gC[2][2], gN[2][2];
    const char* cA = S.a_base(cur); const char* cB = S.b_base(cur);
    if (GATHER) { S.a_rows(cur, rowA, gC);
#pragma unroll
        for (int h = 0; h < 2; ++h)
#pragma unroll
            for (int i = 0; i < 2; ++i) gC[h][i] += voffA[i]; }
    PG8_STAGEB(PG8_SB(0, 0), cB); PG8_STAGEB(PG8_SB(0, 1), cB + hstep); PG8_STAGEA(PG8_SA(0, 0), cA, 0, gC); PG8_STAGEA(PG8_SA(0, 1), cA, 1, gC);
    if (wr == 1) PG8_BAR;
    PG8_WAIT_V(2); PG8_BAR;
    PG8_STAGEB(PG8_SB(1, 0), cB + kstep); PG8_STAGEA(PG8_SA(1, 0), cA + kstep, 0, gC); PG8_STAGEB(PG8_SB(1, 1), cB + hstep + kstep);
    PG8_WAIT_V(6); PG8_BAR;
    for (;;) {
        const bool has_next = S.next(ui + 1, nxt);
        const char* nA = has_next ? S.a_base(nxt) : cA; const char* nB = has_next ? S.b_base(nxt) : cB;
        if (GATHER) { if (has_next) { S.a_rows(nxt, rowA, gN);
#pragma unroll
                for (int h = 0; h < 2; ++h)
#pragma unroll
                    for (int i = 0; i < 2; ++i) gN[h][i] += voffA[i]; }
            else {
#pragma unroll
                for (int h = 0; h < 2; ++h)
#pragma unroll
                    for (int i = 0; i < 2; ++i) gN[h][i] = gC[h][i]; } }
        for (int t = 0; t < nt; t += 2) {
            const bool last = (t == nt - 2);
            const char* a1 = cA + (size_t)(t + 1) * kstep;
            const char* a2 = last ? nA : cA + (size_t)(t + 2) * kstep; const char* b2 = last ? nB : cB + (size_t)(t + 2) * kstep;
            const char* a3 = a2 + kstep; const char* b3 = b2 + kstep;
            unsigned g2[2][2];
            if (GATHER) {
#pragma unroll
                for (int h = 0; h < 2; ++h)
#pragma unroll
                    for (int i = 0; i < 2; ++i) g2[h][i] = last ? gN[h][i] : gC[h][i]; }
            if constexpr (!FP8) {
            PG8_LDB(B0, 0, 0); PG8_LDB(B1, 0, 1); PG8_SCHED; PG8_LDA(At, 0, 0); PG8_STAGEA(PG8_SA(1, 1), a1, 1, gC);
            PG8_WAIT_V(8); PG8_WAIT_L(0); PG8_BAR; PG8_MMA(0, 0, At, B0); PG8_MMA(0, 1, At, B1); PG8_BAR; PG8_SCHED;
            PG8_LDA(At, 0, 1); PG8_STAGEB(PG8_SB(0, 0), b2); PG8_STAGEB(PG8_SB(0, 1), b2 + hstep); PG8_STAGEA(PG8_SA(0, 0), a2, 0, g2);
            PG8_WAIT_V(8); PG8_WAIT_L(0); PG8_BAR; PG8_MMA(1, 0, At, B0); PG8_MMA(1, 1, At, B1); PG8_BAR; PG8_SCHED;
            PG8_LDB(B0, 1, 0); PG8_LDB(B1, 1, 1); PG8_SCHED; PG8_LDA(At, 1, 0); PG8_STAGEA(PG8_SA(0, 1), a2, 1, g2);
            PG8_WAIT_V(8); PG8_WAIT_L(0); PG8_BAR; PG8_MMA(0, 0, At, B0); PG8_MMA(0, 1, At, B1); PG8_BAR; PG8_SCHED;
            PG8_LDA(At, 1, 1); PG8_STAGEB(PG8_SB(1, 0), b3); PG8_STAGEB(PG8_SB(1, 1), b3 + hstep); PG8_STAGEA(PG8_SA(1, 0), a3, 0, g2);
            PG8_WAIT_V(8); PG8_WAIT_L(0); PG8_BAR; PG8_MMA(1, 0, At, B0); PG8_MMA(1, 1, At, B1); PG8_BAR; PG8_SCHED;
            } else {
            PG8_LDB8(B08, 0, 0); PG8_LDB8(B18, 0, 1); PG8_SCHED; PG8_LDA8(At8, 0, 0); PG8_STAGEA(PG8_SA(1, 1), a1, 1, gC);
            PG8_WAIT_V(8); PG8_WAIT_L(0); PG8_BAR; PG8_MMA8(0, 0, At8, B08); PG8_MMA8(0, 1, At8, B18); PG8_BAR; PG8_SCHED;
            PG8_LDA8(At8, 0, 1); PG8_STAGEB(PG8_SB(0, 0), b2); PG8_STAGEB(PG8_SB(0, 1), b2 + hstep); PG8_STAGEA(PG8_SA(0, 0), a2, 0, g2);
            PG8_WAIT_V(8); PG8_WAIT_L(0); PG8_BAR; PG8_MMA8(1, 0, At8, B08); PG8_MMA8(1, 1, At8, B18); PG8_BAR; PG8_SCHED;
            PG8_LDB8(B08, 1, 0); PG8_LDB8(B18, 1, 1); PG8_SCHED; PG8_LDA8(At8, 1, 0); PG8_STAGEA(PG8_SA(0, 1), a2, 1, g2);
            PG8_WAIT_V(8); PG8_WAIT_L(0); PG8_BAR; PG8_MMA8(0, 0, At8, B08); PG8_MMA8(0, 1, At8, B18); PG8_BAR; PG8_SCHED;
            PG8_LDA8(At8, 1, 1); PG8_STAGEB(PG8_SB(1, 0), b3); PG8_STAGEB(PG8_SB(1, 1), b3 + hstep); PG8_STAGEA(PG8_SA(1, 0), a3, 0, g2);
            PG8_WAIT_V(8); PG8_WAIT_L(0); PG8_BAR; PG8_MMA8(1, 0, At8, B08); PG8_MMA8(1, 1, At8, B18); PG8_BAR; PG8_SCHED;
            }
        }
        if constexpr (ALIGN_EPI) { if (wr == 0) PG8_BAR; }
        if constexpr (FP8) asm volatile("s_nop 15\n\ts_nop 15" ::: "memory");
        E(acc, cur, wr, wc, fr, fq);
        if (!has_next) break;
#pragma unroll
        for (int a = 0; a < 2; ++a)
#pragma unroll
            for (int b = 0; b < 2; ++b)
#pragma unroll
                for (int m = 0; m < 4; ++m)
#pragma unroll
                    for (int n = 0; n < 2; ++n) acc[a][b][m][n] = (f32x4){0.f, 0.f, 0.f, 0.f};
        cur = nxt; cA = nA; cB = nB; ++ui;
        if (GATHER) {
#pragma unroll
            for (int h = 0; h < 2; ++h)
#pragma unroll
                for (int i = 0; i < 2; ++i) gC[h][i] = gN[h][i]; }
        if constexpr (ALIGN_EPI) { if (wr == 1) PG8_BAR; }
    }
    PG8_WAIT_V(0);
    if constexpr (!ALIGN_EPI) { if (wr == 0) PG8_BAR; }
    PG8_BAR;
#undef PG8_SA
#undef PG8_SB
#undef PG8_STAGE2
#undef PG8_STAGEA
#undef PG8_STAGEB
#undef PG8_LDA
#undef PG8_LDB
#undef PG8_MMA
#undef PG8_LDA8
#undef PG8_LDB8
#undef PG8_MMA8
#undef PG8_WAIT_V
#undef PG8_WAIT_L
#undef PG8_BAR
#undef PG8_SCHED
}
}
using pg8::Unit;

struct DenseSched {
    const char* A; const char* Bt; int nM, nN, G, c; size_t tstep;
    __device__ __forceinline__ bool next(int i, Unit& u) const { return pg8::tile_order(i, G, c, nM, nN, u); }
    __device__ __forceinline__ const char* a_base(const Unit& u) const { return A + (size_t)u.pm * tstep; }
    __device__ __forceinline__ const char* b_base(const Unit& u) const { return Bt + (size_t)u.pn * tstep; }
    __device__ __forceinline__ void a_rows(const Unit&, const int (&)[2], unsigned (&)[2][2]) const {}
};
struct MoeSched {
    const char* A; const char* Wt; size_t estride; int nM, nN, G, c; size_t tstep;
    const volatile LAS int* bstart; const volatile LAS int* cnt; const int* list; int K2; bool gather;
    const volatile LAS unsigned char* blk_e;
    __device__ __forceinline__ int expert_of(int pm) const { return (int)blk_e[pm]; }
    __device__ __forceinline__ bool next(int i, Unit& u) const { return pg8::tile_order(i, G, c, nM, nN, u); }
    __device__ __forceinline__ const char* a_base(const Unit& u) const { return gather ? A : A + (size_t)u.pm * tstep; }
    __device__ __forceinline__ const char* b_base(const Unit& u) const { const int e = expert_of(u.pm); return Wt + (size_t)e * estride + (size_t)u.pn * tstep; }
    __device__ __forceinline__ void a_rows(const Unit& u, const int (&rowA)[2], unsigned (&o)[2][2]) const {
        const int e = expert_of(u.pm), rb = u.pm - bstart[e], n = cnt[e];
#pragma unroll
        for (int h = 0; h < 2; ++h)
#pragma unroll
            for (int i = 0; i < 2; ++i) { const int idx = rb * 256 + h * 128 + rowA[i]; int tok = 0; if (idx < n) tok = list[e * LCAP + idx] >> 2; o[h][i] = (unsigned)tok * (unsigned)K2; }
    }
};

struct EpiBf16 {
    static constexpr bool PERM = true;
    bf16_t* O; int ldc;
    __device__ __forceinline__ void operator()(const f32x4 (&acc)[2][2][4][2], const Unit& u, int wr, int wc, int fr, int fq) const {
        const int row0 = u.pm * 256 + wr * 64 + fr, col0 = u.pn * 256 + wc * 32 + 8 * fq;
#pragma unroll
        for (int ai = 0; ai < 2; ++ai)
#pragma unroll
            for (int m = 0; m < 4; ++m) { bf16_t* rowp = O + (size_t)(row0 + ai * 128 + m * 16) * ldc + col0;
#pragma unroll
                for (int bj = 0; bj < 2; ++bj) { const f32x4 v0 = acc[ai][bj][m][0], v1 = acc[ai][bj][m][1];
                    u32x4 w; w.x = pg8::cvt_pk_bf16(v0[0], v0[1]); w.y = pg8::cvt_pk_bf16(v0[2], v0[3]); w.z = pg8::cvt_pk_bf16(v1[0], v1[1]); w.w = pg8::cvt_pk_bf16(v1[2], v1[3]);
                    *(u32x4*)(rowp + bj * 128) = w; } }
    }
};
struct EpiResid {
    static constexpr bool PERM = false;
    const float* X; float* H; const float* mod; float* RSS;
    __device__ __forceinline__ void operator()(const f32x4 (&acc)[2][2][4][2], const Unit& u, int wr, int wc, int fr, int fq) const {
        const int b = (u.pm * 256) >> 11; const int col0 = u.pn * 256 + wc * 32 + 4 * fq;
        f32x4 gt[2][2];
#pragma unroll
        for (int bj = 0; bj < 2; ++bj)
#pragma unroll
            for (int n = 0; n < 2; ++n) gt[bj][n] = *(const f32x4*)(mod + b * 6144 + 2048 + col0 + bj * 128 + n * 16);
#pragma unroll
        for (int ai = 0; ai < 2; ++ai)
#pragma unroll
            for (int m = 0; m < 4; ++m) { const int row = u.pm * 256 + ai * 128 + wr * 64 + m * 16 + fr; const size_t off = (size_t)row * D + col0; float ss = 0.f;
#pragma unroll
                for (int bj = 0; bj < 2; ++bj)
#pragma unroll
                    for (int n = 0; n < 2; ++n) { const f32x4 xv = *(const f32x4*)(X + off + bj * 128 + n * 16); const f32x4 hv = xv + gt[bj][n] * acc[ai][bj][m][n];
                        *(f32x4*)(H + off + bj * 128 + n * 16) = hv; ss += (hv[0] * hv[0] + hv[1] * hv[1]) + (hv[2] * hv[2] + hv[3] * hv[3]); }
                ss += __shfl_xor(ss, 16); ss += __shfl_xor(ss, 32);
                if (fq == 0) RSS[(size_t)row * 16 + u.pn * 4 + wc] = ss; }
    }
};
template <bool OUT8> struct EpiSwiglu {
    static constexpr bool PERM = true;
    bf16_t* ACT; const float* b1; const MoeSched* S;
    __device__ __forceinline__ void operator()(const f32x4 (&acc)[2][2][4][2], const Unit& u, int wr, int wc, int fr, int fq) const {
        const int e = S->expert_of(u.pm);
        const int row0 = u.pm * 256 + wr * 64 + fr, col0 = u.pn * 256 + wc * 32 + 8 * fq;
        f32x4 bv[2][2];
#pragma unroll
        for (int bj = 0; bj < 2; ++bj)
#pragma unroll
            for (int n = 0; n < 2; ++n) bv[bj][n] = *(const f32x4*)(b1 + (size_t)e * 2048 + col0 + bj * 128 + 4 * n);
#pragma unroll
        for (int ai = 0; ai < 2; ++ai)
#pragma unroll
            for (int m = 0; m < 4; ++m) { bf16_t* rowp = ACT + (size_t)(row0 + ai * 128 + m * 16) * 1024 + (col0 >> 1);
#pragma unroll
                for (int bj = 0; bj < 2; ++bj) { float a[4];
#pragma unroll
                    for (int n = 0; n < 2; ++n) { const f32x4 v = acc[ai][bj][m][n] + bv[bj][n];
#pragma unroll
                        for (int p = 0; p < 2; ++p) { const float g = fminf(v[2 * p], 7.0f), l = fminf(fmaxf(v[2 * p + 1], -7.0f), 7.0f);
                            a[2 * n + p] = g * fast_sigmoid(1.702f * g) * (l + 1.0f); } }
                    if constexpr (OUT8) { *(unsigned*)((unsigned char*)ACT + (size_t)(row0 + ai * 128 + m * 16) * 1024 + (col0 >> 1) + bj * 64) = pk4_fp8(a[0], a[1], a[2], a[3]); }
                    else { u32x2 w; w.x = pg8::cvt_pk_bf16(a[0], a[1]); w.y = pg8::cvt_pk_bf16(a[2], a[3]); *(u32x2*)(rowp + bj * 64) = w; } } }
    }
};
struct EpiPair {
    static constexpr bool PERM = true;
    bf16_t* PAIR; const float* b2; const float* gate; const MoeSched* S;
    __device__ __forceinline__ void operator()(const f32x4 (&acc)[2][2][4][2], const Unit& u, int wr, int wc, int fr, int fq) const {
        const int e = S->expert_of(u.pm), rb = u.pm - S->bstart[e], n_e = S->cnt[e];
        const int col0 = u.pn * 256 + wc * 32 + 8 * fq;
        f32x4 bv[2][2];
#pragma unroll
        for (int bj = 0; bj < 2; ++bj)
#pragma unroll
            for (int n = 0; n < 2; ++n) bv[bj][n] = *(const f32x4*)(b2 + (size_t)e * 1024 + col0 + bj * 128 + 4 * n);
#pragma unroll
        for (int ai = 0; ai < 2; ++ai)
#pragma unroll
            for (int m = 0; m < 4; ++m) { const int idx = rb * 256 + ai * 128 + wr * 64 + m * 16 + fr;
                if (idx < n_e) { const int pair = S->list[e * LCAP + idx]; const float g = gate[pair]; bf16_t* rowp = PAIR + (size_t)pair * 1024 + col0;
#pragma unroll
                    for (int bj = 0; bj < 2; ++bj) { const f32x4 v0 = (acc[ai][bj][m][0] + bv[bj][0]) * g, v1 = (acc[ai][bj][m][1] + bv[bj][1]) * g;
                        u32x4 w; w.x = pg8::cvt_pk_bf16(v0[0], v0[1]); w.y = pg8::cvt_pk_bf16(v0[2], v0[3]); w.z = pg8::cvt_pk_bf16(v1[0], v1[1]); w.w = pg8::cvt_pk_bf16(v1[2], v1[3]);
                        *(u32x4*)(rowp + bj * 128) = w; } } }
    }
};

struct Args { const float* in[28]; float* out; unsigned char* ws; int ph_lo, ph_hi; };
enum { I_X = 0, I_C, I_ADAW, I_ADAB, I_N1G, I_WIN, I_CONVW, I_CONVGN, I_MU, I_W0, I_WUP, I_A0, I_AUP, I_GUP, I_KK, I_KA, I_RK, I_LNW, I_LNB, I_WOUT, I_N2G, I_RW, I_RB, I_W1, I_B1, I_W2, I_B2, I_FG };
constexpr int NWAVES = 8;
constexpr int LDS_TOTAL = 163840;
constexpr int LDS_MISC = LDS_TOTAL - 512;

__device__ __forceinline__ void p0_mod_unit(const Args& a, int u, LAS unsigned char* lds, int tid) {
    LAS float* cact = (LAS float*)lds; LAS float* red = (LAS float*)(lds + 65536);
    const float* c = a.in[I_C];
    for (int i = tid; i < 16 * 1024; i += 512) { const float v = c[i]; cact[i] = v * fast_sigmoid(v); }
    __syncthreads();
    const int kq = tid >> 5, col = tid & 31;
    float acc[16];
#pragma unroll
    for (int b = 0; b < 16; ++b) acc[b] = 0.f;
    const float* w = a.in[I_ADAW] + (size_t)(kq * 64) * 6144 + u * 32 + col;
#pragma unroll 4
    for (int k = 0; k < 64; ++k) { const float wv = w[(size_t)k * 6144];
#pragma unroll
        for (int b = 0; b < 16; ++b) acc[b] += cact[b * 1024 + kq * 64 + k] * wv; }
#pragma unroll
    for (int b = 0; b < 16; ++b) red[(kq * 16 + b) * 32 + col] = acc[b];
    __syncthreads();
    { const int b = tid >> 5; float s = a.in[I_ADAB][u * 32 + col];
#pragma unroll
      for (int q = 0; q < 16; ++q) s += red[(q * 16 + b) * 32 + col];
      ((float*)(a.ws + WS_MOD))[b * 6144 + u * 32 + col] = s; }
    __syncthreads();
}
__device__ __forceinline__ void tr_item64(const float* W, int ldw, bf16_t* WT, int ldt, int k0, int n0, LAS float* scr, int lane) {
    const int kr = lane >> 4, c4 = lane & 15;
    f32x4 v[16];
#pragma unroll
    for (int i = 0; i < 16; ++i) v[i] = *(const GAS f32x4*)(W + (size_t)(k0 + 4 * i + kr) * ldw + n0 + 4 * c4);
#pragma unroll
    for (int i = 0; i < 16; ++i) { LAS float* s = scr + (4 * i + kr) * 65 + 4 * c4; s[0] = v[i][0]; s[1] = v[i][1]; s[2] = v[i][2]; s[3] = v[i][3]; }
    LDS_WAIT(); asm volatile("" ::: "memory");
    const int c = lane & 7;
#pragma unroll
    for (int j = 0; j < 8; ++j) { const int n = (lane >> 3) + 8 * j; const LAS float* s = scr + (8 * c) * 65 + n;
        u32x4 o; o.x = pk2(s[0], s[65]); o.y = pk2(s[130], s[195]); o.z = pk2(s[260], s[325]); o.w = pk2(s[390], s[455]);
        *(GAS u32x4*)(WT + (size_t)(n0 + n) * ldt + k0 + 8 * c) = o; }
    LDS_WAIT(); asm volatile("" ::: "memory");
}
__device__ __forceinline__ void tr_item64_fp8(const float* W, int ldw, unsigned char* WT, int ldt, int k0, int n0, LAS float* scr, int lane) {
    const int kr = lane >> 4, c4 = lane & 15;
    f32x4 v[16];
#pragma unroll
    for (int i = 0; i < 16; ++i) v[i] = *(const GAS f32x4*)(W + (size_t)(k0 + 4 * i + kr) * ldw + n0 + 4 * c4);
#pragma unroll
    for (int i = 0; i < 16; ++i) { LAS float* s = scr + (4 * i + kr) * 65 + 4 * c4; s[0] = v[i][0]; s[1] = v[i][1]; s[2] = v[i][2]; s[3] = v[i][3]; }
    LDS_WAIT(); asm volatile("" ::: "memory");
    const int c = lane & 7;
#pragma unroll
    for (int j = 0; j < 8; ++j) { const int n = (lane >> 3) + 8 * j; const LAS float* s = scr + (8 * c) * 65 + n;
        u32x2 o; o.x = pk4_fp8(s[0], s[65], s[130], s[195]); o.y = pk4_fp8(s[260], s[325], s[390], s[455]);
        *(GAS u32x2*)(WT + (size_t)(n0 + n) * ldt + k0 + 8 * c) = o; }
    LDS_WAIT(); asm volatile("" ::: "memory");
}
__device__ __forceinline__ void tr_matrix_item(const float* W, int K, int N, bf16_t* WT, int item, LAS float* scr, int lane) {
    const int nb = N / 64; tr_item64(W, N, WT, K, (item / nb) * 64, (item % nb) * 64, scr, lane);
}
constexpr int TI_WIN = 16 * 52, TI_WOUT = 16 * 16, TI_UP = 8, TI_GUP = 16, TI_SMALL = TI_WIN + TI_WOUT + 2 * TI_UP + TI_GUP;
constexpr int TI_W1 = 16 * 32, TI_W2 = 16 * 16, TI_TOTAL = TI_SMALL + NE * (TI_W1 + TI_W2);
__device__ __forceinline__ void p0_phase(const Args& a, LAS unsigned char* lds, int tid, int wave, int lane, int vcu, int G) {
    if (blockIdx.x < 192) p0_mod_unit(a, blockIdx.x, lds, tid);
    else if (blockIdx.x < 256) { const int i = (blockIdx.x - 192) * 512 + tid, k = i >> 5, e = i & 31; const float w = a.in[I_RW][i];
        const unsigned hi = f2bf(w); const float lo = w - __builtin_bit_cast(float, hi << 16);
        bf16_t* rwh = (bf16_t*)(a.ws + WS_RWH); rwh[e * 1024 + k] = (bf16_t)hi; rwh[32 * 1024 + e * 1024 + k] = (bf16_t)f2bf(lo); }
    LAS float* scr = (LAS float*)(lds + wave * 16640);
    unsigned char* ws = a.ws;
    bf16_t* lora = (bf16_t*)(ws + WS_LORA);
    const int gw = vcu * NWAVES + wave, NGW = G * NWAVES;
    for (int it = gw; it < TI_SMALL; it += NGW) {
        int r = it;
        if (r < TI_WIN) { tr_matrix_item(a.in[I_WIN], 1024, NIN, (bf16_t*)(ws + WS_WIN), r, scr, lane); continue; } r -= TI_WIN;
        if (r < TI_WOUT) { tr_matrix_item(a.in[I_WOUT], 1024, 1024, (bf16_t*)(ws + WS_WOUT), r, scr, lane); continue; } r -= TI_WOUT;
        if (r < TI_UP) { tr_matrix_item(a.in[I_WUP], 64, 512, lora, r, scr, lane); continue; } r -= TI_UP;
        if (r < TI_UP) { tr_matrix_item(a.in[I_AUP], 64, 512, lora + 512 * 64, r, scr, lane); continue; } r -= TI_UP;
        tr_matrix_item(a.in[I_GUP], 128, 512, lora + 2 * 512 * 64, r, scr, lane);
    }
}
__device__ __forceinline__ void expert_transposes(const Args& a, LAS float* scr, int gw, int NGW, int lane) {
    unsigned char* ws = a.ws;
    for (int r = gw; r < NE * (TI_W1 + TI_W2); r += NGW) {
        if (r < NE * TI_W1) { const int e = r / TI_W1, it = r % TI_W1;
            if (FP8_G3) tr_item64_fp8(a.in[I_W1] + (size_t)e * 1024 * 2048, 2048, ws + WS_W1T + (size_t)e * 2048 * 1024, 1024, (it / 32) * 64, (it % 32) * 64, scr, lane);
            else tr_matrix_item(a.in[I_W1] + (size_t)e * 1024 * 2048, 1024, 2048, (bf16_t*)(ws + WS_W1T) + (size_t)e * 2048 * 1024, it, scr, lane); }
        else { const int q = r - NE * TI_W1; const int e = q / TI_W2, it = q % TI_W2;
            if (FP8_G4) tr_item64_fp8(a.in[I_W2] + (size_t)e * 1024 * 1024, 1024, ws + WS_W2T + (size_t)e * 1024 * 1024, 1024, (it / 16) * 64, (it % 16) * 64, scr, lane);
            else tr_matrix_item(a.in[I_W2] + (size_t)e * 1024 * 1024, 1024, 1024, (bf16_t*)(ws + WS_W2T) + (size_t)e * 1024 * 1024, it, scr, lane); }
    }
}

__device__ __forceinline__ void p1_phase(const Args& a, int wave, int lane, int vcu, int G) {
    const float* mod = (const float*)(a.ws + WS_MOD); bf16_t* U = (bf16_t*)(a.ws + WS_U);
    const int gw = vcu * NWAVES + wave, NGW = G * NWAVES;
    for (int row = gw; row < M; row += NGW) {
        const int b = row >> 11;
        const GAS f32x4* xr = (const GAS f32x4*)(a.in[I_X] + (size_t)row * D) + lane;
        f32x4 v[4]; float s = 0.f;
#pragma unroll
        for (int j = 0; j < 4; ++j) { v[j] = xr[64 * j]; s += (v[j][0] * v[j][0] + v[j][1] * v[j][1]) + (v[j][2] * v[j][2] + v[j][3] * v[j][3]); }
        const float inv = 1.0f / sqrtf(wave_sum(s) * (1.f / D) + NORM_EPS);
        GAS u32x2* o8 = (GAS u32x2*)(U + (size_t)row * D) + lane;
#pragma unroll
        for (int j = 0; j < 4; ++j) { const int col = 4 * lane + 256 * j;
            const f32x4 g = *(const f32x4*)(a.in[I_N1G] + col), sh = *(const f32x4*)(mod + b * 6144 + col), sc = *(const f32x4*)(mod + b * 6144 + 1024 + col);
            const f32x4 y = v[j] * inv * g * (sc + 1.0f) + sh;
            u32x2 w; w.x = pk2(y[0], y[1]); w.y = pk2(y[2], y[3]); o8[64 * j] = w; }
    }
}

__device__ __forceinline__ void p3_conv(const Args& a, int wave, int lane, int vcu, int G) {
    const bf16_t* P = (const bf16_t*)(a.ws + WS_PROJ); bf16_t* Y = (bf16_t*)(a.ws + WS_YMIX);
    const int gw = vcu * NWAVES + wave, NGW = G * NWAVES;
    const int c0 = 8 * lane;
    float w0[8], w1[8], w2[8], gn[8];
#pragma unroll
    for (int e = 0; e < 8; ++e) { w0[e] = a.in[I_CONVW][c0 + e]; w1[e] = a.in[I_CONVW][512 + c0 + e]; w2[e] = a.in[I_CONVW][1024 + c0 + e]; gn[e] = a.in[I_CONVGN][c0 + e]; }
    for (int row = gw; row < M; row += NGW) {
        const int t = row & (SEQ - 1);
        const bf16_t* pr = P + (size_t)row * NIN + c0;
        const u32x4 bg = *(const GAS u32x4*)(pr + COL_B), cg = *(const GAS u32x4*)(pr + COL_C), hg = *(const GAS u32x4*)(pr + COL_H);
        u32x4 c1 = (u32x4){0u, 0u, 0u, 0u}, h1 = c1, c2 = c1, h2 = c1;
        if (t >= 1) { c1 = *(const GAS u32x4*)(pr - NIN + COL_C); h1 = *(const GAS u32x4*)(pr - NIN + COL_H); }
        if (t >= 2) { c2 = *(const GAS u32x4*)(pr - 2 * NIN + COL_C); h2 = *(const GAS u32x4*)(pr - 2 * NIN + COL_H); }
        float y[8]; float ss = 0.f;
#pragma unroll
        for (int q = 0; q < 4; ++q) {
            const float u0l = bflo(cg[q]) * bflo(hg[q]), u0h = bfhi(cg[q]) * bfhi(hg[q]);
            const float u1l = bflo(c1[q]) * bflo(h1[q]), u1h = bfhi(c1[q]) * bfhi(h1[q]);
            const float u2l = bflo(c2[q]) * bflo(h2[q]), u2h = bfhi(c2[q]) * bfhi(h2[q]);
            const float yl = (w0[2 * q] * u2l + w1[2 * q] * u1l + w2[2 * q] * u0l) * bflo(bg[q]);
            const float yh = (w0[2 * q + 1] * u2h + w1[2 * q + 1] * u1h + w2[2 * q + 1] * u0h) * bfhi(bg[q]);
            y[2 * q] = yl; y[2 * q + 1] = yh; ss += yl * yl + yh * yh; }
        ss += __shfl_xor(ss, 1); ss += __shfl_xor(ss, 2); ss += __shfl_xor(ss, 4);
        const float rs = 1.0f / sqrtf(ss * (1.f / 64.f) + NORM_EPS);
        u32x4 o; o.x = pk2(y[0] * rs * gn[0], y[1] * rs * gn[1]); o.y = pk2(y[2] * rs * gn[2], y[3] * rs * gn[3]); o.z = pk2(y[4] * rs * gn[4], y[5] * rs * gn[5]); o.w = pk2(y[6] * rs * gn[6], y[7] * rs * gn[7]);
        *(GAS u32x4*)(Y + (size_t)row * D + c0) = o;
    }
}

__device__ __forceinline__ f32x16 zero16() { f32x16 z;
#pragma unroll
    for (int i = 0; i < 16; ++i) z[i] = 0.f; return z; }
__device__ __forceinline__ int tile_off(int t, int c) { return t * 128 + ((((c >> 3) ^ (t & 7))) << 4) + (c & 7) * 2; }
template <int KC> __device__ __forceinline__ void lora_mm(const LAS unsigned char* codes, int code_off, const bf16_t* WT, int h, int r32, int h2, f32x16 (&acc)[2]) {
    acc[0] = zero16(); acc[1] = zero16();
#pragma unroll
    for (int ks = 0; ks < KC / 16; ++ks) {
        const bf16x8 A = *(const LAS bf16x8*)(codes + r32 * 528 + (code_off + 16 * ks + 8 * h2) * 2);
#pragma unroll
        for (int ct = 0; ct < 2; ++ct) { const bf16x8 B = *(const GAS bf16x8*)(WT + (size_t)(h * 64 + 32 * ct + r32) * KC + 16 * ks + 8 * h2);
            acc[ct] = __builtin_amdgcn_mfma_f32_32x32x16_bf16(A, B, acc[ct], 0, 0, 0); }
    }
}
__device__ __forceinline__ void acc_to_cols(const f32x16 (&acc)[2], LAS float* SC, int lane, int r32, int h2, float (&x)[32]) {
#pragma unroll
    for (int ct = 0; ct < 2; ++ct)
#pragma unroll
        for (int q = 0; q < 4; ++q) *(LAS f32x4*)(SC + (32 * ct + r32) * 36 + 8 * q + 4 * h2) = (f32x4){acc[ct][4 * q], acc[ct][4 * q + 1], acc[ct][4 * q + 2], acc[ct][4 * q + 3]};
    LDS_WAIT(); asm volatile("" ::: "memory");
#pragma unroll
    for (int q = 0; q < 8; ++q) { const f32x4 v = *(const LAS f32x4*)(SC + lane * 36 + 4 * q); x[4 * q] = v[0]; x[4 * q + 1] = v[1]; x[4 * q + 2] = v[2]; x[4 * q + 3] = v[3]; }
    LDS_WAIT(); asm volatile("" ::: "memory");
}
__device__ __forceinline__ void st_frag(unsigned char* blk, int f, int lanepos, u32x4 v) { *(GAS u32x4*)(blk + f * 1024 + lanepos * 16) = v; }
__device__ __forceinline__ u32x4 tile_frag_pi(const LAS unsigned char* T, int t, int ks, int h2) {
    const u32x2 lo = *(const LAS u32x2*)(T + t * 128 + (((2 * ks) ^ (t & 7)) << 4) + 8 * h2);
    const u32x2 hi = *(const LAS u32x2*)(T + t * 128 + (((2 * ks + 1) ^ (t & 7)) << 4) + 8 * h2);
    return (u32x4){lo.x, lo.y, hi.x, hi.y};
}

__device__ __forceinline__ void p3_rwkv_group(const Args& a, int grp, LAS unsigned char* lds, int tid, int wave, int lane) {
    const int b = grp >> 6, ch = grp & 63, t0 = ch * CL; const size_t row0 = (size_t)b * SEQ + t0;
    const bf16_t* P = (const bf16_t*)(a.ws + WS_PROJ);
    LAS unsigned char* codes = lds + 131072;
    {
        const int t = tid >> 4, j0 = (tid & 15) * 16;
        const bf16_t* cur = P + (row0 + t) * NIN + COL_DW + j0;
        const u32x4 c0 = *(const GAS u32x4*)cur, c1 = *(const GAS u32x4*)(cur + 8);
        u32x4 p0 = (u32x4){0u, 0u, 0u, 0u}, p1 = p0;
        if (t0 + t > 0) { p0 = *(const GAS u32x4*)(cur - NIN); p1 = *(const GAS u32x4*)(cur - NIN + 8); }
        const float* mu = a.in[I_MU] + 1536 + j0;
        float o[16];
#pragma unroll
        for (int q = 0; q < 8; ++q) { const unsigned cw = q < 4 ? c0[q] : c1[q - 4], pw = q < 4 ? p0[q] : p1[q - 4];
            const float cl = bflo(cw), chh = bfhi(cw), pl = bflo(pw), ph = bfhi(pw);
            o[2 * q] = cl + (pl - cl) * mu[2 * q]; o[2 * q + 1] = chh + (ph - chh) * mu[2 * q + 1]; }
        if (j0 < 64) {
#pragma unroll
            for (int e = 0; e < 16; ++e) o[e] = 1.0f - 2.0f * __builtin_amdgcn_rcpf(1.0f + __expf(2.0f * o[e]));
        } else if (j0 >= 128) {
#pragma unroll
            for (int e = 0; e < 16; ++e) o[e] = fast_sigmoid(o[e]);
        }
        u32x4 w0, w1; w0.x = pk2(o[0], o[1]); w0.y = pk2(o[2], o[3]); w0.z = pk2(o[4], o[5]); w0.w = pk2(o[6], o[7]);
        w1.x = pk2(o[8], o[9]); w1.y = pk2(o[10], o[11]); w1.z = pk2(o[12], o[13]); w1.w = pk2(o[14], o[15]);
        *(LAS u32x4*)(codes + t * 528 + j0 * 2) = w0; *(LAS u32x4*)(codes + t * 528 + j0 * 2 + 16) = w1;
    }
    __syncthreads();
    const int h = wave, bh = b * 8 + h, hc = h * 64 + lane, r32 = lane & 31, h2 = lane >> 5;
    LAS unsigned char* wl = lds + wave * 16384;
    LAS float* SC = (LAS float*)wl;
    LAS unsigned char* T_A = wl, *T_B = wl + 4096, *T_K = wl + 8192, *T_R = wl + 12288;
    unsigned char* blk = a.ws + WS_CH + ((size_t)bh * NCH + ch) * CHB;
    const bf16_t* lora = (const bf16_t*)(a.ws + WS_LORA);
    f32x16 acc[2]; float x[32];
    const bf16_t* pr = P + row0 * NIN + COL_R + hc;
    unsigned short rr[8], rk_[8], rv[8];
#pragma unroll
    for (int i = 0; i < 8; ++i) { const bf16_t* p = pr + (size_t)i * NIN; rr[i] = p[0]; rk_[i] = p[512]; rv[i] = p[1024]; }
    lora_mm<128>(codes, 128, lora + 2 * 512 * 64, h, r32, h2, acc); acc_to_cols(acc, SC, lane, r32, h2, x);
    { bf16_t* Gp = (bf16_t*)(a.ws + WS_G) + ((size_t)bh * 64 + lane) * SEQ + t0;
#pragma unroll
      for (int q = 0; q < 4; ++q) { u32x4 w; w.x = pk2(x[8 * q], x[8 * q + 1]); w.y = pk2(x[8 * q + 2], x[8 * q + 3]); w.z = pk2(x[8 * q + 4], x[8 * q + 5]); w.w = pk2(x[8 * q + 6], x[8 * q + 7]); *(GAS u32x4*)(Gp + 8 * q) = w; } }
    float cum[32];
    lora_mm<64>(codes, 0, lora, h, r32, h2, acc); acc_to_cols(acc, SC, lane, r32, h2, x);
    { const float w0c = a.in[I_W0][hc]; float run = 0.f;
#pragma unroll
      for (int t = 0; t < 32; ++t) { run -= 0.6065306597f * fast_sigmoid(w0c + x[t]); cum[t] = run; } }
    lora_mm<64>(codes, 64, lora + 512 * 64, h, r32, h2, acc); acc_to_cols(acc, SC, lane, r32, h2, x);
    { const float a0c = a.in[I_A0][hc];
#pragma unroll
      for (int t = 0; t < 32; ++t) x[t] = fast_sigmoid(a0c + x[t]); }
    const float mur = a.in[I_MU][hc], muk = a.in[I_MU][512 + hc], muv = a.in[I_MU][1024 + hc];
    const float kkc = a.in[I_KK][hc], kac = a.in[I_KA][hc], rkc = a.in[I_RK][hc];
    float pr_r = 0.f, pr_k = 0.f, pr_v = 0.f;
    if (t0 > 0) { pr_r = bf2f(pr[-NIN]); pr_k = bf2f(pr[-NIN + 512]); pr_v = bf2f(pr[-NIN + 1024]); }
    unsigned vv2[16]; float bon = 0.f; float e_prev = 1.0f;
#pragma unroll
    for (int bi = 0; bi < 4; ++bi) {
        unsigned short nr[8], nk[8], nv[8];
        if (bi < 3) {
#pragma unroll
            for (int i = 0; i < 8; ++i) { const bf16_t* p = pr + (size_t)(8 * (bi + 1) + i) * NIN; nr[i] = p[0]; nk[i] = p[512]; nv[i] = p[1024]; }
        }
        asm volatile("" ::: "memory");
        float vprev = 0.f;
#pragma unroll
        for (int i = 0; i < 8; ++i) { const int t = 8 * bi + i;
            const float cr = bf2f(rr[i]), ck = bf2f(rk_[i]), cv = bf2f(rv[i]);
            const float r = cr + (pr_r - cr) * mur, k = ck + (pr_k - ck) * muk, v = cv + (pr_v - cv) * muv;
            pr_r = cr; pr_k = ck; pr_v = cv;
            const float kkr = k * kkc; const float nsq = wave_sum(kkr * kkr);
            const float kkn = kkr * __builtin_amdgcn_rsqf(fmaxf(nsq, 1e-24f));
            const float at = x[t];
            const float kp = k * (1.0f + (at - 1.0f) * kac);
            const float bs = wave_sum(r * kp * rkc);
            bon = (lane == t) ? bs : bon;
            const float e_cur = __expf(cum[t]), e_neg = __builtin_amdgcn_rcpf(e_cur);
            const float Ah = -kkn * e_prev, Bv = kkn * at * e_neg, Kv = kp * e_neg, Rh = r * e_cur;
            e_prev = e_cur;
            if (i & 1) vv2[t >> 1] = pk2(vprev, v); else vprev = v;
            const int to = tile_off(t, lane);
            *(LAS unsigned short*)(T_A + to) = (unsigned short)f2bf(Ah); *(LAS unsigned short*)(T_B + to) = (unsigned short)f2bf(Bv);
            *(LAS unsigned short*)(T_K + to) = (unsigned short)f2bf(Kv); *(LAS unsigned short*)(T_R + to) = (unsigned short)f2bf(Rh);
        }
        asm volatile("" ::: "memory");
        if (bi < 3) {
#pragma unroll
            for (int i = 0; i < 8; ++i) { rr[i] = nr[i]; rk_[i] = nk[i]; rv[i] = nv[i]; }
        }
    }
    { bf16_t* Vp = (bf16_t*)(a.ws + WS_V) + ((size_t)bh * 64 + lane) * SEQ + t0;
#pragma unroll
      for (int q = 0; q < 4; ++q) *(GAS u32x4*)(Vp + 8 * q) = (u32x4){vv2[4 * q], vv2[4 * q + 1], vv2[4 * q + 2], vv2[4 * q + 3]};
      if (lane < 32) ((float*)(a.ws + WS_BON))[(size_t)bh * SEQ + t0 + lane] = bon;
      *(GAS float*)(blk + CH_PL + lane * 4) = e_prev;
#pragma unroll
      for (int ks = 0; ks < 2; ++ks)
#pragma unroll
          for (int hh = 0; hh < 2; ++hh) { const int s0 = 16 * ks + 4 * hh, s1 = s0 + 8;
              st_frag(blk, 22 + 2 * h2 + ks, 32 * hh + r32, (u32x4){vv2[s0 >> 1], vv2[(s0 >> 1) + 1], vv2[s1 >> 1], vv2[(s1 >> 1) + 1]}); } }
    LDS_WAIT(); asm volatile("" ::: "memory");
    f32x16 ab = zero16(), ak = zero16(), rb = zero16(), rk = zero16();
#pragma unroll
    for (int ks = 0; ks < 4; ++ks) { const int fo = r32 * 128 + (((2 * ks + h2) ^ (r32 & 7)) << 4);
        const bf16x8 fa = *(const LAS bf16x8*)(T_A + fo), fb = *(const LAS bf16x8*)(T_B + fo), fk = *(const LAS bf16x8*)(T_K + fo), frr = *(const LAS bf16x8*)(T_R + fo);
        ab = __builtin_amdgcn_mfma_f32_32x32x16_bf16(fb, fa, ab, 0, 0, 0); ak = __builtin_amdgcn_mfma_f32_32x32x16_bf16(fk, fa, ak, 0, 0, 0);
        rb = __builtin_amdgcn_mfma_f32_32x32x16_bf16(fb, frr, rb, 0, 0, 0); rk = __builtin_amdgcn_mfma_f32_32x32x16_bf16(fk, frr, rk, 0, 0, 0); }
#pragma unroll
    for (int ks = 0; ks < 4; ++ks) st_frag(blk, 4 + ks, lane, tile_frag_pi(T_R, r32, ks, h2));
    { unsigned short tb[32], tk[32];
#pragma unroll
      for (int t = 0; t < 32; ++t) { const int to = tile_off(t, lane); tb[t] = *(const LAS unsigned short*)(T_B + to); tk[t] = *(const LAS unsigned short*)(T_K + to); }
#pragma unroll
      for (int ks = 0; ks < 2; ++ks)
#pragma unroll
          for (int hh = 0; hh < 2; ++hh) { const int s0 = 16 * ks + 4 * hh, s1 = s0 + 8; const int lp = 32 * hh + r32;
              u32x4 w; w.x = (unsigned)tb[s0] | ((unsigned)tb[s0 + 1] << 16); w.y = (unsigned)tb[s0 + 2] | ((unsigned)tb[s0 + 3] << 16); w.z = (unsigned)tb[s1] | ((unsigned)tb[s1 + 1] << 16); w.w = (unsigned)tb[s1 + 2] | ((unsigned)tb[s1 + 3] << 16);
              st_frag(blk, 14 + 4 * h2 + ks, lp, w);
              w.x = (unsigned)tk[s0] | ((unsigned)tk[s0 + 1] << 16); w.y = (unsigned)tk[s0 + 2] | ((unsigned)tk[s0 + 3] << 16); w.z = (unsigned)tk[s1] | ((unsigned)tk[s1 + 1] << 16); w.w = (unsigned)tk[s1 + 2] | ((unsigned)tk[s1 + 3] << 16);
              st_frag(blk, 14 + 4 * h2 + 2 + ks, lp, w); } }
    LDS_WAIT(); asm volatile("" ::: "memory");
#pragma unroll
    for (int ks = 0; ks < 2; ++ks) { float m[8], n[8];
#pragma unroll
        for (int j = 0; j < 8; ++j) { const int r = 8 * ks + j; const int s = (r & 3) + 8 * (r >> 2) + 4 * h2; m[j] = (s <= r32) ? rb[r] : 0.f; n[j] = (s <= r32) ? rk[r] : 0.f; }
        u32x4 w; w.x = pk2(m[0], m[1]); w.y = pk2(m[2], m[3]); w.z = pk2(m[4], m[5]); w.w = pk2(m[6], m[7]); st_frag(blk, 8 + ks, lane, w);
        w.x = pk2(n[0], n[1]); w.y = pk2(n[2], n[3]); w.z = pk2(n[4], n[5]); w.w = pk2(n[6], n[7]); st_frag(blk, 12 + ks, lane, w); }
    LAS float* F_AB = (LAS float*)T_B; LAS float* F_AK = (LAS float*)T_K;
#pragma unroll
    for (int q = 0; q < 4; ++q) { f32x4 u, w;
#pragma unroll
        for (int i = 0; i < 4; ++i) { const int s = 8 * q + 4 * h2 + i; u[i] = (s < r32) ? ab[4 * q + i] : 0.f; w[i] = (s < r32) ? ak[4 * q + i] : 0.f; }
        *(LAS f32x4*)(F_AB + r32 * 32 + 8 * q + 4 * h2) = u; *(LAS f32x4*)(F_AK + r32 * 32 + 8 * q + 4 * h2) = w; }
    LDS_WAIT(); asm volatile("" ::: "memory");
    float xs[32], m1[32];
#pragma unroll
    for (int t = 0; t < 32; ++t) { xs[t] = bf2f(*(const LAS unsigned short*)(T_A + tile_off(t, lane))); m1[t] = F_AK[t * 32 + r32]; }
    {
        f32x4 cfc[8], cfn[8];
        cfc[0] = *(const LAS f32x4*)(F_AB + 32);
#pragma unroll
        for (int t = 1; t < 32; ++t) {
            if (t < 31) {
#pragma unroll
                for (int q = 0; q < (t + 4) / 4; ++q) cfn[q] = *(const LAS f32x4*)(F_AB + (t + 1) * 32 + 4 * q);
            }
            asm volatile("" ::: "memory");
            float s1 = xs[t], s2 = m1[t];
#pragma unroll
            for (int q = 0; q < (t + 3) / 4; ++q) {
#pragma unroll
                for (int i = 0; i < 4; ++i) if (4 * q + i < t) { s1 += cfc[q][i] * xs[4 * q + i]; s2 += cfc[q][i] * m1[4 * q + i]; } }
            xs[t] = s1; m1[t] = s2;
            if (t < 31) {
#pragma unroll
                for (int q = 0; q < (t + 4) / 4; ++q) cfc[q] = cfn[q];
            }
            asm volatile("" : "+v"(xs[t]), "+v"(m1[t]));
        }
    }
    LDS_WAIT(); asm volatile("" ::: "memory");
    LAS unsigned char* T_M = T_A;
#pragma unroll
    for (int t = 0; t < 32; ++t) *(LAS unsigned short*)(T_R + tile_off(t, lane)) = (unsigned short)f2bf(xs[t]);
    if (lane < 32) {
#pragma unroll
        for (int t = 0; t < 32; ++t) *(LAS unsigned short*)(T_M + t * 64 + lane * 2) = (unsigned short)f2bf(m1[t]);
    }
    LDS_WAIT(); asm volatile("" ::: "memory");
#pragma unroll
    for (int ks = 0; ks < 4; ++ks) st_frag(blk, ks, lane, tile_frag_pi(T_R, r32, ks, h2));
#pragma unroll
    for (int ks = 0; ks < 2; ++ks) { const u32x2 lo = *(const LAS u32x2*)(T_M + r32 * 64 + (16 * ks + 4 * h2) * 2), hi = *(const LAS u32x2*)(T_M + r32 * 64 + (16 * ks + 8 + 4 * h2) * 2);
        st_frag(blk, 10 + ks, lane, (u32x4){lo.x, lo.y, hi.x, hi.y}); }
    LDS_WAIT(); asm volatile("" ::: "memory");
    __syncthreads();
}
__device__ __forceinline__ void p3_phase(const Args& a, LAS unsigned char* lds, int tid, int wave, int lane, int vcu, int G) {
    for (int grp = vcu; grp < BATCH * NCH; grp += G) p3_rwkv_group(a, grp, lds, tid, wave, lane);
    p3_conv(a, wave, lane, vcu, G);
}

__device__ __forceinline__ void p4_issue(const unsigned char* blkp, LAS unsigned char* slot, int nt, int lane) {
#pragma unroll
    for (int f = 0; f < 22; ++f) __builtin_amdgcn_global_load_lds((const unsigned*)(blkp + f * 1024 + lane * 16), (LAS unsigned*)(slot + f * 1024), 16, 0, 0);
#pragma unroll
    for (int f = 0; f < 2; ++f) __builtin_amdgcn_global_load_lds((const unsigned*)(blkp + (22 + 2 * nt + f) * 1024 + lane * 16), (LAS unsigned*)(slot + (22 + f) * 1024), 16, 0, 0);
    __builtin_amdgcn_global_load_lds((const unsigned*)(blkp + CH_PL + lane * 4), (LAS unsigned*)(slot + 24576), 4, 0, 0);
}
#define P4_FRAG(f) (*(const LAS bf16x8*)(base + (f) * 1024 + lane * 16))
__device__ __forceinline__ void p4_phase(const Args& a, LAS unsigned char* lds, int wave, int lane, int vcu, int G) {
    if (wave >= 2) { expert_transposes(a, (LAS float*)(lds + 57344 + (wave - 2) * 16640), vcu * 6 + (wave - 2), G * 6, lane); return; }
    if (wave != 0) return;
    const int w = blockIdx.x; if (w >= 2 * NBH) return;
    const int bh = w >> 1, nt = w & 1, r32 = lane & 31, h2 = lane >> 5;
    const unsigned char* blk0 = a.ws + WS_CH + (size_t)bh * NCH * CHB;
    float* OT = (float*)(a.ws + WS_OT) + ((size_t)bh * 64 + 32 * nt + r32) * SEQ;
    f32x16 S0 = zero16(), S1 = zero16();
    p4_issue(blk0, lds, nt, lane);
    for (int ci = 0; ci < NCH; ++ci) {
        VM_WAIT();
        if (ci + 1 < NCH) p4_issue(blk0 + (size_t)(ci + 1) * CHB, lds + ((ci + 1) & 1) * 28672, nt, lane);
        const LAS unsigned char* base = lds + (ci & 1) * 28672;
        const bf16x8 sb00 = pack8(S0[0], S0[1], S0[2], S0[3], S0[4], S0[5], S0[6], S0[7]), sb01 = pack8(S0[8], S0[9], S0[10], S0[11], S0[12], S0[13], S0[14], S0[15]);
        const bf16x8 sb10 = pack8(S1[0], S1[1], S1[2], S1[3], S1[4], S1[5], S1[6], S1[7]), sb11 = pack8(S1[8], S1[9], S1[10], S1[11], S1[12], S1[13], S1[14], S1[15]);
        const bf16x8 vt0 = P4_FRAG(22), vt1 = P4_FRAG(23);
        f32x16 U = zero16();
        U = __builtin_amdgcn_mfma_f32_32x32x16_bf16(P4_FRAG(0), sb00, U, 0, 0, 0); U = __builtin_amdgcn_mfma_f32_32x32x16_bf16(P4_FRAG(1), sb01, U, 0, 0, 0);
        U = __builtin_amdgcn_mfma_f32_32x32x16_bf16(P4_FRAG(2), sb10, U, 0, 0, 0); U = __builtin_amdgcn_mfma_f32_32x32x16_bf16(P4_FRAG(3), sb11, U, 0, 0, 0);
        U = __builtin_amdgcn_mfma_f32_32x32x16_bf16(P4_FRAG(10), vt0, U, 0, 0, 0); U = __builtin_amdgcn_mfma_f32_32x32x16_bf16(P4_FRAG(11), vt1, U, 0, 0, 0);
        f32x16 O = zero16();
        O = __builtin_amdgcn_mfma_f32_32x32x16_bf16(P4_FRAG(4), sb00, O, 0, 0, 0); O = __builtin_amdgcn_mfma_f32_32x32x16_bf16(P4_FRAG(5), sb01, O, 0, 0, 0);
        O = __builtin_amdgcn_mfma_f32_32x32x16_bf16(P4_FRAG(6), sb10, O, 0, 0, 0); O = __builtin_amdgcn_mfma_f32_32x32x16_bf16(P4_FRAG(7), sb11, O, 0, 0, 0);
        O = __builtin_amdgcn_mfma_f32_32x32x16_bf16(P4_FRAG(12), vt0, O, 0, 0, 0); O = __builtin_amdgcn_mfma_f32_32x32x16_bf16(P4_FRAG(13), vt1, O, 0, 0, 0);
        const bf16x8 ub0 = pack8(U[0], U[1], U[2], U[3], U[4], U[5], U[6], U[7]), ub1 = pack8(U[8], U[9], U[10], U[11], U[12], U[13], U[14], U[15]);
        O = __builtin_amdgcn_mfma_f32_32x32x16_bf16(P4_FRAG(8), ub0, O, 0, 0, 0); O = __builtin_amdgcn_mfma_f32_32x32x16_bf16(P4_FRAG(9), ub1, O, 0, 0, 0);
        S0 = __builtin_amdgcn_mfma_f32_32x32x16_bf16(P4_FRAG(14), ub0, S0, 0, 0, 0); S0 = __builtin_amdgcn_mfma_f32_32x32x16_bf16(P4_FRAG(15), ub1, S0, 0, 0, 0);
        S0 = __builtin_amdgcn_mfma_f32_32x32x16_bf16(P4_FRAG(16), vt0, S0, 0, 0, 0); S0 = __builtin_amdgcn_mfma_f32_32x32x16_bf16(P4_FRAG(17), vt1, S0, 0, 0, 0);
        S1 = __builtin_amdgcn_mfma_f32_32x32x16_bf16(P4_FRAG(18), ub0, S1, 0, 0, 0); S1 = __builtin_amdgcn_mfma_f32_32x32x16_bf16(P4_FRAG(19), ub1, S1, 0, 0, 0);
        S1 = __builtin_amdgcn_mfma_f32_32x32x16_bf16(P4_FRAG(20), vt0, S1, 0, 0, 0); S1 = __builtin_amdgcn_mfma_f32_32x32x16_bf16(P4_FRAG(21), vt1, S1, 0, 0, 0);
#pragma unroll
        for (int q = 0; q < 4; ++q) { const f32x4 p0 = *(const LAS f32x4*)(base + 24576 + (8 * q + 4 * h2) * 4), p1 = *(const LAS f32x4*)(base + 24576 + (32 + 8 * q + 4 * h2) * 4);
#pragma unroll
            for (int i = 0; i < 4; ++i) { S0[4 * q + i] *= p0[i]; S1[4 * q + i] *= p1[i]; }
            *(GAS f32x4*)(OT + ci * CL + 8 * q + 4 * h2) = (f32x4){O[4 * q], O[4 * q + 1], O[4 * q + 2], O[4 * q + 3]}; }
        LDS_WAIT();
    }
    VM_WAIT();
}

__device__ __forceinline__ void p5_phase(const Args& a, int wave, int lane, int vcu, int G) {
    const int gw = vcu * NWAVES + wave, NGW = G * NWAVES;
    const float* OT = (const float*)(a.ws + WS_OT); const bf16_t* Gb = (const bf16_t*)(a.ws + WS_G); const bf16_t* Vb = (const bf16_t*)(a.ws + WS_V);
    const float* BON = (const float*)(a.ws + WS_BON); bf16_t* Y = (bf16_t*)(a.ws + WS_YMIX);
    for (int un = gw; un < NBH * (SEQ / 64); un += NGW) {
        const int bh = un >> 5, tb = un & 31, t = tb * 64 + lane, b = bh >> 3, h = bh & 7;
        const size_t base = (size_t)bh * 64 * SEQ + t;
        const float o0 = OT[base]; float s = 0.f, q = 0.f;
#pragma unroll 16
        for (int nv = 0; nv < 64; ++nv) { const float d = OT[base + (size_t)nv * SEQ] - o0; s += d; q += d * d; }
        const float md = s * (1.f / 64.f), mean = o0 + md;
        const float rstd = 1.0f / sqrtf(fmaxf(q * (1.f / 64.f) - md * md, 0.f) + GN_EPS);
        const float bon = BON[(size_t)bh * SEQ + t];
        bf16_t* yp = Y + ((size_t)b * SEQ + t) * D + 512 + h * 64;
#pragma unroll 1
        for (int g8 = 0; g8 < 8; ++g8) { float y[8];
#pragma unroll
            for (int e = 0; e < 8; ++e) { const int nv = 8 * g8 + e; const float ov = OT[base + (size_t)nv * SEQ], v = bf2f(Vb[base + (size_t)nv * SEQ]), g = bf2f(Gb[base + (size_t)nv * SEQ]);
                y[e] = ((ov - mean) * rstd * a.in[I_LNW][h * 64 + nv] + a.in[I_LNB][h * 64 + nv] + bon * v) * g; }
            u32x4 w; w.x = pk2(y[0], y[1]); w.y = pk2(y[2], y[3]); w.z = pk2(y[4], y[5]); w.w = pk2(y[6], y[7]);
            *(GAS u32x4*)(yp + 8 * g8) = w; }
    }
}

__device__ __forceinline__ bool rt_better(float va, int ea, float vb, int eb) { return va > vb || (va == vb && ea < eb); }
__device__ __forceinline__ void p7_phase(const Args& a, LAS unsigned char* lds, int tid, int wave, int lane, int cw_cnt = CW_CNT) {
    LAS int* cntL = (LAS int*)lds;
    LAS int* baseL = cntL + 32;
    LAS int* rec = baseL + 32;
    const float* mod = (const float*)(a.ws + WS_MOD); bf16_t* U = (bf16_t*)(a.ws + WS_U);
    const float* H = a.out; const bf16_t* RWH = (const bf16_t*)(a.ws + WS_RWH);
    if (tid < 32) cntL[tid] = 0;
    __syncthreads();
    const int t = lane & 15, q = lane >> 4;
    const int row = blockIdx.x * 128 + wave * 16 + t, b = row >> 11;
    float inv;
    { const f32x4 p = *(const GAS f32x4*)((const float*)(a.ws + WS_RSS) + (size_t)row * 16 + 4 * q); float s = (p[0] + p[1]) + (p[2] + p[3]);
      s += __shfl_xor(s, 16); s += __shfl_xor(s, 32); inv = 1.0f / sqrtf(s * (1.f / D) + NORM_EPS); }
    const float* hp = H + (size_t)row * D + 8 * q; const float* gp = a.in[I_N2G] + 8 * q; const float* shp = mod + b * 6144 + 3072 + 8 * q; const float* scp = mod + b * 6144 + 4096 + 8 * q;
    bf16_t* up = U + (size_t)row * D + 8 * q; const bf16_t* wp = RWH + (size_t)t * 1024 + 8 * q;
    f32x4 acc0 = (f32x4){0.f, 0.f, 0.f, 0.f}, acc1 = acc0;
#pragma unroll 4
    for (int ks = 0; ks < 32; ++ks) {
        const int ko = 32 * ks;
        const f32x4 h0 = *(const GAS f32x4*)(hp + ko), h1 = *(const GAS f32x4*)(hp + ko + 4);
        const f32x4 g0 = *(const f32x4*)(gp + ko), g1 = *(const f32x4*)(gp + ko + 4), s0 = *(const f32x4*)(scp + ko), s1 = *(const f32x4*)(scp + ko + 4), b0 = *(const f32x4*)(shp + ko), b1 = *(const f32x4*)(shp + ko + 4);
        const bf16x8 ah0 = *(const GAS bf16x8*)(wp + ko), ah1 = *(const GAS bf16x8*)(wp + 16 * 1024 + ko), al0 = *(const GAS bf16x8*)(wp + 32 * 1024 + ko), al1 = *(const GAS bf16x8*)(wp + 48 * 1024 + ko);
        const f32x4 u0 = h0 * inv * g0 * (s0 + 1.0f) + b0, u1 = h1 * inv * g1 * (s1 + 1.0f) + b1;
        u32x4 hi; hi.x = pk2(u0[0], u0[1]); hi.y = pk2(u0[2], u0[3]); hi.z = pk2(u1[0], u1[1]); hi.w = pk2(u1[2], u1[3]);
        if (FP8_G3) { u32x2 w8; w8.x = pk4_fp8(u0[0], u0[1], u0[2], u0[3]); w8.y = pk4_fp8(u1[0], u1[1], u1[2], u1[3]); *(GAS u32x2*)((unsigned char*)U + (size_t)row * D + 8 * q + ko) = w8; }
        else *(GAS u32x4*)(up + ko) = hi;
        u32x4 lo; lo.x = pk2(u0[0] - bflo(hi.x), u0[1] - bfhi(hi.x)); lo.y = pk2(u0[2] - bflo(hi.y), u0[3] - bfhi(hi.y)); lo.z = pk2(u1[0] - bflo(hi.z), u1[1] - bfhi(hi.z)); lo.w = pk2(u1[2] - bflo(hi.w), u1[3] - bfhi(hi.w));
        const bf16x8 bh = __builtin_bit_cast(bf16x8, hi), bl = __builtin_bit_cast(bf16x8, lo);
        acc0 = __builtin_amdgcn_mfma_f32_16x16x32_bf16(ah0, bh, acc0, 0, 0, 0); acc0 = __builtin_amdgcn_mfma_f32_16x16x32_bf16(ah0, bl, acc0, 0, 0, 0); acc0 = __builtin_amdgcn_mfma_f32_16x16x32_bf16(al0, bh, acc0, 0, 0, 0);
        acc1 = __builtin_amdgcn_mfma_f32_16x16x32_bf16(ah1, bh, acc1, 0, 0, 0); acc1 = __builtin_amdgcn_mfma_f32_16x16x32_bf16(ah1, bl, acc1, 0, 0, 0); acc1 = __builtin_amdgcn_mfma_f32_16x16x32_bf16(al1, bh, acc1, 0, 0, 0);
    }
    float val[8]; int ex[8];
#pragma unroll
    for (int r = 0; r < 4; ++r) { ex[r] = 4 * q + r; ex[4 + r] = 16 + 4 * q + r; val[r] = acc0[r] + a.in[I_RB][4 * q + r]; val[4 + r] = acc1[r] + a.in[I_RB][16 + 4 * q + r]; }
    int ek[4]; float lk[4];
#pragma unroll
    for (int k = 0; k < 4; ++k) {
        float bv = val[0]; int be = ex[0];
#pragma unroll
        for (int r = 1; r < 8; ++r) if (rt_better(val[r], ex[r], bv, be)) { bv = val[r]; be = ex[r]; }
        { const float ov = __shfl_xor(bv, 16); const int oe = __shfl_xor(be, 16); if (rt_better(ov, oe, bv, be)) { bv = ov; be = oe; } }
        { const float ov = __shfl_xor(bv, 32); const int oe = __shfl_xor(be, 32); if (rt_better(ov, oe, bv, be)) { bv = ov; be = oe; } }
        ek[k] = be; lk[k] = bv;
#pragma unroll
        for (int r = 0; r < 8; ++r) if (ex[r] == be) val[r] = -INFINITY;
    }
    const float e1 = __expf(lk[1] - lk[0]), e2 = __expf(lk[2] - lk[0]), e3 = __expf(lk[3] - lk[0]); const float rs = 1.0f / (1.0f + e1 + e2 + e3);
    { const int e = q == 0 ? ek[0] : q == 1 ? ek[1] : q == 2 ? ek[2] : ek[3];
      const float g = (q == 0 ? 1.0f : q == 1 ? e1 : q == 2 ? e2 : e3) * rs;
      const int pos = atomicAdd((int*)&cntL[e], 1);
      LAS int* r = rec + ((wave * 16 + t) * 4 + q) * 3; r[0] = e; r[1] = pos; r[2] = __builtin_bit_cast(int, g); }
    __syncthreads();
    if (tid < 32) baseL[tid] = atomicAdd((int*)(a.ws + WS_CTL) + cw_cnt + tid, cntL[tid]);
    __syncthreads();
    { const LAS int* r = rec + tid * 3; const int e = r[0], slot = baseL[e] + r[1]; const int pair = (blockIdx.x * 128 + (tid >> 2)) * 4 + (tid & 3);
      ((int*)(a.ws + WS_LIST))[e * LCAP + slot] = pair; ((int*)(a.ws + WS_GATE))[pair] = r[2]; }
}

__device__ __forceinline__ void p10_phase(const Args& a, int wave, int lane, int vcu, int G, float* outp = nullptr) {
    const float* mod = (const float*)(a.ws + WS_MOD); const bf16_t* PAIR = (const bf16_t*)(a.ws + WS_PAIR);
    const int gw = vcu * NWAVES + wave, NGW = G * NWAVES;
    for (int row = gw; row < M; row += NGW) {
        const int b = row >> 11;
        GAS f32x4* hr = (GAS f32x4*)(a.out + (size_t)row * D) + lane; GAS f32x4* orow = outp ? (GAS f32x4*)(outp + (size_t)row * D) + lane : hr;
        const GAS u32x2* pp = (const GAS u32x2*)(PAIR + (size_t)row * 4 * D) + lane;
        f32x4 v[4]; float s = 0.f;
#pragma unroll
        for (int j = 0; j < 4; ++j) { const int col = 4 * lane + 256 * j; v[j] = hr[64 * j];
            f32x4 y = (f32x4){0.f, 0.f, 0.f, 0.f};
#pragma unroll
            for (int k = 0; k < 4; ++k) { const u32x2 w = pp[k * 256 + 64 * j]; y += (f32x4){bflo(w.x), bfhi(w.x), bflo(w.y), bfhi(w.y)}; }
            const f32x4 gt = *(const f32x4*)(mod + b * 6144 + 5120 + col);
            v[j] += gt * y; s += (v[j][0] * v[j][0] + v[j][1] * v[j][1]) + (v[j][2] * v[j][2] + v[j][3] * v[j][3]); }
        const float inv = 1.0f / sqrtf(wave_sum(s) * (1.f / D) + NORM_EPS);
#pragma unroll
        for (int j = 0; j < 4; ++j) { const f32x4 g = *(const f32x4*)(a.in[I_FG] + 4 * lane + 256 * j); orow[64 * j] = v[j] * inv * g; }
    }
}

constexpr int N_PHASES = 11;
__global__ void __launch_bounds__(NWAVES * 64, 2) hymba_fwd(Args a) {
    extern __shared__ __attribute__((aligned(16))) unsigned char lds_raw[];
    LAS unsigned char* lds = (LAS unsigned char*)lds_raw;
    volatile LAS unsigned* MISC = (volatile LAS unsigned*)(lds + LDS_MISC);
    const int tid = threadIdx.x, lane = tid & 63, wave = __builtin_amdgcn_readfirstlane(tid >> 6);
    const int G = gridDim.x; const int bx = blockIdx.x; const int vcu = (G % 8 == 0) ? (bx % 8) * (G / 8) + bx / 8 : bx;
    gu32* ctl = (gu32*)(a.ws + WS_CTL);
    if (tid < 128) MISC[tid] = 0u;
    __syncthreads();
    XcdBarrier bar; bar.bar = (unsigned*)(ctl + CW_BAR); bar.x = 0; bar.st = nullptr;
    if (MK_N_LAUNCHES == 1) bar = xcd_barrier_post((unsigned*)(ctl + CW_BAR), MISC + 8);
    const int lo = a.ph_lo, hi = a.ph_hi;
#ifndef PH_MASK
#define PH_MASK 0x7ff
#endif
#define IN(k) (((PH_MASK >> (k)) & 1) && lo <= (k) && (k) < hi)
#ifndef PROBE_DUP
#define PROBE_DUP -1
#endif
#define SEAM(k) do { if (IN(k) && IN((k) + 1)) xcd_barrier(bar); } while (0)
    if (IN(0)) { p0_phase(a, lds, tid, wave, lane, vcu, G); }
#if PROBE_DUP == 0
    __syncthreads();
    if (IN(0)) { p0_phase(a, lds, tid, wave, lane, vcu, G); }
#endif
    SEAM(0);
    if (IN(1)) { p1_phase(a, wave, lane, vcu, G); }
#if PROBE_DUP == 1
    if (IN(1)) { p1_phase(a, wave, lane, vcu, G); }
#endif
    SEAM(1);
    if (IN(2)) {
        DenseSched S{(const char*)(a.ws + WS_U), (const char*)(a.ws + WS_WIN), M / 256, NIN / 256, G, bx, (size_t)256 * 1024 * 2};
        EpiBf16 E{(bf16_t*)(a.ws + WS_PROJ), NIN};
        pg8::gemm_phase<EpiBf16, DenseSched, false, true>(lds, 1024, S, E);
    }
#if PROBE_DUP == 2
    if (IN(2)) {
        DenseSched S{(const char*)(a.ws + WS_U), (const char*)(a.ws + WS_WIN), M / 256, NIN / 256, G, bx, (size_t)256 * 1024 * 2};
        EpiBf16 E{(bf16_t*)(a.ws + WS_PROJ), NIN};
        pg8::gemm_phase<EpiBf16, DenseSched, false, true>(lds, 1024, S, E);
    }
#endif
    SEAM(2);
    if (IN(3)) { p3_phase(a, lds, tid, wave, lane, vcu, G); }
#if PROBE_DUP == 3
    if (IN(3)) { p3_phase(a, lds, tid, wave, lane, vcu, G); }
#endif
    SEAM(3);
    if (IN(4)) { p4_phase(a, lds, wave, lane, vcu, G); }
#if PROBE_DUP == 4
    if (IN(4)) { p4_phase(a, lds, wave, lane, vcu, G); }
#endif
    SEAM(4);
    if (IN(5)) { p5_phase(a, wave, lane, vcu, G); }
#if PROBE_DUP == 5
    if (IN(5)) { p5_phase(a, wave, lane, vcu, G); }
#endif
    SEAM(5);
    if (IN(6)) {
        DenseSched S{(const char*)(a.ws + WS_YMIX), (const char*)(a.ws + WS_WOUT), M / 256, D / 256, G, bx, (size_t)256 * 1024 * 2};
        EpiResid E{a.in[I_X], a.out, (const float*)(a.ws + WS_MOD), (float*)(a.ws + WS_RSS)};
        pg8::gemm_phase<EpiResid, DenseSched, false, true>(lds, 1024, S, E);
    }
#if PROBE_DUP == 6
    if (IN(6)) {
        DenseSched S{(const char*)(a.ws + WS_YMIX), (const char*)(a.ws + WS_WOUT), M / 256, D / 256, G, bx, (size_t)256 * 1024 * 2};
        EpiResid E{a.in[I_X], a.out, (const float*)(a.ws + WS_MOD), (float*)(a.ws + WS_RSS)};
        pg8::gemm_phase<EpiResid, DenseSched, false, true>(lds, 1024, S, E);
    }
#endif
    SEAM(6);
#if PROBE_DUP == 7
    if (IN(7)) { p7_phase(a, lds, tid, wave, lane, CW_CNT + 1024); __syncthreads(); }
#endif
    if (IN(7)) { p7_phase(a, lds, tid, wave, lane); }
    SEAM(7);
    volatile LAS int* bstart = (volatile LAS int*)(lds + LDS_MISC + 128);
    volatile LAS int* ecnt = bstart + 40;
    volatile LAS unsigned char* blk_e = (volatile LAS unsigned char*)(lds + LDS_MISC - 1024);
    if (IN(8) || IN(9)) {
        if (tid == 0) { int s = 0; for (int e = 0; e < NE; ++e) { const int c = (int)__hip_atomic_load(ctl + CW_CNT + e, RLX_AGENT); ecnt[e] = c; bstart[e] = s; s += (c + 255) >> 8; } bstart[NE] = s; }
        __syncthreads();
        for (int pm = tid; pm < bstart[NE]; pm += NWAVES * 64) { int e = 0; for (int j = 1; j < NE; ++j) e += (bstart[j] <= pm) ? 1 : 0; blk_e[pm] = (unsigned char)e; }
        __syncthreads();
    }
    if (IN(8)) {
        constexpr int EB = FP8_G3 ? 1 : 2;
        MoeSched S{(const char*)(a.ws + WS_U), (const char*)(a.ws + WS_W1T), (size_t)2048 * 1024 * EB, bstart[NE], 8, G, bx, (size_t)256 * 1024 * EB, bstart, ecnt, (const int*)(a.ws + WS_LIST), 1024 * EB, true, blk_e};
        EpiSwiglu<FP8_G4 != 0> E{(bf16_t*)(a.ws + WS_ACT), a.in[I_B1], &S};
        pg8::gemm_phase<EpiSwiglu<FP8_G4 != 0>, MoeSched, true, true, FP8_G3 != 0>(lds, 512 * EB, S, E);
    }
#if PROBE_DUP == 8
    if (IN(8)) {
        constexpr int EB = FP8_G3 ? 1 : 2;
        MoeSched S{(const char*)(a.ws + WS_U), (const char*)(a.ws + WS_W1T), (size_t)2048 * 1024 * EB, bstart[NE], 8, G, bx, (size_t)256 * 1024 * EB, bstart, ecnt, (const int*)(a.ws + WS_LIST), 1024 * EB, true, blk_e};
        EpiSwiglu<FP8_G4 != 0> E{(bf16_t*)(a.ws + WS_ACT), a.in[I_B1], &S};
        pg8::gemm_phase<EpiSwiglu<FP8_G4 != 0>, MoeSched, true, true, FP8_G3 != 0>(lds, 512 * EB, S, E);
    }
#endif
    SEAM(8);
    if (IN(9)) {
        constexpr int EB = FP8_G4 ? 1 : 2;
        MoeSched S{(const char*)(a.ws + WS_ACT), (const char*)(a.ws + WS_W2T), (size_t)1024 * 1024 * EB, bstart[NE], 4, G, bx, (size_t)256 * 1024 * EB, bstart, ecnt, (const int*)(a.ws + WS_LIST), 1024 * EB, false, blk_e};
        EpiPair E{(bf16_t*)(a.ws + WS_PAIR), a.in[I_B2], (const float*)(a.ws + WS_GATE), &S};
        pg8::gemm_phase<EpiPair, MoeSched, false, true, FP8_G4 != 0>(lds, 512 * EB, S, E);
    }
#if PROBE_DUP == 9
    if (IN(9)) {
        constexpr int EB = FP8_G4 ? 1 : 2;
        MoeSched S{(const char*)(a.ws + WS_ACT), (const char*)(a.ws + WS_W2T), (size_t)1024 * 1024 * EB, bstart[NE], 4, G, bx, (size_t)256 * 1024 * EB, bstart, ecnt, (const int*)(a.ws + WS_LIST), 1024 * EB, false, blk_e};
        EpiPair E{(bf16_t*)(a.ws + WS_PAIR), a.in[I_B2], (const float*)(a.ws + WS_GATE), &S};
        pg8::gemm_phase<EpiPair, MoeSched, false, true, FP8_G4 != 0>(lds, 512 * EB, S, E);
    }
#endif
    SEAM(9);
#if PROBE_DUP == 10
    if (IN(10)) { p10_phase(a, wave, lane, vcu, G, (float*)(a.ws + WS_U)); }
#endif
    if (IN(10)) { p10_phase(a, wave, lane, vcu, G); }
#undef IN
#undef SEAM
}

extern "C" void kernel_launch(void* const* d_in, const int* in_sizes, int n_in, void* d_out, int out_size, void* d_ws, size_t ws_size, hipStream_t stream) {
    static int grid = 0;
    if (grid == 0) {
        if (n_in != 28 || in_sizes[0] != M * D || out_size != M * D || ws_size < WS_END) { fprintf(stderr, "kernel_launch: unexpected shapes / workspace (n_in %d, ws %zu)\n", n_in, ws_size); grid = -1; return; }
        int dev = 0, cus = 0;
        if (hipGetDevice(&dev) != hipSuccess || hipDeviceGetAttribute(&cus, hipDeviceAttributeMultiprocessorCount, dev) != hipSuccess) { grid = -1; return; }
        if (hipFuncSetAttribute((const void*)hymba_fwd, hipFuncAttributeMaxDynamicSharedMemorySize, LDS_TOTAL) != hipSuccess) { fprintf(stderr, "kernel_launch: hipFuncSetAttribute failed\n"); grid = -1; return; }
        (void)hipGetLastError();
        grid = cus;
        if (grid != 256) fprintf(stderr, "kernel_launch: %d CUs (built for 256)\n", grid);
    }
    if (grid < 0) return;
    if (hipMemsetAsync((char*)d_ws + WS_CTL, 0, CTL_ZERO_BYTES, stream) != hipSuccess) return;
    Args a{};
    for (int i = 0; i < 28; ++i) a.in[i] = (const float*)d_in[i];
    a.out = (float*)d_out; a.ws = (unsigned char*)d_ws;
#if MK_N_LAUNCHES == 1
    a.ph_lo = 0; a.ph_hi = N_PHASES;
    hipLaunchKernelGGL(hymba_fwd, dim3(grid), dim3(NWAVES * 64), LDS_TOTAL, stream, a);
#else
    for (int p = 0; p < N_PHASES; ++p) { a.ph_lo = p; a.ph_hi = p + 1; hipLaunchKernelGGL(hymba_fwd, dim3(grid), dim3(NWAVES * 64), LDS_TOTAL, stream, a); }
#endif
}
```

```cpp
#include <hip/hip_runtime.h>
#include <cstdio>
#include <cstdint>

#ifndef MK_N_LAUNCHES
#define MK_N_LAUNCHES 1
#endif

#ifndef FP8_G3
#define FP8_G3 1
#endif
#ifndef FP8_G4
#define FP8_G4 1
#endif
#define LAS __attribute__((address_space(3)))
#define GAS __attribute__((address_space(1)))
typedef unsigned short bf16_t;
typedef short bf16x8 __attribute__((ext_vector_type(8)));
typedef float f32x4 __attribute__((ext_vector_type(4)));
typedef float f32x16 __attribute__((ext_vector_type(16)));
typedef float f32x2 __attribute__((ext_vector_type(2)));
typedef unsigned u32x4 __attribute__((ext_vector_type(4)));
typedef int v8i __attribute__((ext_vector_type(8)));
typedef unsigned u32x2 __attribute__((ext_vector_type(2)));
typedef GAS unsigned gu32;
#define RLX_AGENT __ATOMIC_RELAXED, __HIP_MEMORY_SCOPE_AGENT
#define LDS_WAIT() asm volatile("s_waitcnt lgkmcnt(0)" ::: "memory")
#define VM_WAIT() asm volatile("s_waitcnt vmcnt(0)" ::: "memory")

constexpr int D = 1024, BATCH = 16, SEQ = 2048, M = BATCH * SEQ;
constexpr int NIN = 3328;
constexpr int COL_B = 0, COL_C = 512, COL_H = 1024, COL_R = 1536, COL_K = 2048, COL_V = 2560, COL_DW = 3072;
constexpr int NE = 32, LCAP = 32768;
constexpr int CL = 32, NCH = SEQ / CL;
constexpr int NBH = BATCH * 8;
constexpr float NORM_EPS = 1e-5f, GN_EPS = 64e-5f;
constexpr int CHB = 27648;
constexpr int CH_PL = 26624;

constexpr size_t MiB = 1u << 20;
constexpr size_t WS_CTL = 0, CTL_ZERO_BYTES = 64 * 1024;
constexpr size_t WS_MOD = 1 * MiB;
constexpr size_t WS_LORA = 2 * MiB;
constexpr size_t WS_RWH = 2 * MiB + 512 * 1024;
constexpr size_t WS_WOUT = 3 * MiB;
constexpr size_t WS_WIN = 5 * MiB;
constexpr size_t WS_LIST = 12 * MiB;
constexpr size_t WS_W1T = 24 * MiB;
constexpr size_t WS_W2T = 152 * MiB;
constexpr size_t WS_U = 216 * MiB;
constexpr size_t WS_YMIX = 280 * MiB;
constexpr size_t WS_PROJ = 344 * MiB;
constexpr size_t WS_CH = 552 * MiB;
constexpr size_t WS_OT = 768 * MiB;
constexpr size_t WS_G = 832 * MiB;
constexpr size_t WS_V = 864 * MiB;
constexpr size_t WS_BON = 896 * MiB;
constexpr size_t WS_RSS = 897 * MiB;
constexpr size_t WS_ACT = 344 * MiB;
constexpr size_t WS_PAIR = 616 * MiB;
constexpr size_t WS_END = 900 * MiB;
constexpr int CW_TMO = 0;
constexpr int CW_CNT = 64;
constexpr int CW_BAR = 4096;

constexpr int RING_BYTES = 131072;
constexpr int MISC_OFF = 144 * 1024;
constexpr int LDS_BYTES = 147456;

__device__ __forceinline__ unsigned f2bf(float f) { unsigned u = __builtin_bit_cast(unsigned, f); return (u + 0x7fffu + ((u >> 16) & 1u)) >> 16; }
__device__ __forceinline__ unsigned pk2(float lo, float hi) { return f2bf(lo) | (f2bf(hi) << 16); }
__device__ __forceinline__ unsigned pk4_fp8(float a, float b, float c, float d) {
    int r = __builtin_amdgcn_cvt_pk_fp8_f32(a, b, 0, false); r = __builtin_amdgcn_cvt_pk_fp8_f32(c, d, r, true); return (unsigned)r; }
__device__ __forceinline__ float bf2f(unsigned short h) { return __builtin_bit_cast(float, (unsigned)h << 16); }
__device__ __forceinline__ float bflo(unsigned w) { return __builtin_bit_cast(float, w << 16); }
__device__ __forceinline__ float bfhi(unsigned w) { return __builtin_bit_cast(float, w & 0xffff0000u); }
#define DPP_QP1 0xB1
#define DPP_QP2 0x4E
#define DPP_HMIR 0x141
#define DPP_MIR 0x140
#define DPP_BC15 0x142
#define DPP_BC31 0x143
#define dpp_f(old, v, ctrl, rmask) __builtin_bit_cast(float, __builtin_amdgcn_update_dpp(__builtin_bit_cast(int, (float)(old)), __builtin_bit_cast(int, (float)(v)), ctrl, rmask, 0xf, false))
__device__ __forceinline__ float wave_sum(float v) {
    v += dpp_f(0.f, v, DPP_QP1, 0xf); v += dpp_f(0.f, v, DPP_QP2, 0xf); v += dpp_f(0.f, v, DPP_HMIR, 0xf); v += dpp_f(0.f, v, DPP_MIR, 0xf);
    v += dpp_f(0.f, v, DPP_BC15, 0xa); v += dpp_f(0.f, v, DPP_BC31, 0xc);
    return __builtin_bit_cast(float, __builtin_amdgcn_readlane(__builtin_bit_cast(int, v), 63));
}
__device__ __forceinline__ float wave_max(float v) {
    const float ninf = -INFINITY;
    v = fmaxf(v, dpp_f(ninf, v, DPP_QP1, 0xf)); v = fmaxf(v, dpp_f(ninf, v, DPP_QP2, 0xf)); v = fmaxf(v, dpp_f(ninf, v, DPP_HMIR, 0xf)); v = fmaxf(v, dpp_f(ninf, v, DPP_MIR, 0xf));
    v = fmaxf(v, dpp_f(ninf, v, DPP_BC15, 0xa)); v = fmaxf(v, dpp_f(ninf, v, DPP_BC31, 0xc));
    return __builtin_bit_cast(float, __builtin_amdgcn_readlane(__builtin_bit_cast(int, v), 63));
}
__device__ __forceinline__ float fast_sigmoid(float x) { return __builtin_amdgcn_rcpf(1.0f + __expf(-x)); }
__device__ __forceinline__ bf16x8 pack8(float a0, float a1, float a2, float a3, float a4, float a5, float a6, float a7) {
    u32x4 w; w.x = pk2(a0, a1); w.y = pk2(a2, a3); w.z = pk2(a4, a5); w.w = pk2(a6, a7); return __builtin_bit_cast(bf16x8, w);
}

#define XB_TMO      128
#define XB_XCNT(j)  (256  + 64 * (j))
#define XB_XSUB(j)  (1280 + 64 * (j))
#define XB_XGEN(j)  (2304 + 64 * (j))
#define XB_TOP      3328
#define XB_TOPGEN   3392
#define XCD_BAR_WORDS 3456
#define XB_SPIN_CAP (1u << 20)
__device__ __forceinline__ unsigned xb_ld(unsigned* p)              { return __hip_atomic_load(p, __ATOMIC_RELAXED, __HIP_MEMORY_SCOPE_AGENT); }
__device__ __forceinline__ unsigned xb_add(unsigned* p, unsigned v) { return __hip_atomic_fetch_add(p, v, __ATOMIC_RELAXED, __HIP_MEMORY_SCOPE_AGENT); }
__device__ __forceinline__ unsigned xb_xcc_id() { return (unsigned)__builtin_amdgcn_s_getreg((3 << 11) | 20) & 0xFu; }
#define XB_SPIN(cond, bar) do { unsigned _sp = 0; while (cond) { __builtin_amdgcn_s_sleep(1); \
    if ((++_sp & 255u) == 0u) { if (xb_ld(&(bar)[XB_TMO])) break; if (_sp > XB_SPIN_CAP) { atomicAdd(&(bar)[XB_TMO], 1u); break; } } } } while (0)
struct XcdBarrier { unsigned* bar; unsigned x; volatile LAS unsigned* st; };
__device__ __forceinline__ XcdBarrier xcd_barrier_post(unsigned* bar, volatile LAS unsigned* st) {
    XcdBarrier b; b.bar = bar; b.x = xb_xcc_id(); b.st = st;
    if (threadIdx.x == 0) (void)xb_add(&bar[XB_XCNT(b.x)], 1u);
    return b;
}
__device__ __forceinline__ void xcd_barrier_complete(unsigned* bar, unsigned x, unsigned& nloc, unsigned& nx) {
    const unsigned G = gridDim.x * gridDim.y * gridDim.z;
    unsigned sum, cnt, mine, sp = 0u;
    for (;;) {
        sum = 0u; cnt = 0u; mine = 0u;
#pragma unroll
        for (unsigned j = 0; j < 16; ++j) { const unsigned c = xb_ld(&bar[XB_XCNT(j)]); sum += c; cnt += (c > 0u) ? 1u : 0u; mine = (j == x) ? c : mine; }
        if (sum == G) break;
        __builtin_amdgcn_s_sleep(1);
        if ((++sp & 255u) == 0u) { if (xb_ld(&bar[XB_TMO])) break; if (sp > XB_SPIN_CAP) { atomicAdd(&bar[XB_TMO], 1u); break; } }
    }
    nloc = mine > 0u ? mine : 1u; nx = cnt > 0u ? cnt : 1u;
}
__device__ __forceinline__ void xcd_barrier(const XcdBarrier& b) {
    asm volatile("s_waitcnt vmcnt(0)" ::: "memory");
    __syncthreads();
    if (threadIdx.x == 0) {
        unsigned* bar = b.bar;
        __builtin_amdgcn_s_waitcnt(0);
        unsigned nloc = b.st[0], nx = b.st[1];
        if (nloc == 0u) { xcd_barrier_complete(bar, b.x, nloc, nx); b.st[0] = nloc; b.st[1] = nx; }
        const unsigned old = xb_add(&bar[XB_XSUB(b.x)], 1u);
        const unsigned gen = old / nloc;
        if (old + 1u == (gen + 1u) * nloc) {
            __builtin_amdgcn_fence(__ATOMIC_RELEASE, "agent");
            asm volatile("s_waitcnt vmcnt(0)" ::: "memory");
            const unsigned og = xb_add(&bar[XB_TOP], 1u);
            const unsigned tg = og / nx;
            if (og + 1u == (tg + 1u) * nx) xb_add(&bar[XB_TOPGEN], 1u);
            else XB_SPIN(xb_ld(&bar[XB_TOPGEN]) == tg, bar);
            __builtin_amdgcn_fence(__ATOMIC_ACQUIRE, "agent");
            xb_add(&bar[XB_XGEN(b.x)], 1u);
            asm volatile("s_waitcnt vmcnt(0)" ::: "memory");
        } else {
            XB_SPIN(xb_ld(&bar[XB_XGEN(b.x)]) == gen, bar);
            __builtin_amdgcn_fence(__ATOMIC_ACQUIRE, "agent");
            asm volatile("s_waitcnt vmcnt(0)" ::: "memory");
        }
    }
    __syncthreads();
}

namespace pg8 {
constexpr int BM = 256, BK = 64, HALF = 128, HTB = HALF * BK * 2, NXCD = 8, WGM = 8;
__host__ __device__ __forceinline__ int lds_byte(int r, int c) { const int st = (r >> 4) * 2 + (c >> 5), rr = r & 15, cc = c & 31, ob = rr * 64 + cc * 2; return st * 1024 + (ob ^ (((ob >> 9) & 1) << 5)); }
__host__ __device__ __forceinline__ void stage_rc(int b, int& R, int& C) { const int st = b / 1024, sb = b % 1024, swz = sb ^ (((sb >> 9) & 1) << 5); R = (st >> 1) * 16 + swz / 64; C = (st & 1) * 32 + (swz % 64) / 2; }
__host__ __device__ __forceinline__ int perm32(int rho) { const int n = rho >> 4, i = rho & 15; return 8 * (i >> 2) + 4 * n + (i & 3); }
struct Unit { int pm, pn; };
__device__ __forceinline__ bool tile_order(int i, int G, int c, int nM, int nN, Unit& u) {
    const int nwg = nM * nN; const long L = (long)i * G + c; if (L >= nwg) return false;
    int wgid = (int)L; { const int q = nwg / NXCD, r = nwg % NXCD, xcd = wgid % NXCD, off = wgid / NXCD; wgid = (xcd < r ? xcd * (q + 1) : r * (q + 1) + (xcd - r) * q) + off; }
    const int nig = WGM * nN, gid = wgid / nig, fm = gid * WGM, gsz = (nM - fm) < WGM ? (nM - fm) : WGM;
    u.pm = fm + ((wgid % nig) % gsz); u.pn = (wgid % nig) / gsz; return true;
}
__device__ __forceinline__ unsigned cvt_pk_bf16(float lo, float hi) { unsigned r; asm volatile("v_cvt_pk_bf16_f32 %0, %1, %2" : "=v"(r) : "v"(lo), "v"(hi)); return r; }

template <class Epi, class Sched, bool GATHER, bool ALIGN_EPI, bool FP8 = false>
__device__ __forceinline__ void gemm_phase(LAS unsigned char* lds, const int K, const Sched& S, const Epi& E) {
    const int tid = threadIdx.x, wid = __builtin_amdgcn_readfirstlane(tid >> 6), lane = tid & 63, wr = wid >> 2, wc = wid & 3, fr = lane & 15, fq = lane >> 4;
    int nt = K / BK; asm volatile("" : "+s"(nt));
    unsigned voffA[2], voffB[2]; int rowA[2];
#pragma unroll
    for (int i = 0; i < 2; ++i) { int R, C; stage_rc(tid * 16 + i * 8192, R, C); const int Rb = Epi::PERM ? ((R & ~31) + perm32(R & 31)) : R;
        voffA[i] = (unsigned)(R * K + C) * 2u; voffB[i] = (unsigned)(Rb * K + C) * 2u; rowA[i] = R; if (GATHER) voffA[i] = (unsigned)C * 2u; }
    const size_t kstep = (size_t)(BK * 2);
    const size_t hstep = (size_t)HALF * K * 2;
    const unsigned ldsw = (unsigned)wid * 1024u;
    const int aoff = lds_byte(wr * 64 + fr, fq * 8), boff = lds_byte(wc * 32 + fr, fq * 8);
    const int sw8 = (fq >> 1) * 1024 + fr * 64 + ((((fq & 1) ^ (fr >> 3))) << 5);
    const int aoff8 = wr * 8192 + sw8, boff8 = wc * 4096 + sw8;
#define PG8_SA(b, h) (((b) * 2 + (h)) * HTB)
#define PG8_SB(b, h) ((4 + (b) * 2 + (h)) * HTB)
#define PG8_STAGE2(bufoff, gbase, o0, o1) do { \
        __builtin_amdgcn_global_load_lds((const unsigned*)((const char*)(gbase) + (o0)), (LAS unsigned*)(lds + (bufoff) + ldsw), 16, 0, 0); \
        __builtin_amdgcn_global_load_lds((const unsigned*)((const char*)(gbase) + (o1)), (LAS unsigned*)(lds + (bufoff) + ldsw + 8192), 16, 0, 0); } while (0)
#define PG8_STAGEB(bufoff, gbase) PG8_STAGE2(bufoff, gbase, voffB[0], voffB[1])
#define PG8_STAGEA(bufoff, kp, hh, OS) do { if (GATHER) PG8_STAGE2(bufoff, kp, OS[hh][0], OS[hh][1]); else PG8_STAGE2(bufoff, (kp) + (hh) * hstep, voffA[0], voffA[1]); } while (0)
#define PG8_LDA(dst, b, h) do { _Pragma("unroll") for (int m = 0; m < 4; ++m) _Pragma("unroll") for (int k = 0; k < 2; ++k) dst[m][k] = *(const LAS bf16x8*)(lds + PG8_SA(b, h) + aoff + m * 2048 + k * 1024); } while (0)
#define PG8_LDB(dst, b, h) do { _Pragma("unroll") for (int n = 0; n < 2; ++n) _Pragma("unroll") for (int k = 0; k < 2; ++k) dst[n][k] = *(const LAS bf16x8*)(lds + PG8_SB(b, h) + boff + n * 2048 + k * 1024); } while (0)
#define PG8_MMA(ai, bj, At, Bt) do { __builtin_amdgcn_s_setprio(1); _Pragma("unroll") for (int m = 0; m < 4; ++m) _Pragma("unroll") for (int n = 0; n < 2; ++n) _Pragma("unroll") for (int k = 0; k < 2; ++k) \
        acc[ai][bj][m][n] = __builtin_amdgcn_mfma_f32_16x16x32_bf16(Bt[n][k], At[m][k], acc[ai][bj][m][n], 0, 0, 0); __builtin_amdgcn_s_setprio(0); } while (0)
#define PG8_LDA8(dst, b, h) do { _Pragma("unroll") for (int m = 0; m < 4; ++m) { const u32x4 _x = *(const LAS u32x4*)(lds + PG8_SA(b, h) + aoff8 + m * 2048), _y = *(const LAS u32x4*)(lds + PG8_SA(b, h) + aoff8 + m * 2048 + 16); \
        dst[m] = (v8i){(int)_x.x, (int)_x.y, (int)_x.z, (int)_x.w, (int)_y.x, (int)_y.y, (int)_y.z, (int)_y.w}; } } while (0)
#define PG8_LDB8(dst, b, h) do { _Pragma("unroll") for (int n = 0; n < 2; ++n) { const u32x4 _x = *(const LAS u32x4*)(lds + PG8_SB(b, h) + boff8 + n * 2048), _y = *(const LAS u32x4*)(lds + PG8_SB(b, h) + boff8 + n * 2048 + 16); \
        dst[n] = (v8i){(int)_x.x, (int)_x.y, (int)_x.z, (int)_x.w, (int)_y.x, (int)_y.y, (int)_y.z, (int)_y.w}; } } while (0)
#define PG8_MMA8(ai, bj, At, Bt) do { __builtin_amdgcn_s_setprio(1); asm volatile("s_nop 1" ::: "memory"); _Pragma("unroll") for (int m = 0; m < 4; ++m) _Pragma("unroll") for (int n = 0; n < 2; ++n) \
        asm volatile("v_mfma_f32_16x16x128_f8f6f4 %0, %1, %2, %0" : "+v"(acc[ai][bj][m][n]) : "v"(Bt[n]), "v"(At[m])); __builtin_amdgcn_s_setprio(0); } while (0)
#define PG8_WAIT_V(n) asm volatile("s_waitcnt vmcnt(" #n ")" ::: "memory")
#define PG8_WAIT_L(n) asm volatile("s_waitcnt lgkmcnt(" #n ")" ::: "memory")
#define PG8_BAR __builtin_amdgcn_s_barrier()
#define PG8_SCHED __builtin_amdgcn_sched_barrier(0)
    Unit cur, nxt; int ui = 0;
    if (!S.next(0, cur)) return;
    f32x4 acc[2][2][4][2];
#pragma unroll
    for (int a = 0; a < 2; ++a)
#pragma unroll
        for (int b = 0; b < 2; ++b)
#pragma unroll
            for (int m = 0; m < 4; ++m)
#pragma unroll
                for (int n = 0; n < 2; ++n) acc[a][b][m][n] = (f32x4){0.f, 0.f, 0.f, 0.f};
    bf16x8 At[4][2], B0[2][2], B1[2][2];
    v8i At8[4], B08[2], B18[2];
    unsigned gC[2][2], gN[2][2];
    const char* cA = S.a_base(cur); const char* cB = S.b_base(cur);
    if (GATHER) { S.a_rows(cur, rowA, gC);
#pragma unroll
        for (int h = 0; h < 2; ++h)
#pragma unroll
            for (int i = 0; i < 2; ++i) gC[h][i] += voffA[i]; }
    PG8_STAGEB(PG8_SB(0, 0), cB); PG8_STAGEB(PG8_SB(0, 1), cB + hstep); PG8_STAGEA(PG8_SA(0, 0), cA, 0, gC); PG8_STAGEA(PG8_SA(0, 1), cA, 1, gC);
    if (wr == 1) PG8_BAR;
    PG8_WAIT_V(2); PG8_BAR;
    PG8_STAGEB(PG8_SB(1, 0), cB + kstep); PG8_STAGEA(PG8_SA(1, 0), cA + kstep, 0, gC); PG8_STAGEB(PG8_SB(1, 1), cB + hstep + kstep);
    PG8_WAIT_V(6); PG8_BAR;
    for (;;) {
        const bool has_next = S.next(ui + 1, nxt);
        const char* nA = has_next ? S.a_base(nxt) : cA; const char* nB = has_next ? S.b_base(nxt) : cB;
        if (GATHER) { if (has_next) { S.a_rows(nxt, rowA, gN);
#pragma unroll
                for (int h = 0; h < 2; ++h)
#pragma unroll
                    for (int i = 0; i < 2; ++i) gN[h][i] += voffA[i]; }
            else {
#pragma unroll
                for (int h = 0; h < 2; ++h)
#pragma unroll
                    for (int i = 0; i < 2; ++i) gN[h][i] = gC[h][i]; } }
        for (int t = 0; t < nt; t += 2) {
            const bool last = (t == nt - 2);
            const char* a1 = cA + (size_t)(t + 1) * kstep;
            const char* a2 = last ? nA : cA + (size_t)(t + 2) * kstep; const char* b2 = last ? nB : cB + (size_t)(t + 2) * kstep;
            const char* a3 = a2 + kstep; const char* b3 = b2 + kstep;
            unsigned g2[2][2];
            if (GATHER) {
#pragma unroll
                for (int h = 0; h < 2; ++h)
#pragma unroll
                    for (int i = 0; i < 2; ++i) g2[h][i] = last ? gN[h][i] : gC[h][i]; }
            if constexpr (!FP8) {
            PG8_LDB(B0, 0, 0); PG8_LDB(B1, 0, 1); PG8_SCHED; PG8_LDA(At, 0, 0); PG8_STAGEA(PG8_SA(1, 1), a1, 1, gC);
            PG8_WAIT_V(8); PG8_WAIT_L(0); PG8_BAR; PG8_MMA(0, 0, At, B0); PG8_MMA(0, 1, At, B1); PG8_BAR; PG8_SCHED;
            PG8_LDA(At, 0, 1); PG8_STAGEB(PG8_SB(0, 0), b2); PG8_STAGEB(PG8_SB(0, 1), b2 + hstep); PG8_STAGEA(PG8_SA(0, 0), a2, 0, g2);
            PG8_WAIT_V(8); PG8_WAIT_L(0); PG8_BAR; PG8_MMA(1, 0, At, B0); PG8_MMA(1, 1, At, B1); PG8_BAR; PG8_SCHED;
            PG8_LDB(B0, 1, 0); PG8_LDB(B1, 1, 1); PG8_SCHED; PG8_LDA(At, 1, 0); PG8_STAGEA(PG8_SA(0, 1), a2, 1, g2);
            PG8_WAIT_V(8); PG8_WAIT_L(0); PG8_BAR; PG8_MMA(0, 0, At, B0); PG8_MMA(0, 1, At, B1); PG8_BAR; PG8_SCHED;
            PG8_LDA(At, 1, 1); PG8_STAGEB(PG8_SB(1, 0), b3); PG8_STAGEB(PG8_SB(1, 1), b3 + hstep); PG8_STAGEA(PG8_SA(1, 0), a3, 0, g2);
            PG8_WAIT_V(8); PG8_WAIT_L(0); PG8_BAR; PG8_MMA(1, 0, At, B0); PG8_MMA(1, 1, At, B1); PG8_BAR; PG8_SCHED;
            } else {
            PG8_LDB8(B08, 0, 0); PG8_LDB8(B18, 0, 1); PG8_SCHED; PG8_LDA8(At8, 0, 0); PG8_STAGEA(PG8_SA(1, 1), a1, 1, gC);
            PG8_WAIT_V(8); PG8_WAIT_L(0); PG8_BAR; PG8_MMA8(0, 0, At8, B08); PG8_MMA8(0, 1, At8, B18); PG8_BAR; PG8_SCHED;
            PG8_LDA8(At8, 0, 1); PG8_STAGEB(PG8_SB(0, 0), b2); PG8_STAGEB(PG8_SB(0, 1), b2 + hstep); PG8_STAGEA(PG8_SA(0, 0), a2, 0, g2);
            PG8_WAIT_V(8); PG8_WAIT_L(0); PG8_BAR; PG8_MMA8(1, 0, At8, B08); PG8_MMA8(1, 1, At8, B18); PG8_BAR; PG8_SCHED;
            PG8_LDB8(B08, 1, 0); PG8_LDB8(B18, 1, 1); PG8_SCHED; PG8_LDA8(At8, 1, 0); PG8_STAGEA(PG8_SA(0, 1), a2, 1, g2);
            PG8_WAIT_V(8); PG8_WAIT_L(0); PG8_BAR; PG8_MMA8(0, 0, At8, B08); PG8_MMA8(0, 1, At8, B18); PG8_BAR; PG8_SCHED;
            PG8_LDA8(At8, 1, 1); PG8_STAGEB(PG8_SB(1, 0), b3); PG8_STAGEB(PG8_SB(1, 1), b3 + hstep); PG8_STAGEA(PG8_SA(1, 0), a3, 0, g2);
            PG8_WAIT_V(8); PG8_WAIT_L(0); PG8_BAR; PG8_MMA8(1, 0, At8, B08); PG8_MMA8(1, 1, At8, B18); PG8_BAR; PG8_SCHED;
            }
        }
        if constexpr (ALIGN_EPI) { if (wr == 0) PG8_BAR; }
        if constexpr (FP8) asm volatile("s_nop 15\n\ts_nop 15" ::: "memory");
        E(acc, cur, wr, wc, fr, fq);
        if (!has_next) break;
#pragma unroll
        for (int a = 0; a < 2; ++a)
#pragma unroll
            for (int b = 0; b < 2; ++b)
#pragma unroll
                for (int m = 0; m < 4; ++m)
#pragma unroll
                    for (int n = 0; n < 2; ++n) acc[a][b][m][n] = (f32x4){0.f, 0.f, 0.f, 0.f};
        cur = nxt; cA = nA; cB = nB; ++ui;
        if (GATHER) {
#pragma unroll
            for (int h = 0; h < 2; ++h)
#pragma unroll
                for (int i = 0; i < 2; ++i) gC[h][i] = gN[h][i]; }
        if constexpr (ALIGN_EPI) { if (wr == 1) PG8_BAR; }
    }
    PG8_WAIT_V(0);
    if constexpr (!ALIGN_EPI) { if (wr == 0) PG8_BAR; }
    PG8_BAR;
#undef PG8_SA
#undef PG8_SB
#undef PG8_STAGE2
#undef PG8_STAGEA
#undef PG8_STAGEB
#undef PG8_LDA
#undef PG8_LDB
#undef PG8_MMA
#undef PG8_LDA8
#undef PG8_LDB8
#undef PG8_MMA8
#undef PG8_WAIT_V
#undef PG8_WAIT_L
#undef PG8_BAR
#undef PG8_SCHED
}
}
using pg8::Unit;

struct DenseSched {
    const char* A; const char* Bt; int nM, nN, G, c; size_t tstep;
    __device__ __forceinline__ bool next(int i, Unit& u) const { return pg8::tile_order(i, G, c, nM, nN, u); }
    __device__ __forceinline__ const char* a_base(const Unit& u) const { return A + (size_t)u.pm * tstep; }
    __device__ __forceinline__ const char* b_base(const Unit& u) const { return Bt + (size_t)u.pn * tstep; }
    __device__ __forceinline__ void a_rows(const Unit&, const int (&)[2], unsigned (&)[2][2]) const {}
};
struct MoeSched {
    const char* A; const char* Wt; size_t estride; int nM, nN, G, c; size_t tstep;
    const volatile LAS int* bstart; const volatile LAS int* cnt; const int* list; int K2; bool gather;
    const volatile LAS unsigned char* blk_e;
    __device__ __forceinline__ int expert_of(int pm) const { return (int)blk_e[pm]; }
    __device__ __forceinline__ bool next(int i, Unit& u) const { return pg8::tile_order(i, G, c, nM, nN, u); }
    __device__ __forceinline__ const char* a_base(const Unit& u) const { return gather ? A : A + (size_t)u.pm * tstep; }
    __device__ __forceinline__ const char* b_base(const Unit& u) const { const int e = expert_of(u.pm); return Wt + (size_t)e * estride + (size_t)u.pn * tstep; }
    __device__ __forceinline__ void a_rows(const Unit& u, const int (&rowA)[2], unsigned (&o)[2][2]) const {
        const int e = expert_of(u.pm), rb = u.pm - bstart[e], n = cnt[e];
#pragma unroll
        for (int h = 0; h < 2; ++h)
#pragma unroll
            for (int i = 0; i < 2; ++i) { const int idx = rb * 256 + h * 128 + rowA[i]; int tok = 0; if (idx < n) tok = list[2 * (e * LCAP + idx)] >> 2; o[h][i] = (unsigned)tok * (unsigned)K2; }
    }
};

struct EpiBf16 {
    static constexpr bool PERM = true;
    bf16_t* O; int ldc;
    __device__ __forceinline__ void operator()(const f32x4 (&acc)[2][2][4][2], const Unit& u, int wr, int wc, int fr, int fq) const {
        const int row0 = u.pm * 256 + wr * 64 + fr, col0 = u.pn * 256 + wc * 32 + 8 * fq;
#pragma unroll
        for (int ai = 0; ai < 2; ++ai)
#pragma unroll
            for (int m = 0; m < 4; ++m) { bf16_t* rowp = O + (size_t)(row0 + ai * 128 + m * 16) * ldc + col0;
#pragma unroll
                for (int bj = 0; bj < 2; ++bj) { const f32x4 v0 = acc[ai][bj][m][0], v1 = acc[ai][bj][m][1];
                    u32x4 w; w.x = pg8::cvt_pk_bf16(v0[0], v0[1]); w.y = pg8::cvt_pk_bf16(v0[2], v0[3]); w.z = pg8::cvt_pk_bf16(v1[0], v1[1]); w.w = pg8::cvt_pk_bf16(v1[2], v1[3]);
                    *(u32x4*)(rowp + bj * 128) = w; } }
    }
};
struct EpiResid {
    static constexpr bool PERM = false;
    const float* X; float* H; const float* mod; float* RSS;
    __device__ __forceinline__ void operator()(const f32x4 (&acc)[2][2][4][2], const Unit& u, int wr, int wc, int fr, int fq) const {
        const int b = (u.pm * 256) >> 11; const int col0 = u.pn * 256 + wc * 32 + 4 * fq;
        f32x4 gt[2][2];
#pragma unroll
        for (int bj = 0; bj < 2; ++bj)
#pragma unroll
            for (int n = 0; n < 2; ++n) gt[bj][n] = *(const f32x4*)(mod + b * 6144 + 2048 + col0 + bj * 128 + n * 16);
#pragma unroll
        for (int ai = 0; ai < 2; ++ai)
#pragma unroll
            for (int m = 0; m < 4; ++m) { const int row = u.pm * 256 + ai * 128 + wr * 64 + m * 16 + fr; const size_t off = (size_t)row * D + col0; float ss = 0.f;
#pragma unroll
                for (int bj = 0; bj < 2; ++bj)
#pragma unroll
                    for (int n = 0; n < 2; ++n) { const f32x4 xv = *(const f32x4*)(X + off + bj * 128 + n * 16); const f32x4 hv = xv + gt[bj][n] * acc[ai][bj][m][n];
                        *(f32x4*)(H + off + bj * 128 + n * 16) = hv; ss += (hv[0] * hv[0] + hv[1] * hv[1]) + (hv[2] * hv[2] + hv[3] * hv[3]); }
                ss += __shfl_xor(ss, 16); ss += __shfl_xor(ss, 32);
                if (fq == 0) RSS[(size_t)row * 16 + u.pn * 4 + wc] = ss; }
    }
};
template <bool OUT8> struct EpiSwiglu {
    static constexpr bool PERM = true;
    bf16_t* ACT; const float* b1; const MoeSched* S;
    __device__ __forceinline__ void operator()(const f32x4 (&acc)[2][2][4][2], const Unit& u, int wr, int wc, int fr, int fq) const {
        const int e = S->expert_of(u.pm);
        const int row0 = u.pm * 256 + wr * 64 + fr, col0 = u.pn * 256 + wc * 32 + 8 * fq;
        f32x4 bv[2][2];
#pragma unroll
        for (int bj = 0; bj < 2; ++bj)
#pragma unroll
            for (int n = 0; n < 2; ++n) bv[bj][n] = *(const f32x4*)(b1 + (size_t)e * 2048 + col0 + bj * 128 + 4 * n);
#pragma unroll
        for (int ai = 0; ai < 2; ++ai)
#pragma unroll
            for (int m = 0; m < 4; ++m) { bf16_t* rowp = ACT + (size_t)(row0 + ai * 128 + m * 16) * 1024 + (col0 >> 1);
#pragma unroll
                for (int bj = 0; bj < 2; ++bj) { float a[4];
#pragma unroll
                    for (int n = 0; n < 2; ++n) { const f32x4 v = acc[ai][bj][m][n] + bv[bj][n];
#pragma unroll
                        for (int p = 0; p < 2; ++p) { const float g = fminf(v[2 * p], 7.0f), l = fminf(fmaxf(v[2 * p + 1], -7.0f), 7.0f);
                            a[2 * n + p] = g * fast_sigmoid(1.702f * g) * (l + 1.0f); } }
                    if constexpr (OUT8) { *(unsigned*)((unsigned char*)ACT + (size_t)(row0 + ai * 128 + m * 16) * 1024 + (col0 >> 1) + bj * 64) = pk4_fp8(a[0], a[1], a[2], a[3]); }
                    else { u32x2 w; w.x = pg8::cvt_pk_bf16(a[0], a[1]); w.y = pg8::cvt_pk_bf16(a[2], a[3]); *(u32x2*)(rowp + bj * 64) = w; } } }
    }
};
struct EpiPair {
    static constexpr bool PERM = true;
    bf16_t* PAIR; const float* b2; const MoeSched* S;
    __device__ __forceinline__ void operator()(const f32x4 (&acc)[2][2][4][2], const Unit& u, int wr, int wc, int fr, int fq) const {
        const int e = S->expert_of(u.pm), rb = u.pm - S->bstart[e], n_e = S->cnt[e];
        const int col0 = u.pn * 256 + wc * 32 + 8 * fq;
        f32x4 bv[2][2];
#pragma unroll
        for (int bj = 0; bj < 2; ++bj)
#pragma unroll
            for (int n = 0; n < 2; ++n) bv[bj][n] = *(const f32x4*)(b2 + (size_t)e * 1024 + col0 + bj * 128 + 4 * n);
#pragma unroll
        for (int ai = 0; ai < 2; ++ai)
#pragma unroll
            for (int m = 0; m < 4; ++m) { const int idx = rb * 256 + ai * 128 + wr * 64 + m * 16 + fr;
                if (idx < n_e) { const u32x2 rec = *(const GAS u32x2*)(S->list + 2 * (e * LCAP + idx)); const int pair = (int)rec.x; const unsigned gb = rec.y; const float g = __uint_as_float(gb);     bf16_t* rowp = PAIR + (size_t)pair * 1024 + col0;
#pragma unroll
                    for (int bj = 0; bj < 2; ++bj) { const f32x4 v0 = (acc[ai][bj][m][0] + bv[bj][0]) * g, v1 = (acc[ai][bj][m][1] + bv[bj][1]) * g;
                        u32x4 w; w.x = pg8::cvt_pk_bf16(v0[0], v0[1]); w.y = pg8::cvt_pk_bf16(v0[2], v0[3]); w.z = pg8::cvt_pk_bf16(v1[0], v1[1]); w.w = pg8::cvt_pk_bf16(v1[2], v1[3]);
                        *(u32x4*)(rowp + bj * 128) = w; } } }
    }
};

struct Args { const float* in[28]; float* out; unsigned char* ws; int ph_lo, ph_hi; };
enum { I_X = 0, I_C, I_ADAW, I_ADAB, I_N1G, I_WIN, I_CONVW, I_CONVGN, I_MU, I_W0, I_WUP, I_A0, I_AUP, I_GUP, I_KK, I_KA, I_RK, I_LNW, I_LNB, I_WOUT, I_N2G, I_RW, I_RB, I_W1, I_B1, I_W2, I_B2, I_FG };
constexpr int NWAVES = 8;
constexpr int LDS_TOTAL = 163840;
constexpr int LDS_MISC = LDS_TOTAL - 512;

__device__ __forceinline__ void p0_mod_unit(const Args& a, int u, LAS unsigned char* lds, int tid) {
    LAS float* cact = (LAS float*)lds; LAS float* red = (LAS float*)(lds + 65536);
    const float* c = a.in[I_C];
    for (int i = tid; i < 16 * 1024; i += 512) { const float v = c[i]; cact[i] = v * fast_sigmoid(v); }
    __syncthreads();
    const int kq = tid >> 5, col = tid & 31;
    float acc[16];
#pragma unroll
    for (int b = 0; b < 16; ++b) acc[b] = 0.f;
    const float* w = a.in[I_ADAW] + (size_t)(kq * 64) * 6144 + u * 32 + col;
#pragma unroll 4
    for (int k = 0; k < 64; ++k) { const float wv = w[(size_t)k * 6144];
#pragma unroll
        for (int b = 0; b < 16; ++b) acc[b] += cact[b * 1024 + kq * 64 + k] * wv; }
#pragma unroll
    for (int b = 0; b < 16; ++b) red[(kq * 16 + b) * 32 + col] = acc[b];
    __syncthreads();
    { const int b = tid >> 5; float s = a.in[I_ADAB][u * 32 + col];
#pragma unroll
      for (int q = 0; q < 16; ++q) s += red[(q * 16 + b) * 32 + col];
      ((float*)(a.ws + WS_MOD))[b * 6144 + u * 32 + col] = s; }
    __syncthreads();
}
__device__ __forceinline__ void tr_item64(const float* W, int ldw, bf16_t* WT, int ldt, int k0, int n0, LAS float* scr, int lane) {
    const int kr = lane >> 4, c4 = lane & 15;
    f32x4 v[16];
#pragma unroll
    for (int i = 0; i < 16; ++i) v[i] = *(const GAS f32x4*)(W + (size_t)(k0 + 4 * i + kr) * ldw + n0 + 4 * c4);
#pragma unroll
    for (int i = 0; i < 16; ++i) { LAS float* s = scr + (4 * i + kr) * 65 + 4 * c4; s[0] = v[i][0]; s[1] = v[i][1]; s[2] = v[i][2]; s[3] = v[i][3]; }
    LDS_WAIT(); asm volatile("" ::: "memory");
    const int c = lane & 7;
#pragma unroll
    for (int j = 0; j < 8; ++j) { const int n = (lane >> 3) + 8 * j; const LAS float* s = scr + (8 * c) * 65 + n;
        u32x4 o; o.x = pk2(s[0], s[65]); o.y = pk2(s[130], s[195]); o.z = pk2(s[260], s[325]); o.w = pk2(s[390], s[455]);
        *(GAS u32x4*)(WT + (size_t)(n0 + n) * ldt + k0 + 8 * c) = o; }
    LDS_WAIT(); asm volatile("" ::: "memory");
}
__device__ __forceinline__ void tr_item64_fp8(const float* W, int ldw, unsigned char* WT, int ldt, int k0, int n0, int lane) {
    const GAS float* src = (const GAS float*)(W + (size_t)k0 * ldw + n0 + lane);
    float v[64];
#pragma unroll
    for (int k = 0; k < 64; ++k) v[k] = src[(size_t)k * ldw];
    GAS u32x4* dst = (GAS u32x4*)(WT + (size_t)(n0 + lane) * ldt + k0);
#pragma unroll
    for (int j = 0; j < 4; ++j) { u32x4 o; o.x = pk4_fp8(v[16 * j], v[16 * j + 1], v[16 * j + 2], v[16 * j + 3]); o.y = pk4_fp8(v[16 * j + 4], v[16 * j + 5], v[16 * j + 6], v[16 * j + 7]);
        o.z = pk4_fp8(v[16 * j + 8], v[16 * j + 9], v[16 * j + 10], v[16 * j + 11]); o.w = pk4_fp8(v[16 * j + 12], v[16 * j + 13], v[16 * j + 14], v[16 * j + 15]); dst[j] = o; }
}
__device__ __forceinline__ void tr_matrix_item(const float* W, int K, int N, bf16_t* WT, int item, LAS float* scr, int lane) {
    const int nb = N / 64; tr_item64(W, N, WT, K, (item / nb) * 64, (item % nb) * 64, scr, lane);
}
constexpr int TI_WIN = 16 * 52, TI_WOUT = 16 * 16, TI_UP = 8, TI_GUP = 16, TI_SMALL = TI_WIN + TI_WOUT + 2 * TI_UP + TI_GUP;
constexpr int TI_W1 = 16 * 32, TI_W2 = 16 * 16, TI_TOTAL = TI_SMALL + NE * (TI_W1 + TI_W2);
__device__ __forceinline__ void p0_phase(const Args& a, LAS unsigned char* lds, int tid, int wave, int lane, int vcu, int G) {
    if (blockIdx.x < 192) p0_mod_unit(a, blockIdx.x, lds, tid);
    else if (blockIdx.x < 256) { const int i = (blockIdx.x - 192) * 512 + tid, k = i >> 5, e = i & 31; const float w = a.in[I_RW][i];
        const unsigned hi = f2bf(w); const float lo = w - __builtin_bit_cast(float, hi << 16);
        bf16_t* rwh = (bf16_t*)(a.ws + WS_RWH); rwh[e * 1024 + k] = (bf16_t)hi; rwh[32 * 1024 + e * 1024 + k] = (bf16_t)f2bf(lo); }
    LAS float* scr = (LAS float*)(lds + wave * 16640);
    unsigned char* ws = a.ws;
    bf16_t* lora = (bf16_t*)(ws + WS_LORA);
    const int gw = vcu * NWAVES + wave, NGW = G * NWAVES;
    for (int it = gw; it < TI_SMALL; it += NGW) {
        int r = it;
        if (r < TI_WIN) { tr_matrix_item(a.in[I_WIN], 1024, NIN, (bf16_t*)(ws + WS_WIN), r, scr, lane); continue; } r -= TI_WIN;
        if (r < TI_WOUT) { tr_matrix_item(a.in[I_WOUT], 1024, 1024, (bf16_t*)(ws + WS_WOUT), r, scr, lane); continue; } r -= TI_WOUT;
        if (r < TI_UP) { tr_matrix_item(a.in[I_WUP], 64, 512, lora, r, scr, lane); continue; } r -= TI_UP;
        if (r < TI_UP) { tr_matrix_item(a.in[I_AUP], 64, 512, lora + 512 * 64, r, scr, lane); continue; } r -= TI_UP;
        tr_matrix_item(a.in[I_GUP], 128, 512, lora + 2 * 512 * 64, r, scr, lane);
    }
}
__device__ __forceinline__ void expert_transposes(const Args& a, LAS float* scr, int gw, int NGW, int lane) {
    unsigned char* ws = a.ws;
    for (int r = gw; r < NE * (TI_W1 + TI_W2); r += NGW) {
        if (r < NE * TI_W1) { const int e = r / TI_W1, it = r % TI_W1;
            if (FP8_G3) tr_item64_fp8(a.in[I_W1] + (size_t)e * 1024 * 2048, 2048, ws + WS_W1T + (size_t)e * 2048 * 1024, 1024, (it / 32) * 64, (it % 32) * 64, lane);
            else tr_matrix_item(a.in[I_W1] + (size_t)e * 1024 * 2048, 1024, 2048, (bf16_t*)(ws + WS_W1T) + (size_t)e * 2048 * 1024, it, scr, lane); }
        else { const int q = r - NE * TI_W1; const int e = q / TI_W2, it = q % TI_W2;
            if (FP8_G4) tr_item64_fp8(a.in[I_W2] + (size_t)e * 1024 * 1024, 1024, ws + WS_W2T + (size_t)e * 1024 * 1024, 1024, (it / 16) * 64, (it % 16) * 64, lane);
            else tr_matrix_item(a.in[I_W2] + (size_t)e * 1024 * 1024, 1024, 1024, (bf16_t*)(ws + WS_W2T) + (size_t)e * 1024 * 1024, it, scr, lane); }
    }
}

__device__ __forceinline__ void p1_phase(const Args& a, int wave, int lane, int vcu, int G) {
    const float* mod = (const float*)(a.ws + WS_MOD); bf16_t* U = (bf16_t*)(a.ws + WS_U);
    const int gw = vcu * NWAVES + wave, NGW = G * NWAVES;
    for (int row = gw; row < M; row += NGW) {
        const int b = row >> 11;
        const GAS f32x4* xr = (const GAS f32x4*)(a.in[I_X] + (size_t)row * D) + lane;
        f32x4 v[4]; float s = 0.f;
#pragma unroll
        for (int j = 0; j < 4; ++j) { v[j] = xr[64 * j]; s += (v[j][0] * v[j][0] + v[j][1] * v[j][1]) + (v[j][2] * v[j][2] + v[j][3] * v[j][3]); }
        const float inv = 1.0f / sqrtf(wave_sum(s) * (1.f / D) + NORM_EPS);
        GAS u32x2* o8 = (GAS u32x2*)(U + (size_t)row * D) + lane;
#pragma unroll
        for (int j = 0; j < 4; ++j) { const int col = 4 * lane + 256 * j;
            const f32x4 g = *(const f32x4*)(a.in[I_N1G] + col), sh = *(const f32x4*)(mod + b * 6144 + col), sc = *(const f32x4*)(mod + b * 6144 + 1024 + col);
            const f32x4 y = v[j] * inv * g * (sc + 1.0f) + sh;
            u32x2 w; w.x = pk2(y[0], y[1]); w.y = pk2(y[2], y[3]); o8[64 * j] = w; }
    }
}

__device__ __forceinline__ void p3_conv(const Args& a, int wave, int lane, int vcu, int G) {
    const bf16_t* P = (const bf16_t*)(a.ws + WS_PROJ); bf16_t* Y = (bf16_t*)(a.ws + WS_YMIX);
    const int gw = vcu * NWAVES + wave, NGW = G * NWAVES;
    const int c0 = 8 * lane;
    float w0[8], w1[8], w2[8], gn[8];
#pragma unroll
    for (int e = 0; e < 8; ++e) { w0[e] = a.in[I_CONVW][c0 + e]; w1[e] = a.in[I_CONVW][512 + c0 + e]; w2[e] = a.in[I_CONVW][1024 + c0 + e]; gn[e] = a.in[I_CONVGN][c0 + e]; }
    for (int row = gw; row < M; row += NGW) {
        const int t = row & (SEQ - 1);
        const bf16_t* pr = P + (size_t)row * NIN + c0;
        const u32x4 bg = *(const GAS u32x4*)(pr + COL_B), cg = *(const GAS u32x4*)(pr + COL_C), hg = *(const GAS u32x4*)(pr + COL_H);
        u32x4 c1 = (u32x4){0u, 0u, 0u, 0u}, h1 = c1, c2 = c1, h2 = c1;
        if (t >= 1) { c1 = *(const GAS u32x4*)(pr - NIN + COL_C); h1 = *(const GAS u32x4*)(pr - NIN + COL_H); }
        if (t >= 2) { c2 = *(const GAS u32x4*)(pr - 2 * NIN + COL_C); h2 = *(const GAS u32x4*)(pr - 2 * NIN + COL_H); }
        float y[8]; float ss = 0.f;
#pragma unroll
        for (int q = 0; q < 4; ++q) {
            const float u0l = bflo(cg[q]) * bflo(hg[q]), u0h = bfhi(cg[q]) * bfhi(hg[q]);
            const float u1l = bflo(c1[q]) * bflo(h1[q]), u1h = bfhi(c1[q]) * bfhi(h1[q]);
            const float u2l = bflo(c2[q]) * bflo(h2[q]), u2h = bfhi(c2[q]) * bfhi(h2[q]);
            const float yl = (w0[2 * q] * u2l + w1[2 * q] * u1l + w2[2 * q] * u0l) * bflo(bg[q]);
            const float yh = (w0[2 * q + 1] * u2h + w1[2 * q + 1] * u1h + w2[2 * q + 1] * u0h) * bfhi(bg[q]);
            y[2 * q] = yl; y[2 * q + 1] = yh; ss += yl * yl + yh * yh; }
        ss += __shfl_xor(ss, 1); ss += __shfl_xor(ss, 2); ss += __shfl_xor(ss, 4);
        const float rs = 1.0f / sqrtf(ss * (1.f / 64.f) + NORM_EPS);
        u32x4 o; o.x = pk2(y[0] * rs * gn[0], y[1] * rs * gn[1]); o.y = pk2(y[2] * rs * gn[2], y[3] * rs * gn[3]); o.z = pk2(y[4] * rs * gn[4], y[5] * rs * gn[5]); o.w = pk2(y[6] * rs * gn[6], y[7] * rs * gn[7]);
        *(GAS u32x4*)(Y + (size_t)row * D + c0) = o;
    }
}

__device__ __forceinline__ f32x16 zero16() { f32x16 z;
#pragma unroll
    for (int i = 0; i < 16; ++i) z[i] = 0.f; return z; }
__device__ __forceinline__ int tile_off(int t, int c) { return t * 128 + ((((c >> 3) ^ (t & 7))) << 4) + (c & 7) * 2; }
template <int KC> __device__ __forceinline__ void lora_mm(const LAS unsigned char* codes, int code_off, const bf16_t* WT, int h, int r32, int h2, f32x16 (&acc)[2]) {
    acc[0] = zero16(); acc[1] = zero16();
#pragma unroll
    for (int ks = 0; ks < KC / 16; ++ks) {
        const bf16x8 A = *(const LAS bf16x8*)(codes + r32 * 528 + (code_off + 16 * ks + 8 * h2) * 2);
#pragma unroll
        for (int ct = 0; ct < 2; ++ct) { const bf16x8 B = *(const GAS bf16x8*)(WT + (size_t)(h * 64 + 32 * ct + r32) * KC + 16 * ks + 8 * h2);
            acc[ct] = __builtin_amdgcn_mfma_f32_32x32x16_bf16(A, B, acc[ct], 0, 0, 0); }
    }
}
__device__ __forceinline__ void acc_to_cols(const f32x16 (&acc)[2], LAS float* SC, int lane, int r32, int h2, float (&x)[32]) {
#pragma unroll
    for (int ct = 0; ct < 2; ++ct)
#pragma unroll
        for (int q = 0; q < 4; ++q) *(LAS f32x4*)(SC + (32 * ct + r32) * 36 + 8 * q + 4 * h2) = (f32x4){acc[ct][4 * q], acc[ct][4 * q + 1], acc[ct][4 * q + 2], acc[ct][4 * q + 3]};
    LDS_WAIT(); asm volatile("" ::: "memory");
#pragma unroll
    for (int q = 0; q < 8; ++q) { const f32x4 v = *(const LAS f32x4*)(SC + lane * 36 + 4 * q); x[4 * q] = v[0]; x[4 * q + 1] = v[1]; x[4 * q + 2] = v[2]; x[4 * q + 3] = v[3]; }
    LDS_WAIT(); asm volatile("" ::: "memory");
}
__device__ __forceinline__ void st_frag(unsigned char* blk, int f, int lanepos, u32x4 v) { *(GAS u32x4*)(blk + f * 1024 + lanepos * 16) = v; }
__device__ __forceinline__ u32x4 tile_frag_pi(const LAS unsigned char* T, int t, int ks, int h2) {
    const u32x2 lo = *(const LAS u32x2*)(T + t * 128 + (((2 * ks) ^ (t & 7)) << 4) + 8 * h2);
    const u32x2 hi = *(const LAS u32x2*)(T + t * 128 + (((2 * ks + 1) ^ (t & 7)) << 4) + 8 * h2);
    return (u32x4){lo.x, lo.y, hi.x, hi.y};
}

__device__ __forceinline__ void p3_rwkv_group(const Args& a, int grp, LAS unsigned char* lds, int tid, int wave, int lane) {
    const int b = grp >> 6, ch = grp & 63, t0 = ch * CL; const size_t row0 = (size_t)b * SEQ + t0;
    const bf16_t* P = (const bf16_t*)(a.ws + WS_PROJ);
    LAS unsigned char* codes = lds + 131072;
    {
        const int t = tid >> 4, j0 = (tid & 15) * 16;
        const bf16_t* cur = P + (row0 + t) * NIN + COL_DW + j0;
        const u32x4 c0 = *(const GAS u32x4*)cur, c1 = *(const GAS u32x4*)(cur + 8);
        u32x4 p0 = (u32x4){0u, 0u, 0u, 0u}, p1 = p0;
        if (t0 + t > 0) { p0 = *(const GAS u32x4*)(cur - NIN); p1 = *(const GAS u32x4*)(cur - NIN + 8); }
        const float* mu = a.in[I_MU] + 1536 + j0;
        float o[16];
#pragma unroll
        for (int q = 0; q < 8; ++q) { const unsigned cw = q < 4 ? c0[q] : c1[q - 4], pw = q < 4 ? p0[q] : p1[q - 4];
            const float cl = bflo(cw), chh = bfhi(cw), pl = bflo(pw), ph = bfhi(pw);
            o[2 * q] = cl + (pl - cl) * mu[2 * q]; o[2 * q + 1] = chh + (ph - chh) * mu[2 * q + 1]; }
        if (j0 < 64) {
#pragma unroll
            for (int e = 0; e < 16; ++e) o[e] = 1.0f - 2.0f * __builtin_amdgcn_rcpf(1.0f + __expf(2.0f * o[e]));
        } else if (j0 >= 128) {
#pragma unroll
            for (int e = 0; e < 16; ++e) o[e] = fast_sigmoid(o[e]);
        }
        u32x4 w0, w1; w0.x = pk2(o[0], o[1]); w0.y = pk2(o[2], o[3]); w0.z = pk2(o[4], o[5]); w0.w = pk2(o[6], o[7]);
        w1.x = pk2(o[8], o[9]); w1.y = pk2(o[10], o[11]); w1.z = pk2(o[12], o[13]); w1.w = pk2(o[14], o[15]);
        *(LAS u32x4*)(codes + t * 528 + j0 * 2) = w0; *(LAS u32x4*)(codes + t * 528 + j0 * 2 + 16) = w1;
    }
    __syncthreads();
    const int h = wave, bh = b * 8 + h, hc = h * 64 + lane, r32 = lane & 31, h2 = lane >> 5;
    LAS unsigned char* wl = lds + wave * 16384;
    LAS float* SC = (LAS float*)wl;
    LAS unsigned char* T_A = wl, *T_B = wl + 4096, *T_K = wl + 8192, *T_R = wl + 12288;
    unsigned char* blk = a.ws + WS_CH + ((size_t)bh * NCH + ch) * CHB;
    const bf16_t* lora = (const bf16_t*)(a.ws + WS_LORA);
    f32x16 acc[2]; float x[32];
    const bf16_t* pr = P + row0 * NIN + COL_R + hc;
    unsigned short rr[8], rk_[8], rv[8];
#pragma unroll
    for (int i = 0; i < 8; ++i) { const bf16_t* p = pr + (size_t)i * NIN; rr[i] = p[0]; rk_[i] = p[512]; rv[i] = p[1024]; }
    lora_mm<128>(codes, 128, lora + 2 * 512 * 64, h, r32, h2, acc); acc_to_cols(acc, SC, lane, r32, h2, x);
    { bf16_t* Gp = (bf16_t*)(a.ws + WS_G) + ((size_t)bh * 64 + lane) * SEQ + t0;
#pragma unroll
      for (int q = 0; q < 4; ++q) { u32x4 w; w.x = pk2(x[8 * q], x[8 * q + 1]); w.y = pk2(x[8 * q + 2], x[8 * q + 3]); w.z = pk2(x[8 * q + 4], x[8 * q + 5]); w.w = pk2(x[8 * q + 6], x[8 * q + 7]); *(GAS u32x4*)(Gp + 8 * q) = w; } }
    float cum[32];
    lora_mm<64>(codes, 0, lora, h, r32, h2, acc); acc_to_cols(acc, SC, lane, r32, h2, x);
    { const float w0c = a.in[I_W0][hc]; float run = 0.f;
#pragma unroll
      for (int t = 0; t < 32; ++t) { run -= 0.6065306597f * fast_sigmoid(w0c + x[t]); cum[t] = run; } }
    lora_mm<64>(codes, 64, lora + 512 * 64, h, r32, h2, acc); acc_to_cols(acc, SC, lane, r32, h2, x);
    { const float a0c = a.in[I_A0][hc];
#pragma unroll
      for (int t = 0; t < 32; ++t) x[t] = fast_sigmoid(a0c + x[t]); }
    const float mur = a.in[I_MU][hc], muk = a.in[I_MU][512 + hc], muv = a.in[I_MU][1024 + hc];
    const float kkc = a.in[I_KK][hc], kac = a.in[I_KA][hc], rkc = a.in[I_RK][hc];
    float pr_r = 0.f, pr_k = 0.f, pr_v = 0.f;
    if (t0 > 0) { pr_r = bf2f(pr[-NIN]); pr_k = bf2f(pr[-NIN + 512]); pr_v = bf2f(pr[-NIN + 1024]); }
    unsigned vv2[16]; float bon = 0.f; float e_prev = 1.0f;
#pragma unroll
    for (int bi = 0; bi < 4; ++bi) {
        unsigned short nr[8], nk[8], nv[8];
        if (bi < 3) {
#pragma unroll
            for (int i = 0; i < 8; ++i) { const bf16_t* p = pr + (size_t)(8 * (bi + 1) + i) * NIN; nr[i] = p[0]; nk[i] = p[512]; nv[i] = p[1024]; }
        }
        asm volatile("" ::: "memory");
        float vprev = 0.f;
#pragma unroll
        for (int i = 0; i < 8; ++i) { const int t = 8 * bi + i;
            const float cr = bf2f(rr[i]), ck = bf2f(rk_[i]), cv = bf2f(rv[i]);
            const float r = cr + (pr_r - cr) * mur, k = ck + (pr_k - ck) * muk, v = cv + (pr_v - cv) * muv;
            pr_r = cr; pr_k = ck; pr_v = cv;
            const float kkr = k * kkc; const float nsq = wave_sum(kkr * kkr);
            const float kkn = kkr * __builtin_amdgcn_rsqf(fmaxf(nsq, 1e-24f));
            const float at = x[t];
            const float kp = k * (1.0f + (at - 1.0f) * kac);
            const float bs = wave_sum(r * kp * rkc);
            bon = (lane == t) ? bs : bon;
            const float e_cur = __expf(cum[t]), e_neg = __builtin_amdgcn_rcpf(e_cur);
            const float Ah = -kkn * e_prev, Bv = kkn * at * e_neg, Kv = kp * e_neg, Rh = r * e_cur;
            e_prev = e_cur;
            if (i & 1) vv2[t >> 1] = pk2(vprev, v); else vprev = v;
            const int to = tile_off(t, lane);
            *(LAS unsigned short*)(T_A + to) = (unsigned short)f2bf(Ah); *(LAS unsigned short*)(T_B + to) = (unsigned short)f2bf(Bv);
            *(LAS unsigned short*)(T_K + to) = (unsigned short)f2bf(Kv); *(LAS unsigned short*)(T_R + to) = (unsigned short)f2bf(Rh);
        }
        asm volatile("" ::: "memory");
        if (bi < 3) {
#pragma unroll
            for (int i = 0; i < 8; ++i) { rr[i] = nr[i]; rk_[i] = nk[i]; rv[i] = nv[i]; }
        }
    }
    { bf16_t* Vp = (bf16_t*)(a.ws + WS_V) + ((size_t)bh * 64 + lane) * SEQ + t0;
#pragma unroll
      for (int q = 0; q < 4; ++q) *(GAS u32x4*)(Vp + 8 * q) = (u32x4){vv2[4 * q], vv2[4 * q + 1], vv2[4 * q + 2], vv2[4 * q + 3]};
      if (lane < 32) ((float*)(a.ws + WS_BON))[(size_t)bh * SEQ + t0 + lane] = bon;
      *(GAS float*)(blk + CH_PL + lane * 4) = e_prev;
#pragma unroll
      for (int ks = 0; ks < 2; ++ks)
#pragma unroll
          for (int hh = 0; hh < 2; ++hh) { const int s0 = 16 * ks + 4 * hh, s1 = s0 + 8;
              st_frag(blk, 22 + 2 * h2 + ks, 32 * hh + r32, (u32x4){vv2[s0 >> 1], vv2[(s0 >> 1) + 1], vv2[s1 >> 1], vv2[(s1 >> 1) + 1]}); } }
    LDS_WAIT(); asm volatile("" ::: "memory");
    f32x16 ab = zero16(), ak = zero16(), rb = zero16(), rk = zero16();
#pragma unroll
    for (int ks = 0; ks < 4; ++ks) { const int fo = r32 * 128 + (((2 * ks + h2) ^ (r32 & 7)) << 4);
        const bf16x8 fa = *(const LAS bf16x8*)(T_A + fo), fb = *(const LAS bf16x8*)(T_B + fo), fk = *(const LAS bf16x8*)(T_K + fo), frr = *(const LAS bf16x8*)(T_R + fo);
        ab = __builtin_amdgcn_mfma_f32_32x32x16_bf16(fb, fa, ab, 0, 0, 0); ak = __builtin_amdgcn_mfma_f32_32x32x16_bf16(fk, fa, ak, 0, 0, 0);
        rb = __builtin_amdgcn_mfma_f32_32x32x16_bf16(fb, frr, rb, 0, 0, 0); rk = __builtin_amdgcn_mfma_f32_32x32x16_bf16(fk, frr, rk, 0, 0, 0); }
#pragma unroll
    for (int ks = 0; ks < 4; ++ks) st_frag(blk, 4 + ks, lane, tile_frag_pi(T_R, r32, ks, h2));
    { unsigned short tb[32], tk[32];
#pragma unroll
      for (int t = 0; t < 32; ++t) { const int to = tile_off(t, lane); tb[t] = *(const LAS unsigned short*)(T_B + to); tk[t] = *(const LAS unsigned short*)(T_K + to); }
#pragma unroll
      for (int ks = 0; ks < 2; ++ks)
#pragma unroll
          for (int hh = 0; hh < 2; ++hh) { const int s0 = 16 * ks + 4 * hh, s1 = s0 + 8; const int lp = 32 * hh + r32;
              u32x4 w; w.x = (unsigned)tb[s0] | ((unsigned)tb[s0 + 1] << 16); w.y = (unsigned)tb[s0 + 2] | ((unsigned)tb[s0 + 3] << 16); w.z = (unsigned)tb[s1] | ((unsigned)tb[s1 + 1] << 16); w.w = (unsigned)tb[s1 + 2] | ((unsigned)tb[s1 + 3] << 16);
              st_frag(blk, 14 + 4 * h2 + ks, lp, w);
              w.x = (unsigned)tk[s0] | ((unsigned)tk[s0 + 1] << 16); w.y = (unsigned)tk[s0 + 2] | ((unsigned)tk[s0 + 3] << 16); w.z = (unsigned)tk[s1] | ((unsigned)tk[s1 + 1] << 16); w.w = (unsigned)tk[s1 + 2] | ((unsigned)tk[s1 + 3] << 16);
              st_frag(blk, 14 + 4 * h2 + 2 + ks, lp, w); } }
    LDS_WAIT(); asm volatile("" ::: "memory");
#pragma unroll
    for (int ks = 0; ks < 2; ++ks) { float m[8], n[8];
#pragma unroll
        for (int j = 0; j < 8; ++j) { const int r = 8 * ks + j; const int s = (r & 3) + 8 * (r >> 2) + 4 * h2; m[j] = (s <= r32) ? rb[r] : 0.f; n[j] = (s <= r32) ? rk[r] : 0.f; }
        u32x4 w; w.x = pk2(m[0], m[1]); w.y = pk2(m[2], m[3]); w.z = pk2(m[4], m[5]); w.w = pk2(m[6], m[7]); st_frag(blk, 8 + ks, lane, w);
        w.x = pk2(n[0], n[1]); w.y = pk2(n[2], n[3]); w.z = pk2(n[4], n[5]); w.w = pk2(n[6], n[7]); st_frag(blk, 12 + ks, lane, w); }
    LAS float* F_AB = (LAS float*)T_B; LAS float* F_AK = (LAS float*)T_K;
#pragma unroll
    for (int q = 0; q < 4; ++q) { f32x4 u, w;
#pragma unroll
        for (int i = 0; i < 4; ++i) { const int s = 8 * q + 4 * h2 + i; u[i] = (s < r32) ? ab[4 * q + i] : 0.f; w[i] = (s < r32) ? ak[4 * q + i] : 0.f; }
        *(LAS f32x4*)(F_AB + r32 * 32 + 8 * q + 4 * h2) = u; *(LAS f32x4*)(F_AK + r32 * 32 + 8 * q + 4 * h2) = w; }
    LDS_WAIT(); asm volatile("" ::: "memory");
    float xs[32], m1[32];
#pragma unroll
    for (int t = 0; t < 32; ++t) { xs[t] = bf2f(*(const LAS unsigned short*)(T_A + tile_off(t, lane))); m1[t] = F_AK[t * 32 + r32]; }
    {
        f32x4 cfc[8], cfn[8];
        cfc[0] = *(const LAS f32x4*)(F_AB + 32);
#pragma unroll
        for (int t = 1; t < 32; ++t) {
            if (t < 31) {
#pragma unroll
                for (int q = 0; q < (t + 4) / 4; ++q) cfn[q] = *(const LAS f32x4*)(F_AB + (t + 1) * 32 + 4 * q);
            }
            asm volatile("" ::: "memory");
            float s1 = xs[t], s2 = m1[t];
#pragma unroll
            for (int q = 0; q < (t + 3) / 4; ++q) {
#pragma unroll
                for (int i = 0; i < 4; ++i) if (4 * q + i < t) { s1 += cfc[q][i] * xs[4 * q + i]; s2 += cfc[q][i] * m1[4 * q + i]; } }
            xs[t] = s1; m1[t] = s2;
            if (t < 31) {
#pragma unroll
                for (int q = 0; q < (t + 4) / 4; ++q) cfc[q] = cfn[q];
            }
            asm volatile("" : "+v"(xs[t]), "+v"(m1[t]));
        }
    }
    LDS_WAIT(); asm volatile("" ::: "memory");
    LAS unsigned char* T_M = T_A;
#pragma unroll
    for (int t = 0; t < 32; ++t) *(LAS unsigned short*)(T_R + tile_off(t, lane)) = (unsigned short)f2bf(xs[t]);
    if (lane < 32) {
#pragma unroll
        for (int t = 0; t < 32; ++t) *(LAS unsigned short*)(T_M + t * 64 + lane * 2) = (unsigned short)f2bf(m1[t]);
    }
    LDS_WAIT(); asm volatile("" ::: "memory");
#pragma unroll
    for (int ks = 0; ks < 4; ++ks) st_frag(blk, ks, lane, tile_frag_pi(T_R, r32, ks, h2));
#pragma unroll
    for (int ks = 0; ks < 2; ++ks) { const u32x2 lo = *(const LAS u32x2*)(T_M + r32 * 64 + (16 * ks + 4 * h2) * 2), hi = *(const LAS u32x2*)(T_M + r32 * 64 + (16 * ks + 8 + 4 * h2) * 2);
        st_frag(blk, 10 + ks, lane, (u32x4){lo.x, lo.y, hi.x, hi.y}); }
    LDS_WAIT(); asm volatile("" ::: "memory");
    __syncthreads();
}
__device__ __forceinline__ void p3_phase(const Args& a, LAS unsigned char* lds, int tid, int wave, int lane, int vcu, int G) {
    for (int grp = vcu; grp < BATCH * NCH; grp += G) p3_rwkv_group(a, grp, lds, tid, wave, lane);
    p3_conv(a, wave, lane, vcu, G);
}

__device__ __forceinline__ void p4_issue(const unsigned char* blkp, LAS unsigned char* slot, int nt, int lane) {
#pragma unroll
    for (int f = 0; f < 22; ++f) __builtin_amdgcn_global_load_lds((const unsigned*)(blkp + f * 1024 + lane * 16), (LAS unsigned*)(slot + f * 1024), 16, 0, 0);
#pragma unroll
    for (int f = 0; f < 2; ++f) __builtin_amdgcn_global_load_lds((const unsigned*)(blkp + (22 + 2 * nt + f) * 1024 + lane * 16), (LAS unsigned*)(slot + (22 + f) * 1024), 16, 0, 0);
    __builtin_amdgcn_global_load_lds((const unsigned*)(blkp + CH_PL + lane * 4), (LAS unsigned*)(slot + 24576), 4, 0, 0);
}
#define P4_FRAG(f) (*(const LAS bf16x8*)(base + (f) * 1024 + lane * 16))
__device__ __forceinline__ void p4_phase(const Args& a, LAS unsigned char* lds, int wave, int lane, int vcu, int G) {
    if (wave >= 1) { expert_transposes(a, (LAS float*)(lds + 98304 + (wave - 1) * 8192), vcu * 7 + (wave - 1), G * 7, lane); return; }
    const int w = blockIdx.x; if (w >= 2 * NBH) return;
    const int bh = w >> 1, nt = w & 1, r32 = lane & 31, h2 = lane >> 5;
    const unsigned char* blk0 = a.ws + WS_CH + (size_t)bh * NCH * CHB;
    float* OT = (float*)(a.ws + WS_OT) + ((size_t)bh * 64 + 32 * nt + r32) * SEQ;
    f32x16 S0 = zero16(), S1 = zero16();
    p4_issue(blk0, lds, nt, lane);
    p4_issue(blk0 + CHB, lds + 28672, nt, lane);
    for (int ci = 0; ci < NCH; ++ci) {
        if (ci + 1 < NCH) asm volatile("s_waitcnt vmcnt(25)" ::: "memory"); else VM_WAIT();
        if (ci + 2 < NCH) p4_issue(blk0 + (size_t)(ci + 2) * CHB, lds + ((ci + 2) % 3) * 28672, nt, lane);
        const LAS unsigned char* base = lds + (ci % 3) * 28672;
        const bf16x8 sb00 = pack8(S0[0], S0[1], S0[2], S0[3], S0[4], S0[5], S0[6], S0[7]), sb01 = pack8(S0[8], S0[9], S0[10], S0[11], S0[12], S0[13], S0[14], S0[15]);
        const bf16x8 sb10 = pack8(S1[0], S1[1], S1[2], S1[3], S1[4], S1[5], S1[6], S1[7]), sb11 = pack8(S1[8], S1[9], S1[10], S1[11], S1[12], S1[13], S1[14], S1[15]);
        const bf16x8 vt0 = P4_FRAG(22), vt1 = P4_FRAG(23);
        f32x16 U = zero16();
        U = __builtin_amdgcn_mfma_f32_32x32x16_bf16(P4_FRAG(0), sb00, U, 0, 0, 0); U = __builtin_amdgcn_mfma_f32_32x32x16_bf16(P4_FRAG(1), sb01, U, 0, 0, 0);
        U = __builtin_amdgcn_mfma_f32_32x32x16_bf16(P4_FRAG(2), sb10, U, 0, 0, 0); U = __builtin_amdgcn_mfma_f32_32x32x16_bf16(P4_FRAG(3), sb11, U, 0, 0, 0);
        U = __builtin_amdgcn_mfma_f32_32x32x16_bf16(P4_FRAG(10), vt0, U, 0, 0, 0); U = __builtin_amdgcn_mfma_f32_32x32x16_bf16(P4_FRAG(11), vt1, U, 0, 0, 0);
        f32x16 O = zero16();
        O = __builtin_amdgcn_mfma_f32_32x32x16_bf16(P4_FRAG(4), sb00, O, 0, 0, 0); O = __builtin_amdgcn_mfma_f32_32x32x16_bf16(P4_FRAG(5), sb01, O, 0, 0, 0);
        O = __builtin_amdgcn_mfma_f32_32x32x16_bf16(P4_FRAG(6), sb10, O, 0, 0, 0); O = __builtin_amdgcn_mfma_f32_32x32x16_bf16(P4_FRAG(7), sb11, O, 0, 0, 0);
        O = __builtin_amdgcn_mfma_f32_32x32x16_bf16(P4_FRAG(12), vt0, O, 0, 0, 0); O = __builtin_amdgcn_mfma_f32_32x32x16_bf16(P4_FRAG(13), vt1, O, 0, 0, 0);
        const bf16x8 ub0 = pack8(U[0], U[1], U[2], U[3], U[4], U[5], U[6], U[7]), ub1 = pack8(U[8], U[9], U[10], U[11], U[12], U[13], U[14], U[15]);
        O = __builtin_amdgcn_mfma_f32_32x32x16_bf16(P4_FRAG(8), ub0, O, 0, 0, 0); O = __builtin_amdgcn_mfma_f32_32x32x16_bf16(P4_FRAG(9), ub1, O, 0, 0, 0);
        S0 = __builtin_amdgcn_mfma_f32_32x32x16_bf16(P4_FRAG(14), ub0, S0, 0, 0, 0); S0 = __builtin_amdgcn_mfma_f32_32x32x16_bf16(P4_FRAG(15), ub1, S0, 0, 0, 0);
        S0 = __builtin_amdgcn_mfma_f32_32x32x16_bf16(P4_FRAG(16), vt0, S0, 0, 0, 0); S0 = __builtin_amdgcn_mfma_f32_32x32x16_bf16(P4_FRAG(17), vt1, S0, 0, 0, 0);
        S1 = __builtin_amdgcn_mfma_f32_32x32x16_bf16(P4_FRAG(18), ub0, S1, 0, 0, 0); S1 = __builtin_amdgcn_mfma_f32_32x32x16_bf16(P4_FRAG(19), ub1, S1, 0, 0, 0);
        S1 = __builtin_amdgcn_mfma_f32_32x32x16_bf16(P4_FRAG(20), vt0, S1, 0, 0, 0); S1 = __builtin_amdgcn_mfma_f32_32x32x16_bf16(P4_FRAG(21), vt1, S1, 0, 0, 0);
#pragma unroll
        for (int q = 0; q < 4; ++q) { const f32x4 p0 = *(const LAS f32x4*)(base + 24576 + (8 * q + 4 * h2) * 4), p1 = *(const LAS f32x4*)(base + 24576 + (32 + 8 * q + 4 * h2) * 4);
#pragma unroll
            for (int i = 0; i < 4; ++i) { S0[4 * q + i] *= p0[i]; S1[4 * q + i] *= p1[i]; }
            *(GAS f32x4*)(OT + ci * CL + 8 * q + 4 * h2) = (f32x4){O[4 * q], O[4 * q + 1], O[4 * q + 2], O[4 * q + 3]}; }
        LDS_WAIT();
    }
    VM_WAIT();
}

__device__ __forceinline__ void p5_phase(const Args& a, int wave, int lane, int vcu, int G) {
    const int gw = vcu * NWAVES + wave, NGW = G * NWAVES;
    const float* OT = (const float*)(a.ws + WS_OT); const bf16_t* Gb = (const bf16_t*)(a.ws + WS_G); const bf16_t* Vb = (const bf16_t*)(a.ws + WS_V);
    const float* BON = (const float*)(a.ws + WS_BON); bf16_t* Y = (bf16_t*)(a.ws + WS_YMIX);
    for (int un = gw; un < NBH * (SEQ / 64); un += NGW) {
        const int bh = un >> 5, tb = un & 31, t = tb * 64 + lane, b = bh >> 3, h = bh & 7;
        const size_t base = (size_t)bh * 64 * SEQ + t;
        const float o0 = OT[base]; float s = 0.f, q = 0.f;
#pragma unroll 16
        for (int nv = 0; nv < 64; ++nv) { const float d = OT[base + (size_t)nv * SEQ] - o0; s += d; q += d * d; }
        const float md = s * (1.f / 64.f), mean = o0 + md;
        const float rstd = 1.0f / sqrtf(fmaxf(q * (1.f / 64.f) - md * md, 0.f) + GN_EPS);
        const float bon = BON[(size_t)bh * SEQ + t];
        bf16_t* yp = Y + ((size_t)b * SEQ + t) * D + 512 + h * 64;
#pragma unroll 1
        for (int g8 = 0; g8 < 8; ++g8) { float y[8];
#pragma unroll
            for (int e = 0; e < 8; ++e) { const int nv = 8 * g8 + e; const float ov = OT[base + (size_t)nv * SEQ], v = bf2f(Vb[base + (size_t)nv * SEQ]), g = bf2f(Gb[base + (size_t)nv * SEQ]);
                y[e] = ((ov - mean) * rstd * a.in[I_LNW][h * 64 + nv] + a.in[I_LNB][h * 64 + nv] + bon * v) * g; }
            u32x4 w; w.x = pk2(y[0], y[1]); w.y = pk2(y[2], y[3]); w.z = pk2(y[4], y[5]); w.w = pk2(y[6], y[7]);
            *(GAS u32x4*)(yp + 8 * g8) = w; }
    }
}

__device__ __forceinline__ bool rt_better(float va, int ea, float vb, int eb) { return va > vb || (va == vb && ea < eb); }
__device__ __forceinline__ void p7_phase(const Args& a, LAS unsigned char* lds, int tid, int wave, int lane, int cw_cnt = CW_CNT) {
    LAS int* cntL = (LAS int*)lds;
    LAS int* baseL = cntL + 32;
    LAS int* rec = baseL + 32;
    const float* mod = (const float*)(a.ws + WS_MOD); bf16_t* U = (bf16_t*)(a.ws + WS_U);
    const float* H = a.out; const bf16_t* RWH = (const bf16_t*)(a.ws + WS_RWH);
    if (tid < 32) cntL[tid] = 0;
    __syncthreads();
    const int t = lane & 15, q = lane >> 4;
    const int row = blockIdx.x * 128 + wave * 16 + t, b = row >> 11;
    float inv;
    { const f32x4 p = *(const GAS f32x4*)((const float*)(a.ws + WS_RSS) + (size_t)row * 16 + 4 * q); float s = (p[0] + p[1]) + (p[2] + p[3]);
      s += __shfl_xor(s, 16); s += __shfl_xor(s, 32); inv = 1.0f / sqrtf(s * (1.f / D) + NORM_EPS); }
    const float* hp = H + (size_t)row * D + 8 * q; const float* gp = a.in[I_N2G] + 8 * q; const float* shp = mod + b * 6144 + 3072 + 8 * q; const float* scp = mod + b * 6144 + 4096 + 8 * q;
    bf16_t* up = U + (size_t)row * D + 8 * q; const bf16_t* wp = RWH + (size_t)t * 1024 + 8 * q;
    f32x4 acc0 = (f32x4){0.f, 0.f, 0.f, 0.f}, acc1 = acc0;
#pragma unroll 4
    for (int ks = 0; ks < 32; ++ks) {
        const int ko = 32 * ks;
        const f32x4 h0 = *(const GAS f32x4*)(hp + ko), h1 = *(const GAS f32x4*)(hp + ko + 4);
        const f32x4 g0 = *(const f32x4*)(gp + ko), g1 = *(const f32x4*)(gp + ko + 4), s0 = *(const f32x4*)(scp + ko), s1 = *(const f32x4*)(scp + ko + 4), b0 = *(const f32x4*)(shp + ko), b1 = *(const f32x4*)(shp + ko + 4);
        const bf16x8 ah0 = *(const GAS bf16x8*)(wp + ko), ah1 = *(const GAS bf16x8*)(wp + 16 * 1024 + ko), al0 = *(const GAS bf16x8*)(wp + 32 * 1024 + ko), al1 = *(const GAS bf16x8*)(wp + 48 * 1024 + ko);
        const f32x4 u0 = h0 * inv * g0 * (s0 + 1.0f) + b0, u1 = h1 * inv * g1 * (s1 + 1.0f) + b1;
        u32x4 hi; hi.x = pk2(u0[0], u0[1]); hi.y = pk2(u0[2], u0[3]); hi.z = pk2(u1[0], u1[1]); hi.w = pk2(u1[2], u1[3]);
        if (FP8_G3) { u32x2 w8; w8.x = pk4_fp8(u0[0], u0[1], u0[2], u0[3]); w8.y = pk4_fp8(u1[0], u1[1], u1[2], u1[3]); *(GAS u32x2*)((unsigned char*)U + (size_t)row * D + 8 * q + ko) = w8; }
        else *(GAS u32x4*)(up + ko) = hi;
        u32x4 lo; lo.x = pk2(u0[0] - bflo(hi.x), u0[1] - bfhi(hi.x)); lo.y = pk2(u0[2] - bflo(hi.y), u0[3] - bfhi(hi.y)); lo.z = pk2(u1[0] - bflo(hi.z), u1[1] - bfhi(hi.z)); lo.w = pk2(u1[2] - bflo(hi.w), u1[3] - bfhi(hi.w));
        const bf16x8 bh = __builtin_bit_cast(bf16x8, hi), bl = __builtin_bit_cast(bf16x8, lo);
        acc0 = __builtin_amdgcn_mfma_f32_16x16x32_bf16(ah0, bh, acc0, 0, 0, 0); acc0 = __builtin_amdgcn_mfma_f32_16x16x32_bf16(ah0, bl, acc0, 0, 0, 0); acc0 = __builtin_amdgcn_mfma_f32_16x16x32_bf16(al0, bh, acc0, 0, 0, 0);
        acc1 = __builtin_amdgcn_mfma_f32_16x16x32_bf16(ah1, bh, acc1, 0, 0, 0); acc1 = __builtin_amdgcn_mfma_f32_16x16x32_bf16(ah1, bl, acc1, 0, 0, 0); acc1 = __builtin_amdgcn_mfma_f32_16x16x32_bf16(al1, bh, acc1, 0, 0, 0);
    }
    float val[8]; int ex[8];
#pragma unroll
    for (int r = 0; r < 4; ++r) { ex[r] = 4 * q + r; ex[4 + r] = 16 + 4 * q + r; val[r] = acc0[r] + a.in[I_RB][4 * q + r]; val[4 + r] = acc1[r] + a.in[I_RB][16 + 4 * q + r]; }
    int ek[4]; float lk[4];
#pragma unroll
    for (int k = 0; k < 4; ++k) {
        float bv = val[0]; int be = ex[0];
#pragma unroll
        for (int r = 1; r < 8; ++r) if (rt_better(val[r], ex[r], bv, be)) { bv = val[r]; be = ex[r]; }
        { const float ov = __shfl_xor(bv, 16); const int oe = __shfl_xor(be, 16); if (rt_better(ov, oe, bv, be)) { bv = ov; be = oe; } }
        { const float ov = __shfl_xor(bv, 32); const int oe = __shfl_xor(be, 32); if (rt_better(ov, oe, bv, be)) { bv = ov; be = oe; } }
        ek[k] = be; lk[k] = bv;
#pragma unroll
        for (int r = 0; r < 8; ++r) if (ex[r] == be) val[r] = -INFINITY;
    }
    const float e1 = __expf(lk[1] - lk[0]), e2 = __expf(lk[2] - lk[0]), e3 = __expf(lk[3] - lk[0]); const float rs = 1.0f / (1.0f + e1 + e2 + e3);
    { const int e = q == 0 ? ek[0] : q == 1 ? ek[1] : q == 2 ? ek[2] : ek[3];
      const float g = (q == 0 ? 1.0f : q == 1 ? e1 : q == 2 ? e2 : e3) * rs;
      const int pos = atomicAdd((int*)&cntL[e], 1);
      LAS int* r = rec + ((wave * 16 + t) * 4 + q) * 3; r[0] = e; r[1] = pos; r[2] = __builtin_bit_cast(int, g); }
    __syncthreads();
    if (tid < 32) baseL[tid] = atomicAdd((int*)(a.ws + WS_CTL) + cw_cnt + tid, cntL[tid]);
    __syncthreads();
    { const LAS int* r = rec + tid * 3; const int e = r[0], slot = baseL[e] + r[1]; const int pair = (blockIdx.x * 128 + (tid >> 2)) * 4 + (tid & 3);
      ((GAS u32x2*)(a.ws + WS_LIST))[e * LCAP + slot] = (u32x2){(unsigned)pair, (unsigned)r[2]}; }
}

__device__ __forceinline__ void p10_phase(const Args& a, int wave, int lane, int vcu, int G, float* outp = nullptr) {
    const float* mod = (const float*)(a.ws + WS_MOD); const bf16_t* PAIR = (const bf16_t*)(a.ws + WS_PAIR);
    const int gw = vcu * NWAVES + wave, NGW = G * NWAVES;
    for (int row = gw; row < M; row += NGW) {
        const int b = row >> 11;
        GAS f32x4* hr = (GAS f32x4*)(a.out + (size_t)row * D) + lane; GAS f32x4* orow = outp ? (GAS f32x4*)(outp + (size_t)row * D) + lane : hr;
        const GAS u32x2* pp = (const GAS u32x2*)(PAIR + (size_t)row * 4 * D) + lane;
        f32x4 v[4]; float s = 0.f;
#pragma unroll
        for (int j = 0; j < 4; ++j) { const int col = 4 * lane + 256 * j; v[j] = hr[64 * j];
            f32x4 y = (f32x4){0.f, 0.f, 0.f, 0.f};
#pragma unroll
            for (int k = 0; k < 4; ++k) { const u32x2 w = pp[k * 256 + 64 * j]; y += (f32x4){bflo(w.x), bfhi(w.x), bflo(w.y), bfhi(w.y)}; }
            const f32x4 gt = *(const f32x4*)(mod + b * 6144 + 5120 + col);
            v[j] += gt * y; s += (v[j][0] * v[j][0] + v[j][1] * v[j][1]) + (v[j][2] * v[j][2] + v[j][3] * v[j][3]); }
        const float inv = 1.0f / sqrtf(wave_sum(s) * (1.f / D) + NORM_EPS);
#pragma unroll
        for (int j = 0; j < 4; ++j) { const f32x4 g = *(const f32x4*)(a.in[I_FG] + 4 * lane + 256 * j); orow[64 * j] = v[j] * inv * g; }
    }
}

constexpr int N_PHASES = 11;
__global__ void __launch_bounds__(NWAVES * 64, 2) hymba_fwd(Args a) {
    extern __shared__ __attribute__((aligned(16))) unsigned char lds_raw[];
    LAS unsigned char* lds = (LAS unsigned char*)lds_raw;
    volatile LAS unsigned* MISC = (volatile LAS unsigned*)(lds + LDS_MISC);
    const int tid = threadIdx.x, lane = tid & 63, wave = __builtin_amdgcn_readfirstlane(tid >> 6);
    const int G = gridDim.x; const int bx = blockIdx.x; const int vcu = (G % 8 == 0) ? (bx % 8) * (G / 8) + bx / 8 : bx;
    gu32* ctl = (gu32*)(a.ws + WS_CTL);
    if (tid < 128) MISC[tid] = 0u;
    __syncthreads();
    XcdBarrier bar; bar.bar = (unsigned*)(ctl + CW_BAR); bar.x = 0; bar.st = nullptr;
    if (MK_N_LAUNCHES == 1) bar = xcd_barrier_post((unsigned*)(ctl + CW_BAR), MISC + 8);
    const int lo = a.ph_lo, hi = a.ph_hi;
#ifndef PH_MASK
#define PH_MASK 0x7ff
#endif
#define IN(k) (((PH_MASK >> (k)) & 1) && lo <= (k) && (k) < hi)
#ifndef PROBE_DUP
#define PROBE_DUP -1
#endif
#define SEAM(k) do { if (IN(k) && IN((k) + 1)) xcd_barrier(bar); } while (0)
    if (IN(0)) { p0_phase(a, lds, tid, wave, lane, vcu, G); }
#if PROBE_DUP == 0
    __syncthreads();
    if (IN(0)) { p0_phase(a, lds, tid, wave, lane, vcu, G); }
#endif
    SEAM(0);
    if (IN(1)) { p1_phase(a, wave, lane, vcu, G); }
#if PROBE_DUP == 1
    if (IN(1)) { p1_phase(a, wave, lane, vcu, G); }
#endif
    SEAM(1);
    if (IN(2)) {
        DenseSched S{(const char*)(a.ws + WS_U), (const char*)(a.ws + WS_WIN), M / 256, NIN / 256, G, bx, (size_t)256 * 1024 * 2};
        EpiBf16 E{(bf16_t*)(a.ws + WS_PROJ), NIN};
        pg8::gemm_phase<EpiBf16, DenseSched, false, true>(lds, 1024, S, E);
    }
#if PROBE_DUP == 2
    if (IN(2)) {
        DenseSched S{(const char*)(a.ws + WS_U), (const char*)(a.ws + WS_WIN), M / 256, NIN / 256, G, bx, (size_t)256 * 1024 * 2};
        EpiBf16 E{(bf16_t*)(a.ws + WS_PROJ), NIN};
        pg8::gemm_phase<EpiBf16, DenseSched, false, true>(lds, 1024, S, E);
    }
#endif
    SEAM(2);
    if (IN(3)) { p3_phase(a, lds, tid, wave, lane, vcu, G); }
#if PROBE_DUP == 3
    if (IN(3)) { p3_phase(a, lds, tid, wave, lane, vcu, G); }
#endif
    SEAM(3);
    if (IN(4)) { p4_phase(a, lds, wave, lane, vcu, G); }
#if PROBE_DUP == 4
    if (IN(4)) { p4_phase(a, lds, wave, lane, vcu, G); }
#endif
    SEAM(4);
    if (IN(5)) { p5_phase(a, wave, lane, vcu, G); }
#if PROBE_DUP == 5
    if (IN(5)) { p5_phase(a, wave, lane, vcu, G); }
#endif
    SEAM(5);
    if (IN(6)) {
        DenseSched S{(const char*)(a.ws + WS_YMIX), (const char*)(a.ws + WS_WOUT), M / 256, D / 256, G, bx, (size_t)256 * 1024 * 2};
        EpiResid E{a.in[I_X], a.out, (const float*)(a.ws + WS_MOD), (float*)(a.ws + WS_RSS)};
        pg8::gemm_phase<EpiResid, DenseSched, false, true>(lds, 1024, S, E);
    }
#if PROBE_DUP == 6
    if (IN(6)) {
        DenseSched S{(const char*)(a.ws + WS_YMIX), (const char*)(a.ws + WS_WOUT), M / 256, D / 256, G, bx, (size_t)256 * 1024 * 2};
        EpiResid E{a.in[I_X], a.out, (const float*)(a.ws + WS_MOD), (float*)(a.ws + WS_RSS)};
        pg8::gemm_phase<EpiResid, DenseSched, false, true>(lds, 1024, S, E);
    }
#endif
    SEAM(6);
#if PROBE_DUP == 7
    if (IN(7)) { p7_phase(a, lds, tid, wave, lane, CW_CNT + 1024); __syncthreads(); }
#endif
    if (IN(7)) { p7_phase(a, lds, tid, wave, lane); }
    SEAM(7);
    volatile LAS int* bstart = (volatile LAS int*)(lds + LDS_MISC + 128);
    volatile LAS int* ecnt = bstart + 40;
    volatile LAS unsigned char* blk_e = (volatile LAS unsigned char*)(lds + LDS_MISC - 1024);
    if (IN(8) || IN(9)) {
        if (tid == 0) { int s = 0; for (int e = 0; e < NE; ++e) { const int c = (int)__hip_atomic_load(ctl + CW_CNT + e, RLX_AGENT); ecnt[e] = c; bstart[e] = s; s += (c + 255) >> 8; } bstart[NE] = s; }
        __syncthreads();
        for (int pm = tid; pm < bstart[NE]; pm += NWAVES * 64) { int e = 0; for (int j = 1; j < NE; ++j) e += (bstart[j] <= pm) ? 1 : 0; blk_e[pm] = (unsigned char)e; }
        __syncthreads();
    }
    if (IN(8)) {
        constexpr int EB = FP8_G3 ? 1 : 2;
        MoeSched S{(const char*)(a.ws + WS_U), (const char*)(a.ws + WS_W1T), (size_t)2048 * 1024 * EB, bstart[NE], 8, G, bx, (size_t)256 * 1024 * EB, bstart, ecnt, (const int*)(a.ws + WS_LIST), 1024 * EB, true, blk_e};
        EpiSwiglu<FP8_G4 != 0> E{(bf16_t*)(a.ws + WS_ACT), a.in[I_B1], &S};
        pg8::gemm_phase<EpiSwiglu<FP8_G4 != 0>, MoeSched, true, true, FP8_G3 != 0>(lds, 512 * EB, S, E);
    }
#if PROBE_DUP == 8
    if (IN(8)) {
        constexpr int EB = FP8_G3 ? 1 : 2;
        MoeSched S{(const char*)(a.ws + WS_U), (const char*)(a.ws + WS_W1T), (size_t)2048 * 1024 * EB, bstart[NE], 8, G, bx, (size_t)256 * 1024 * EB, bstart, ecnt, (const int*)(a.ws + WS_LIST), 1024 * EB, true, blk_e};
        EpiSwiglu<FP8_G4 != 0> E{(bf16_t*)(a.ws + WS_ACT), a.in[I_B1], &S};
        pg8::gemm_phase<EpiSwiglu<FP8_G4 != 0>, MoeSched, true, true, FP8_G3 != 0>(lds, 512 * EB, S, E);
    }
#endif
    SEAM(8);
    if (IN(9)) {
        constexpr int EB = FP8_G4 ? 1 : 2;
        MoeSched S{(const char*)(a.ws + WS_ACT), (const char*)(a.ws + WS_W2T), (size_t)1024 * 1024 * EB, bstart[NE], 4, G, bx, (size_t)256 * 1024 * EB, bstart, ecnt, (const int*)(a.ws + WS_LIST), 1024 * EB, false, blk_e};
        EpiPair E{(bf16_t*)(a.ws + WS_PAIR), a.in[I_B2], &S};
        pg8::gemm_phase<EpiPair, MoeSched, false, true, FP8_G4 != 0>(lds, 512 * EB, S, E);
    }
#if PROBE_DUP == 9
    if (IN(9)) {
        constexpr int EB = FP8_G4 ? 1 : 2;
        MoeSched S{(const char*)(a.ws + WS_ACT), (const char*)(a.ws + WS_W2T), (size_t)1024 * 1024 * EB, bstart[NE], 4, G, bx, (size_t)256 * 1024 * EB, bstart, ecnt, (const int*)(a.ws + WS_LIST), 1024 * EB, false, blk_e};
        EpiPair E{(bf16_t*)(a.ws + WS_PAIR), a.in[I_B2], &S};
        pg8::gemm_phase<EpiPair, MoeSched, false, true, FP8_G4 != 0>(lds, 512 * EB, S, E);
    }
#endif
    SEAM(9);
#if PROBE_DUP == 10
    if (IN(10)) { p10_phase(a, wave, lane, vcu, G, (float*)(a.ws + WS_U)); }
#endif
    if (IN(10)) { p10_phase(a, wave, lane, vcu, G); }
#undef IN
#undef SEAM
}

extern "C" void kernel_launch(void* const* d_in, const int* in_sizes, int n_in, void* d_out, int out_size, void* d_ws, size_t ws_size, hipStream_t stream) {
    static int grid = 0;
    if (grid == 0) {
        if (n_in != 28 || in_sizes[0] != M * D || out_size != M * D || ws_size < WS_END) { fprintf(stderr, "kernel_launch: unexpected shapes / workspace (n_in %d, ws %zu)\n", n_in, ws_size); grid = -1; return; }
        int dev = 0, cus = 0;
        if (hipGetDevice(&dev) != hipSuccess || hipDeviceGetAttribute(&cus, hipDeviceAttributeMultiprocessorCount, dev) != hipSuccess) { grid = -1; return; }
        if (hipFuncSetAttribute((const void*)hymba_fwd, hipFuncAttributeMaxDynamicSharedMemorySize, LDS_TOTAL) != hipSuccess) { fprintf(stderr, "kernel_launch: hipFuncSetAttribute failed\n"); grid = -1; return; }
        (void)hipGetLastError();
        grid = cus;
        if (grid != 256) fprintf(stderr, "kernel_launch: %d CUs (built for 256)\n", grid);
    }
    if (grid < 0) return;
    if (hipMemsetAsync((char*)d_ws + WS_CTL, 0, CTL_ZERO_BYTES, stream) != hipSuccess) return;
    Args a{};
    for (int i = 0; i < 28; ++i) a.in[i] = (const float*)d_in[i];
    a.out = (float*)d_out; a.ws = (unsigned char*)d_ws;
#if MK_N_LAUNCHES == 1
    a.ph_lo = 0; a.ph_hi = N_PHASES;
    hipLaunchKernelGGL(hymba_fwd, dim3(grid), dim3(NWAVES * 64), LDS_TOTAL, stream, a);
#else
    for (int p = 0; p < N_PHASES; ++p) { a.ph_lo = p; a.ph_hi = p + 1; hipLaunchKernelGGL(hymba_fwd, dim3(grid), dim3(NWAVES * 64), LDS_TOTAL, stream, a); }
#endif
}
```

```cpp
#include <hip/hip_runtime.h>
#include <cstdio>
#include <cstdint>

#ifndef MK_N_LAUNCHES
#define MK_N_LAUNCHES 1
#endif

#ifndef XPOSE_IN_P3
#define XPOSE_IN_P3 1
#endif
constexpr int XP3_PER = 2;
#ifndef FP8_G3
#define FP8_G3 1
#endif
#ifndef FP8_G4
#define FP8_G4 1
#endif
#define LAS __attribute__((address_space(3)))
#define GAS __attribute__((address_space(1)))
typedef unsigned short bf16_t;
typedef short bf16x8 __attribute__((ext_vector_type(8)));
typedef float f32x4 __attribute__((ext_vector_type(4)));
typedef float f32x16 __attribute__((ext_vector_type(16)));
typedef float f32x2 __attribute__((ext_vector_type(2)));
typedef unsigned u32x4 __attribute__((ext_vector_type(4)));
typedef int v8i __attribute__((ext_vector_type(8)));
typedef unsigned u32x2 __attribute__((ext_vector_type(2)));
typedef GAS unsigned gu32;
#define RLX_AGENT __ATOMIC_RELAXED, __HIP_MEMORY_SCOPE_AGENT
#define LDS_WAIT() asm volatile("s_waitcnt lgkmcnt(0)" ::: "memory")
#define VM_WAIT() asm volatile("s_waitcnt vmcnt(0)" ::: "memory")

constexpr int D = 1024, BATCH = 16, SEQ = 2048, M = BATCH * SEQ;
constexpr int NIN = 3328;
constexpr int COL_B = 0, COL_C = 512, COL_H = 1024, COL_R = 1536, COL_K = 2048, COL_V = 2560, COL_DW = 3072;
constexpr int NE = 32, LCAP = 32768;
constexpr int CL = 32, NCH = SEQ / CL;
constexpr int NBH = BATCH * 8;
constexpr float NORM_EPS = 1e-5f, GN_EPS = 64e-5f;
constexpr int CHB = 35840;
constexpr int CH_PL = 26624, CH_BON = 26624 + 256, CH_G = 27648, CH_V = 31744, CH_PIECES = 35;

constexpr size_t MiB = 1u << 20;
constexpr size_t WS_CTL = 0, CTL_ZERO_BYTES = 64 * 1024;
constexpr size_t WS_MOD = 1 * MiB;
constexpr size_t WS_LORA = 2 * MiB;
constexpr size_t WS_RWH = 2 * MiB + 512 * 1024;
constexpr size_t WS_WOUT = 3 * MiB;
constexpr size_t WS_WIN = 5 * MiB;
constexpr size_t WS_LIST = 12 * MiB;
constexpr size_t WS_W1T = 24 * MiB;
constexpr size_t WS_W2T = 152 * MiB;
constexpr size_t WS_U = 216 * MiB;
constexpr size_t WS_YMIX = 280 * MiB;
constexpr size_t WS_PROJ = 344 * MiB;
constexpr size_t WS_CH = 552 * MiB;
constexpr size_t WS_OT = 768 * MiB;
constexpr size_t WS_G = 832 * MiB;
constexpr size_t WS_V = 864 * MiB;
constexpr size_t WS_BON = 896 * MiB;
constexpr size_t WS_RSS = 897 * MiB;
constexpr size_t WS_ACT = 344 * MiB;
constexpr size_t WS_PAIR = 616 * MiB;
constexpr size_t WS_END = 900 * MiB;
constexpr int CW_TMO = 0;
constexpr int CW_CNT = 64;
constexpr int CW_BAR = 4096;

constexpr int RING_BYTES = 131072;
constexpr int MISC_OFF = 144 * 1024;
constexpr int LDS_BYTES = 147456;

__device__ __forceinline__ unsigned f2bf(float f) { unsigned u = __builtin_bit_cast(unsigned, f); return (u + 0x7fffu + ((u >> 16) & 1u)) >> 16; }
__device__ __forceinline__ unsigned pk2(float lo, float hi) { return f2bf(lo) | (f2bf(hi) << 16); }
__device__ __forceinline__ unsigned pk4_fp8(float a, float b, float c, float d) {
    int r = __builtin_amdgcn_cvt_pk_fp8_f32(a, b, 0, false); r = __builtin_amdgcn_cvt_pk_fp8_f32(c, d, r, true); return (unsigned)r; }
__device__ __forceinline__ float bf2f(unsigned short h) { return __builtin_bit_cast(float, (unsigned)h << 16); }
__device__ __forceinline__ float bflo(unsigned w) { return __builtin_bit_cast(float, w << 16); }
__device__ __forceinline__ float bfhi(unsigned w) { return __builtin_bit_cast(float, w & 0xffff0000u); }
#define DPP_QP1 0xB1
#define DPP_QP2 0x4E
#define DPP_HMIR 0x141
#define DPP_MIR 0x140
#define DPP_BC15 0x142
#define DPP_BC31 0x143
#define dpp_f(old, v, ctrl, rmask) __builtin_bit_cast(float, __builtin_amdgcn_update_dpp(__builtin_bit_cast(int, (float)(old)), __builtin_bit_cast(int, (float)(v)), ctrl, rmask, 0xf, false))
__device__ __forceinline__ float wave_sum(float v) {
    v += dpp_f(0.f, v, DPP_QP1, 0xf); v += dpp_f(0.f, v, DPP_QP2, 0xf); v += dpp_f(0.f, v, DPP_HMIR, 0xf); v += dpp_f(0.f, v, DPP_MIR, 0xf);
    v += dpp_f(0.f, v, DPP_BC15, 0xa); v += dpp_f(0.f, v, DPP_BC31, 0xc);
    return __builtin_bit_cast(float, __builtin_amdgcn_readlane(__builtin_bit_cast(int, v), 63));
}
__device__ __forceinline__ float wave_max(float v) {
    const float ninf = -INFINITY;
    v = fmaxf(v, dpp_f(ninf, v, DPP_QP1, 0xf)); v = fmaxf(v, dpp_f(ninf, v, DPP_QP2, 0xf)); v = fmaxf(v, dpp_f(ninf, v, DPP_HMIR, 0xf)); v = fmaxf(v, dpp_f(ninf, v, DPP_MIR, 0xf));
    v = fmaxf(v, dpp_f(ninf, v, DPP_BC15, 0xa)); v = fmaxf(v, dpp_f(ninf, v, DPP_BC31, 0xc));
    return __builtin_bit_cast(float, __builtin_amdgcn_readlane(__builtin_bit_cast(int, v), 63));
}
__device__ __forceinline__ float fast_sigmoid(float x) { return __builtin_amdgcn_rcpf(1.0f + __expf(-x)); }
__device__ __forceinline__ bf16x8 pack8(float a0, float a1, float a2, float a3, float a4, float a5, float a6, float a7) {
    u32x4 w; w.x = pk2(a0, a1); w.y = pk2(a2, a3); w.z = pk2(a4, a5); w.w = pk2(a6, a7); return __builtin_bit_cast(bf16x8, w);
}

#define XB_TMO      128
#define XB_XCNT(j)  (256  + 64 * (j))
#define XB_XSUB(j)  (1280 + 64 * (j))
#define XB_XGEN(j)  (2304 + 64 * (j))
#define XB_TOP      3328
#define XB_TOPGEN   3392
#define XCD_BAR_WORDS 3456
#define XB_SPIN_CAP (1u << 20)
__device__ __forceinline__ unsigned xb_ld(unsigned* p)              { return __hip_atomic_load(p, __ATOMIC_RELAXED, __HIP_MEMORY_SCOPE_AGENT); }
__device__ __forceinline__ unsigned xb_add(unsigned* p, unsigned v) { return __hip_atomic_fetch_add(p, v, __ATOMIC_RELAXED, __HIP_MEMORY_SCOPE_AGENT); }
__device__ __forceinline__ unsigned xb_xcc_id() { return (unsigned)__builtin_amdgcn_s_getreg((3 << 11) | 20) & 0xFu; }
#define XB_SPIN(cond, bar) do { unsigned _sp = 0; while (cond) { __builtin_amdgcn_s_sleep(1); \
    if ((++_sp & 255u) == 0u) { if (xb_ld(&(bar)[XB_TMO])) break; if (_sp > XB_SPIN_CAP) { atomicAdd(&(bar)[XB_TMO], 1u); break; } } } } while (0)
struct XcdBarrier { unsigned* bar; unsigned x; volatile LAS unsigned* st; };
__device__ __forceinline__ XcdBarrier xcd_barrier_post(unsigned* bar, volatile LAS unsigned* st) {
    XcdBarrier b; b.bar = bar; b.x = xb_xcc_id(); b.st = st;
    if (threadIdx.x == 0) (void)xb_add(&bar[XB_XCNT(b.x)], 1u);
    return b;
}
__device__ __forceinline__ void xcd_barrier_complete(unsigned* bar, unsigned x, unsigned& nloc, unsigned& nx) {
    const unsigned G = gridDim.x * gridDim.y * gridDim.z;
    unsigned sum, cnt, mine, sp = 0u;
    for (;;) {
        sum = 0u; cnt = 0u; mine = 0u;
#pragma unroll
        for (unsigned j = 0; j < 16; ++j) { const unsigned c = xb_ld(&bar[XB_XCNT(j)]); sum += c; cnt += (c > 0u) ? 1u : 0u; mine = (j == x) ? c : mine; }
        if (sum == G) break;
        __builtin_amdgcn_s_sleep(1);
        if ((++sp & 255u) == 0u) { if (xb_ld(&bar[XB_TMO])) break; if (sp > XB_SPIN_CAP) { atomicAdd(&bar[XB_TMO], 1u); break; } }
    }
    nloc = mine > 0u ? mine : 1u; nx = cnt > 0u ? cnt : 1u;
}
__device__ __forceinline__ void xcd_barrier(const XcdBarrier& b) {
    asm volatile("s_waitcnt vmcnt(0)" ::: "memory");
    __syncthreads();
    if (threadIdx.x == 0) {
        unsigned* bar = b.bar;
        __builtin_amdgcn_s_waitcnt(0);
        unsigned nloc = b.st[0], nx = b.st[1];
        if (nloc == 0u) { xcd_barrier_complete(bar, b.x, nloc, nx); b.st[0] = nloc; b.st[1] = nx; }
        const unsigned old = xb_add(&bar[XB_XSUB(b.x)], 1u);
        const unsigned gen = old / nloc;
        if (old + 1u == (gen + 1u) * nloc) {
            __builtin_amdgcn_fence(__ATOMIC_RELEASE, "agent");
            asm volatile("s_waitcnt vmcnt(0)" ::: "memory");
            const unsigned og = xb_add(&bar[XB_TOP], 1u);
            const unsigned tg = og / nx;
            if (og + 1u == (tg + 1u) * nx) xb_add(&bar[XB_TOPGEN], 1u);
            else XB_SPIN(xb_ld(&bar[XB_TOPGEN]) == tg, bar);
            __builtin_amdgcn_fence(__ATOMIC_ACQUIRE, "agent");
            xb_add(&bar[XB_XGEN(b.x)], 1u);
            asm volatile("s_waitcnt vmcnt(0)" ::: "memory");
        } else {
            XB_SPIN(xb_ld(&bar[XB_XGEN(b.x)]) == gen, bar);
            __builtin_amdgcn_fence(__ATOMIC_ACQUIRE, "agent");
            asm volatile("s_waitcnt vmcnt(0)" ::: "memory");
        }
    }
    __syncthreads();
}

namespace pg8 {
constexpr int BM = 256, BK = 64, HALF = 128, HTB = HALF * BK * 2, NXCD = 8, WGM = 8;
__host__ __device__ __forceinline__ int lds_byte(int r, int c) { const int st = (r >> 4) * 2 + (c >> 5), rr = r & 15, cc = c & 31, ob = rr * 64 + cc * 2; return st * 1024 + (ob ^ (((ob >> 9) & 1) << 5)); }
__host__ __device__ __forceinline__ void stage_rc(int b, int& R, int& C) { const int st = b / 1024, sb = b % 1024, swz = sb ^ (((sb >> 9) & 1) << 5); R = (st >> 1) * 16 + swz / 64; C = (st & 1) * 32 + (swz % 64) / 2; }
__host__ __device__ __forceinline__ int perm32(int rho) { const int n = rho >> 4, i = rho & 15; return 8 * (i >> 2) + 4 * n + (i & 3); }
struct Unit { int pm, pn; };
__device__ __forceinline__ bool tile_order(int i, int G, int c, int nM, int nN, Unit& u) {
    const int nwg = nM * nN; const long L = (long)i * G + c; if (L >= nwg) return false;
    int wgid = (int)L; { const int q = nwg / NXCD, r = nwg % NXCD, xcd = wgid % NXCD, off = wgid / NXCD; wgid = (xcd < r ? xcd * (q + 1) : r * (q + 1) + (xcd - r) * q) + off; }
    const int nig = WGM * nN, gid = wgid / nig, fm = gid * WGM, gsz = (nM - fm) < WGM ? (nM - fm) : WGM;
    u.pm = fm + ((wgid % nig) % gsz); u.pn = (wgid % nig) / gsz; return true;
}
__device__ __forceinline__ unsigned cvt_pk_bf16(float lo, float hi) { unsigned r; asm volatile("v_cvt_pk_bf16_f32 %0, %1, %2" : "=v"(r) : "v"(lo), "v"(hi)); return r; }

template <class Epi, class Sched, bool GATHER, bool ALIGN_EPI, bool FP8 = false>
__device__ __forceinline__ void gemm_phase(LAS unsigned char* lds, const int K, const Sched& S, const Epi& E) {
    const int tid = threadIdx.x, wid = __builtin_amdgcn_readfirstlane(tid >> 6), lane = tid & 63, wr = wid >> 2, wc = wid & 3, fr = lane & 15, fq = lane >> 4;
    int nt = K / BK; asm volatile("" : "+s"(nt));
    unsigned voffA[2], voffB[2]; int rowA[2];
#pragma unroll
    for (int i = 0; i < 2; ++i) { int R, C; stage_rc(tid * 16 + i * 8192, R, C); const int Rb = Epi::PERM ? ((R & ~31) + perm32(R & 31)) : R;
        voffA[i] = (unsigned)(R * K + C) * 2u; voffB[i] = (unsigned)(Rb * K + C) * 2u; rowA[i] = R; if (GATHER) voffA[i] = (unsigned)C * 2u; }
    const size_t kstep = (size_t)(BK * 2);
    const size_t hstep = (size_t)HALF * K * 2;
    const unsigned ldsw = (unsigned)wid * 1024u;
    const int aoff = lds_byte(wr * 64 + fr, fq * 8), boff = lds_byte(wc * 32 + fr, fq * 8);
    const int sw8 = (fq >> 1) * 1024 + fr * 64 + ((((fq & 1) ^ (fr >> 3))) << 5);
    const int aoff8 = wr * 8192 + sw8, boff8 = wc * 4096 + sw8;
#define PG8_SA(b, h) (((b) * 2 + (h)) * HTB)
#define PG8_SB(b, h) ((4 + (b) * 2 + (h)) * HTB)
#define PG8_STAGE2(bufoff, gbase, o0, o1) do { \
        __builtin_amdgcn_global_load_lds((const unsigned*)((const char*)(gbase) + (o0)), (LAS unsigned*)(lds + (bufoff) + ldsw), 16, 0, 0); \
        __builtin_amdgcn_global_load_lds((const unsigned*)((const char*)(gbase) + (o1)), (LAS unsigned*)(lds + (bufoff) + ldsw + 8192), 16, 0, 0); } while (0)
#define PG8_STAGEB(bufoff, gbase) PG8_STAGE2(bufoff, gbase, voffB[0], voffB[1])
#define PG8_STAGEA(bufoff, kp, hh, OS) do { if (GATHER) PG8_STAGE2(bufoff, kp, OS[hh][0], OS[hh][1]); else PG8_STAGE2(bufoff, (kp) + (hh) * hstep, voffA[0], voffA[1]); } while (0)
#define PG8_LDA(dst, b, h) do { _Pragma("unroll") for (int m = 0; m < 4; ++m) _Pragma("unroll") for (int k = 0; k < 2; ++k) dst[m][k] = *(const LAS bf16x8*)(lds + PG8_SA(b, h) + aoff + m * 2048 + k * 1024); } while (0)
#define PG8_LDB(dst, b, h) do { _Pragma("unroll") for (int n = 0; n < 2; ++n) _Pragma("unroll") for (int k = 0; k < 2; ++k) dst[n][k] = *(const LAS bf16x8*)(lds + PG8_SB(b, h) + boff + n * 2048 + k * 1024); } while (0)
#define PG8_MMA(ai, bj, At, Bt) do { __builtin_amdgcn_s_setprio(1); _Pragma("unroll") for (int m = 0; m < 4; ++m) _Pragma("unroll") for (int n = 0; n < 2; ++n) _Pragma("unroll") for (int k = 0; k < 2; ++k) \
        acc[ai][bj][m][n] = __builtin_amdgcn_mfma_f32_16x16x32_bf16(Bt[n][k], At[m][k], acc[ai][bj][m][n], 0, 0, 0); __builtin_amdgcn_s_setprio(0); } while (0)
#define PG8_LDA8(dst, b, h) do { _Pragma("unroll") for (int m = 0; m < 4; ++m) { const u32x4 _x = *(const LAS u32x4*)(lds + PG8_SA(b, h) + aoff8 + m * 2048), _y = *(const LAS u32x4*)(lds + PG8_SA(b, h) + aoff8 + m * 2048 + 16); \
        dst[m] = (v8i){(int)_x.x, (int)_x.y, (int)_x.z, (int)_x.w, (int)_y.x, (int)_y.y, (int)_y.z, (int)_y.w}; } } while (0)
#define PG8_LDB8(dst, b, h) do { _Pragma("unroll") for (int n = 0; n < 2; ++n) { const u32x4 _x = *(const LAS u32x4*)(lds + PG8_SB(b, h) + boff8 + n * 2048), _y = *(const LAS u32x4*)(lds + PG8_SB(b, h) + boff8 + n * 2048 + 16); \
        dst[n] = (v8i){(int)_x.x, (int)_x.y, (int)_x.z, (int)_x.w, (int)_y.x, (int)_y.y, (int)_y.z, (int)_y.w}; } } while (0)
#define PG8_MMA8(ai, bj, At, Bt) do { __builtin_amdgcn_s_setprio(1); asm volatile("s_nop 1" ::: "memory"); _Pragma("unroll") for (int m = 0; m < 4; ++m) _Pragma("unroll") for (int n = 0; n < 2; ++n) \
        asm volatile("v_mfma_f32_16x16x128_f8f6f4 %0, %1, %2, %0" : "+v"(acc[ai][bj][m][n]) : "v"(Bt[n]), "v"(At[m])); __builtin_amdgcn_s_setprio(0); } while (0)
#define PG8_WAIT_V(n) asm volatile("s_waitcnt vmcnt(" #n ")" ::: "memory")
#define PG8_WAIT_L(n) asm volatile("s_waitcnt lgkmcnt(" #n ")" ::: "memory")
#define PG8_BAR __builtin_amdgcn_s_barrier()
#define PG8_SCHED __builtin_amdgcn_sched_barrier(0)
    Unit cur, nxt; int ui = 0;
    if (!S.next(0, cur)) return;
    f32x4 acc[2][2][4][2];
#pragma unroll
    for (int a = 0; a < 2; ++a)
#pragma unroll
        for (int b = 0; b < 2; ++b)
#pragma unroll
            for (int m = 0; m < 4; ++m)
#pragma unroll
                for (int n = 0; n < 2; ++n) acc[a][b][m][n] = (f32x4){0.f, 0.f, 0.f, 0.f};
    bf16x8 At[4][2], B0[2][2], B1[2][2];
    v8i At8[4], B08[2], B18[2];
    unsigned gC[2][2], gN[2][2];
    const char* cA = S.a_base(cur); const char* cB = S.b_base(cur);
    if (GATHER) { S.a_rows(cur, rowA, gC);
#pragma unroll
        for (int h = 0; h < 2; ++h)
#pragma unroll
            for (int i = 0; i < 2; ++i) gC[h][i] += voffA[i]; }
    PG8_STAGEB(PG8_SB(0, 0), cB); PG8_STAGEB(PG8_SB(0, 1), cB + hstep); PG8_STAGEA(PG8_SA(0, 0), cA, 0, gC); PG8_STAGEA(PG8_SA(0, 1), cA, 1, gC);
    if (wr == 1) PG8_BAR;
    PG8_WAIT_V(2); PG8_BAR;
    PG8_STAGEB(PG8_SB(1, 0), cB + kstep); PG8_STAGEA(PG8_SA(1, 0), cA + kstep, 0, gC); PG8_STAGEB(PG8_SB(1, 1), cB + hstep + kstep);
    PG8_WAIT_V(6); PG8_BAR;
    for (;;) {
        const bool has_next = S.next(ui + 1, nxt);
        const char* nA = has_next ? S.a_base(nxt) : cA; const char* nB = has_next ? S.b_base(nxt) : cB;
        if (GATHER) { if (has_next) { S.a_rows(nxt, rowA, gN);
#pragma unroll
                for (int h = 0; h < 2; ++h)
#pragma unroll
                    for (int i = 0; i < 2; ++i) gN[h][i] += voffA[i]; }
            else {
#pragma unroll
                for (int h = 0; h < 2; ++h)
#pragma unroll
                    for (int i = 0; i < 2; ++i) gN[h][i] = gC[h][i]; } }
        for (int t = 0; t < nt; t += 2) {
            const bool last = (t == nt - 2);
            const char* a1 = cA + (size_t)(t + 1) * kstep;
            const char* a2 = last ? nA : cA + (size_t)(t + 2) * kstep; const char* b2 = last ? nB : cB + (size_t)(t + 2) * kstep;
            const char* a3 = a2 + kstep; const char* b3 = b2 + kstep;
            unsigned g2[2][2];
            if (GATHER) {
#pragma unroll
                for (int h = 0; h < 2; ++h)
#pragma unroll
                    for (int i = 0; i < 2; ++i) g2[h][i] = last ? gN[h][i] : gC[h][i]; }
            if constexpr (!FP8) {
            PG8_LDB(B0, 0, 0); PG8_LDB(B1, 0, 1); PG8_SCHED; PG8_LDA(At, 0, 0); PG8_STAGEA(PG8_SA(1, 1), a1, 1, gC);
            PG8_WAIT_V(8); PG8_WAIT_L(0); PG8_BAR; PG8_MMA(0, 0, At, B0); PG8_MMA(0, 1, At, B1); PG8_BAR; PG8_SCHED;
            PG8_LDA(At, 0, 1); PG8_STAGEB(PG8_SB(0, 0), b2); PG8_STAGEB(PG8_SB(0, 1), b2 + hstep); PG8_STAGEA(PG8_SA(0, 0), a2, 0, g2);
            PG8_WAIT_V(8); PG8_WAIT_L(0); PG8_BAR; PG8_MMA(1, 0, At, B0); PG8_MMA(1, 1, At, B1); PG8_BAR; PG8_SCHED;
            PG8_LDB(B0, 1, 0); PG8_LDB(B1, 1, 1); PG8_SCHED; PG8_LDA(At, 1, 0); PG8_STAGEA(PG8_SA(0, 1), a2, 1, g2);
            PG8_WAIT_V(8); PG8_WAIT_L(0); PG8_BAR; PG8_MMA(0, 0, At, B0); PG8_MMA(0, 1, At, B1); PG8_BAR; PG8_SCHED;
            PG8_LDA(At, 1, 1); PG8_STAGEB(PG8_SB(1, 0), b3); PG8_STAGEB(PG8_SB(1, 1), b3 + hstep); PG8_STAGEA(PG8_SA(1, 0), a3, 0, g2);
            PG8_WAIT_V(8); PG8_WAIT_L(0); PG8_BAR; PG8_MMA(1, 0, At, B0); PG8_MMA(1, 1, At, B1); PG8_BAR; PG8_SCHED;
            } else {
            PG8_LDB8(B08, 0, 0); PG8_LDB8(B18, 0, 1); PG8_SCHED; PG8_LDA8(At8, 0, 0); PG8_STAGEA(PG8_SA(1, 1), a1, 1, gC);
            PG8_WAIT_V(8); PG8_WAIT_L(0); PG8_BAR; PG8_MMA8(0, 0, At8, B08); PG8_MMA8(0, 1, At8, B18); PG8_BAR; PG8_SCHED;
            PG8_LDA8(At8, 0, 1); PG8_STAGEB(PG8_SB(0, 0), b2); PG8_STAGEB(PG8_SB(0, 1), b2 + hstep); PG8_STAGEA(PG8_SA(0, 0), a2, 0, g2);
            PG8_WAIT_V(8); PG8_WAIT_L(0); PG8_BAR; PG8_MMA8(1, 0, At8, B08); PG8_MMA8(1, 1, At8, B18); PG8_BAR; PG8_SCHED;
            PG8_LDB8(B08, 1, 0); PG8_LDB8(B18, 1, 1); PG8_SCHED; PG8_LDA8(At8, 1, 0); PG8_STAGEA(PG8_SA(0, 1), a2, 1, g2);
            PG8_WAIT_V(8); PG8_WAIT_L(0); PG8_BAR; PG8_MMA8(0, 0, At8, B08); PG8_MMA8(0, 1, At8, B18); PG8_BAR; PG8_SCHED;
            PG8_LDA8(At8, 1, 1); PG8_STAGEB(PG8_SB(1, 0), b3); PG8_STAGEB(PG8_SB(1, 1), b3 + hstep); PG8_STAGEA(PG8_SA(1, 0), a3, 0, g2);
            PG8_WAIT_V(8); PG8_WAIT_L(0); PG8_BAR; PG8_MMA8(1, 0, At8, B08); PG8_MMA8(1, 1, At8, B18); PG8_BAR; PG8_SCHED;
            }
        }
        if constexpr (ALIGN_EPI) { if (wr == 0) PG8_BAR; }
        if constexpr (FP8) asm volatile("s_nop 15\n\ts_nop 15" ::: "memory");
        E(acc, cur, wr, wc, fr, fq);
        if (!has_next) break;
#pragma unroll
        for (int a = 0; a < 2; ++a)
#pragma unroll
            for (int b = 0; b < 2; ++b)
#pragma unroll
                for (int m = 0; m < 4; ++m)
#pragma unroll
                    for (int n = 0; n < 2; ++n) acc[a][b][m][n] = (f32x4){0.f, 0.f, 0.f, 0.f};
        cur = nxt; cA = nA; cB = nB; ++ui;
        if (GATHER) {
#pragma unroll
            for (int h = 0; h < 2; ++h)
#pragma unroll
                for (int i = 0; i < 2; ++i) gC[h][i] = gN[h][i]; }
        if constexpr (ALIGN_EPI) { if (wr == 1) PG8_BAR; }
    }
    PG8_WAIT_V(0);
    if constexpr (!ALIGN_EPI) { if (wr == 0) PG8_BAR; }
    PG8_BAR;
#undef PG8_SA
#undef PG8_SB
#undef PG8_STAGE2
#undef PG8_STAGEA
#undef PG8_STAGEB
#undef PG8_LDA
#undef PG8_LDB
#undef PG8_MMA
#undef PG8_LDA8
#undef PG8_LDB8
#undef PG8_MMA8
#undef PG8_WAIT_V
#undef PG8_WAIT_L
#undef PG8_BAR
#undef PG8_SCHED
}
}
using pg8::Unit;

struct DenseSched {
    const char* A; const char* Bt; int nM, nN, G, c; size_t tstep;
    __device__ __forceinline__ bool next(int i, Unit& u) const { return pg8::tile_order(i, G, c, nM, nN, u); }
    __device__ __forceinline__ const char* a_base(const Unit& u) const { return A + (size_t)u.pm * tstep; }
    __device__ __forceinline__ const char* b_base(const Unit& u) const { return Bt + (size_t)u.pn * tstep; }
    __device__ __forceinline__ void a_rows(const Unit&, const int (&)[2], unsigned (&)[2][2]) const {}
};
struct MoeSched {
    const char* A; const char* Wt; size_t estride; int nM, nN, G, c; size_t tstep;
    const volatile LAS int* bstart; const volatile LAS int* cnt; const int* list; int K2; bool gather;
    const volatile LAS unsigned char* blk_e;
    __device__ __forceinline__ int expert_of(int pm) const { return (int)blk_e[pm]; }
    __device__ __forceinline__ bool next(int i, Unit& u) const { return pg8::tile_order(i, G, c, nM, nN, u); }
    __device__ __forceinline__ const char* a_base(const Unit& u) const { return gather ? A : A + (size_t)u.pm * tstep; }
    __device__ __forceinline__ const char* b_base(const Unit& u) const { const int e = expert_of(u.pm); return Wt + (size_t)e * estride + (size_t)u.pn * tstep; }
    __device__ __forceinline__ void a_rows(const Unit& u, const int (&rowA)[2], unsigned (&o)[2][2]) const {
        const int e = expert_of(u.pm), rb = u.pm - bstart[e], n = cnt[e];
#pragma unroll
        for (int h = 0; h < 2; ++h)
#pragma unroll
            for (int i = 0; i < 2; ++i) { const int idx = rb * 256 + h * 128 + rowA[i]; int tok = 0; if (idx < n) tok = list[2 * (e * LCAP + idx)] >> 2; o[h][i] = (unsigned)tok * (unsigned)K2; }
    }
};

struct EpiBf16 {
    static constexpr bool PERM = true;
    bf16_t* O; int ldc;
    __device__ __forceinline__ void operator()(const f32x4 (&acc)[2][2][4][2], const Unit& u, int wr, int wc, int fr, int fq) const {
        const int row0 = u.pm * 256 + wr * 64 + fr, col0 = u.pn * 256 + wc * 32 + 8 * fq;
#pragma unroll
        for (int ai = 0; ai < 2; ++ai)
#pragma unroll
            for (int m = 0; m < 4; ++m) { bf16_t* rowp = O + (size_t)(row0 + ai * 128 + m * 16) * ldc + col0;
#pragma unroll
                for (int bj = 0; bj < 2; ++bj) { const f32x4 v0 = acc[ai][bj][m][0], v1 = acc[ai][bj][m][1];
                    u32x4 w; w.x = pg8::cvt_pk_bf16(v0[0], v0[1]); w.y = pg8::cvt_pk_bf16(v0[2], v0[3]); w.z = pg8::cvt_pk_bf16(v1[0], v1[1]); w.w = pg8::cvt_pk_bf16(v1[2], v1[3]);
                    *(u32x4*)(rowp + bj * 128) = w; } }
    }
};
struct EpiResid {
    static constexpr bool PERM = false;
    const float* X; float* H; const float* mod; float* RSS;
    __device__ __forceinline__ void operator()(const f32x4 (&acc)[2][2][4][2], const Unit& u, int wr, int wc, int fr, int fq) const {
        const int b = (u.pm * 256) >> 11; const int col0 = u.pn * 256 + wc * 32 + 4 * fq;
        f32x4 gt[2][2];
#pragma unroll
        for (int bj = 0; bj < 2; ++bj)
#pragma unroll
            for (int n = 0; n < 2; ++n) gt[bj][n] = *(const f32x4*)(mod + b * 6144 + 2048 + col0 + bj * 128 + n * 16);
#pragma unroll
        for (int ai = 0; ai < 2; ++ai)
#pragma unroll
            for (int m = 0; m < 4; ++m) { const int row = u.pm * 256 + ai * 128 + wr * 64 + m * 16 + fr; const size_t off = (size_t)row * D + col0; float ss = 0.f;
#pragma unroll
                for (int bj = 0; bj < 2; ++bj)
#pragma unroll
                    for (int n = 0; n < 2; ++n) { const f32x4 xv = *(const f32x4*)(X + off + bj * 128 + n * 16); const f32x4 hv = xv + gt[bj][n] * acc[ai][bj][m][n];
                        *(f32x4*)(H + off + bj * 128 + n * 16) = hv; ss += (hv[0] * hv[0] + hv[1] * hv[1]) + (hv[2] * hv[2] + hv[3] * hv[3]); }
                ss += __shfl_xor(ss, 16); ss += __shfl_xor(ss, 32);
                if (fq == 0) RSS[(size_t)row * 16 + u.pn * 4 + wc] = ss; }
    }
};
template <bool OUT8> struct EpiSwiglu {
    static constexpr bool PERM = true;
    bf16_t* ACT; const float* b1; const MoeSched* S;
    __device__ __forceinline__ void operator()(const f32x4 (&acc)[2][2][4][2], const Unit& u, int wr, int wc, int fr, int fq) const {
        const int e = S->expert_of(u.pm);
        const int row0 = u.pm * 256 + wr * 64 + fr, col0 = u.pn * 256 + wc * 32 + 8 * fq;
        f32x4 bv[2][2];
#pragma unroll
        for (int bj = 0; bj < 2; ++bj)
#pragma unroll
            for (int n = 0; n < 2; ++n) bv[bj][n] = *(const f32x4*)(b1 + (size_t)e * 2048 + col0 + bj * 128 + 4 * n);
#pragma unroll
        for (int ai = 0; ai < 2; ++ai)
#pragma unroll
            for (int m = 0; m < 4; ++m) { bf16_t* rowp = ACT + (size_t)(row0 + ai * 128 + m * 16) * 1024 + (col0 >> 1);
#pragma unroll
                for (int bj = 0; bj < 2; ++bj) { float a[4];
#pragma unroll
                    for (int n = 0; n < 2; ++n) { const f32x4 v = acc[ai][bj][m][n] + bv[bj][n];
#pragma unroll
                        for (int p = 0; p < 2; ++p) { const float g = fminf(v[2 * p], 7.0f), l = fminf(fmaxf(v[2 * p + 1], -7.0f), 7.0f);
                            a[2 * n + p] = g * fast_sigmoid(1.702f * g) * (l + 1.0f); } }
                    if constexpr (OUT8) { *(unsigned*)((unsigned char*)ACT + (size_t)(row0 + ai * 128 + m * 16) * 1024 + (col0 >> 1) + bj * 64) = pk4_fp8(a[0], a[1], a[2], a[3]); }
                    else { u32x2 w; w.x = pg8::cvt_pk_bf16(a[0], a[1]); w.y = pg8::cvt_pk_bf16(a[2], a[3]); *(u32x2*)(rowp + bj * 64) = w; } } }
    }
};
struct EpiPair {
    static constexpr bool PERM = true;
    bf16_t* PAIR; const float* b2; const MoeSched* S;
    __device__ __forceinline__ void operator()(const f32x4 (&acc)[2][2][4][2], const Unit& u, int wr, int wc, int fr, int fq) const {
        const int e = S->expert_of(u.pm), rb = u.pm - S->bstart[e], n_e = S->cnt[e];
        const int col0 = u.pn * 256 + wc * 32 + 8 * fq;
        f32x4 bv[2][2];
#pragma unroll
        for (int bj = 0; bj < 2; ++bj)
#pragma unroll
            for (int n = 0; n < 2; ++n) bv[bj][n] = *(const f32x4*)(b2 + (size_t)e * 1024 + col0 + bj * 128 + 4 * n);
#pragma unroll
        for (int ai = 0; ai < 2; ++ai)
#pragma unroll
            for (int m = 0; m < 4; ++m) { const int idx = rb * 256 + ai * 128 + wr * 64 + m * 16 + fr;
                if (idx < n_e) { const u32x2 rec = *(const GAS u32x2*)(S->list + 2 * (e * LCAP + idx)); const int pair = (int)rec.x; const unsigned gb = rec.y; const float g = __uint_as_float(gb);     bf16_t* rowp = PAIR + (size_t)pair * 1024 + col0;
#pragma unroll
                    for (int bj = 0; bj < 2; ++bj) { const f32x4 v0 = (acc[ai][bj][m][0] + bv[bj][0]) * g, v1 = (acc[ai][bj][m][1] + bv[bj][1]) * g;
                        u32x4 w; w.x = pg8::cvt_pk_bf16(v0[0], v0[1]); w.y = pg8::cvt_pk_bf16(v0[2], v0[3]); w.z = pg8::cvt_pk_bf16(v1[0], v1[1]); w.w = pg8::cvt_pk_bf16(v1[2], v1[3]);
                        *(u32x4*)(rowp + bj * 128) = w; } } }
    }
};

struct Args { const float* in[28]; float* out; unsigned char* ws; int ph_lo, ph_hi; };
enum { I_X = 0, I_C, I_ADAW, I_ADAB, I_N1G, I_WIN, I_CONVW, I_CONVGN, I_MU, I_W0, I_WUP, I_A0, I_AUP, I_GUP, I_KK, I_KA, I_RK, I_LNW, I_LNB, I_WOUT, I_N2G, I_RW, I_RB, I_W1, I_B1, I_W2, I_B2, I_FG };
constexpr int NWAVES = 8;
constexpr int LDS_TOTAL = 163840;
constexpr int LDS_MISC = LDS_TOTAL - 512;

__device__ __forceinline__ void p0_mod_unit(const Args& a, int u, LAS unsigned char* lds, int tid) {
    LAS float* cact = (LAS float*)lds; LAS float* red = (LAS float*)(lds + 65536);
    const float* c = a.in[I_C];
    for (int i = tid; i < 16 * 1024; i += 512) { const float v = c[i]; cact[i] = v * fast_sigmoid(v); }
    __syncthreads();
    const int kq = tid >> 5, col = tid & 31;
    float acc[16];
#pragma unroll
    for (int b = 0; b < 16; ++b) acc[b] = 0.f;
    const float* w = a.in[I_ADAW] + (size_t)(kq * 64) * 6144 + u * 32 + col;
#pragma unroll 4
    for (int k = 0; k < 64; ++k) { const float wv = w[(size_t)k * 6144];
#pragma unroll
        for (int b = 0; b < 16; ++b) acc[b] += cact[b * 1024 + kq * 64 + k] * wv; }
#pragma unroll
    for (int b = 0; b < 16; ++b) red[(kq * 16 + b) * 32 + col] = acc[b];
    __syncthreads();
    { const int b = tid >> 5; float s = a.in[I_ADAB][u * 32 + col];
#pragma unroll
      for (int q = 0; q < 16; ++q) s += red[(q * 16 + b) * 32 + col];
      ((float*)(a.ws + WS_MOD))[b * 6144 + u * 32 + col] = s; }
    __syncthreads();
}
__device__ __forceinline__ void tr_item64(const float* W, int ldw, bf16_t* WT, int ldt, int k0, int n0, LAS float* scr, int lane) {
    const int kr = lane >> 4, c4 = lane & 15;
    f32x4 v[16];
#pragma unroll
    for (int i = 0; i < 16; ++i) v[i] = *(const GAS f32x4*)(W + (size_t)(k0 + 4 * i + kr) * ldw + n0 + 4 * c4);
#pragma unroll
    for (int i = 0; i < 16; ++i) { LAS float* s = scr + (4 * i + kr) * 65 + 4 * c4; s[0] = v[i][0]; s[1] = v[i][1]; s[2] = v[i][2]; s[3] = v[i][3]; }
    LDS_WAIT(); asm volatile("" ::: "memory");
    const int c = lane & 7;
#pragma unroll
    for (int j = 0; j < 8; ++j) { const int n = (lane >> 3) + 8 * j; const LAS float* s = scr + (8 * c) * 65 + n;
        u32x4 o; o.x = pk2(s[0], s[65]); o.y = pk2(s[130], s[195]); o.z = pk2(s[260], s[325]); o.w = pk2(s[390], s[455]);
        *(GAS u32x4*)(WT + (size_t)(n0 + n) * ldt + k0 + 8 * c) = o; }
    LDS_WAIT(); asm volatile("" ::: "memory");
}
__device__ __forceinline__ void tr_item64_fp8(const float* W, int ldw, unsigned char* WT, int ldt, int k0, int n0, int lane) {
    const GAS float* src = (const GAS float*)(W + (size_t)k0 * ldw + n0 + lane);
    float v[64];
#pragma unroll
    for (int k = 0; k < 64; ++k) v[k] = src[(size_t)k * ldw];
    GAS u32x4* dst = (GAS u32x4*)(WT + (size_t)(n0 + lane) * ldt + k0);
#pragma unroll
    for (int j = 0; j < 4; ++j) { u32x4 o; o.x = pk4_fp8(v[16 * j], v[16 * j + 1], v[16 * j + 2], v[16 * j + 3]); o.y = pk4_fp8(v[16 * j + 4], v[16 * j + 5], v[16 * j + 6], v[16 * j + 7]);
        o.z = pk4_fp8(v[16 * j + 8], v[16 * j + 9], v[16 * j + 10], v[16 * j + 11]); o.w = pk4_fp8(v[16 * j + 12], v[16 * j + 13], v[16 * j + 14], v[16 * j + 15]); dst[j] = o; }
}
__device__ __forceinline__ void tr_matrix_item(const float* W, int K, int N, bf16_t* WT, int item, LAS float* scr, int lane) {
    const int nb = N / 64; tr_item64(W, N, WT, K, (item / nb) * 64, (item % nb) * 64, scr, lane);
}
constexpr int TI_WIN = 16 * 52, TI_WOUT = 16 * 16, TI_UP = 8, TI_GUP = 16, TI_SMALL = TI_WIN + TI_WOUT + 2 * TI_UP + TI_GUP;
constexpr int TI_W1 = 16 * 32, TI_W2 = 16 * 16, TI_TOTAL = TI_SMALL + NE * (TI_W1 + TI_W2);
constexpr int XP3_ITEMS = 4 * 256 * 8 * XP3_PER;
__device__ __forceinline__ void p0_phase(const Args& a, LAS unsigned char* lds, int tid, int wave, int lane, int vcu, int G) {
    if (blockIdx.x < 192) p0_mod_unit(a, blockIdx.x, lds, tid);
    else if (blockIdx.x < 256) { const int i = (blockIdx.x - 192) * 512 + tid, k = i >> 5, e = i & 31; const float w = a.in[I_RW][i];
        const unsigned hi = f2bf(w); const float lo = w - __builtin_bit_cast(float, hi << 16);
        bf16_t* rwh = (bf16_t*)(a.ws + WS_RWH); rwh[e * 1024 + k] = (bf16_t)hi; rwh[32 * 1024 + e * 1024 + k] = (bf16_t)f2bf(lo); }
    LAS float* scr = (LAS float*)(lds + wave * 16640);
    unsigned char* ws = a.ws;
    bf16_t* lora = (bf16_t*)(ws + WS_LORA);
    const int gw = vcu * NWAVES + wave, NGW = G * NWAVES;
    for (int it = gw; it < TI_SMALL; it += NGW) {
        int r = it;
        if (r < TI_WIN) { tr_matrix_item(a.in[I_WIN], 1024, NIN, (bf16_t*)(ws + WS_WIN), r, scr, lane); continue; } r -= TI_WIN;
        if (r < TI_WOUT) { tr_matrix_item(a.in[I_WOUT], 1024, 1024, (bf16_t*)(ws + WS_WOUT), r, scr, lane); continue; } r -= TI_WOUT;
        if (r < TI_UP) { tr_matrix_item(a.in[I_WUP], 64, 512, lora, r, scr, lane); continue; } r -= TI_UP;
        if (r < TI_UP) { tr_matrix_item(a.in[I_AUP], 64, 512, lora + 512 * 64, r, scr, lane); continue; } r -= TI_UP;
        tr_matrix_item(a.in[I_GUP], 128, 512, lora + 2 * 512 * 64, r, scr, lane);
    }
}
__device__ __forceinline__ void expert_transposes(const Args& a, LAS float* scr, int gw, int NGW, int lane, int rend = NE * (TI_W1 + TI_W2)) {
    unsigned char* ws = a.ws;
    for (int r = gw; r < rend; r += NGW) {
        if (r < NE * TI_W1) { const int e = r / TI_W1, it = r % TI_W1;
            if (FP8_G3) tr_item64_fp8(a.in[I_W1] + (size_t)e * 1024 * 2048, 2048, ws + WS_W1T + (size_t)e * 2048 * 1024, 1024, (it / 32) * 64, (it % 32) * 64, lane);
            else tr_matrix_item(a.in[I_W1] + (size_t)e * 1024 * 2048, 1024, 2048, (bf16_t*)(ws + WS_W1T) + (size_t)e * 2048 * 1024, it, scr, lane); }
        else { const int q = r - NE * TI_W1; const int e = q / TI_W2, it = q % TI_W2;
            if (FP8_G4) tr_item64_fp8(a.in[I_W2] + (size_t)e * 1024 * 1024, 1024, ws + WS_W2T + (size_t)e * 1024 * 1024, 1024, (it / 16) * 64, (it % 16) * 64, lane);
            else tr_matrix_item(a.in[I_W2] + (size_t)e * 1024 * 1024, 1024, 1024, (bf16_t*)(ws + WS_W2T) + (size_t)e * 1024 * 1024, it, scr, lane); }
    }
}

__device__ __forceinline__ void p1_phase(const Args& a, int wave, int lane, int vcu, int G) {
    const float* mod = (const float*)(a.ws + WS_MOD); bf16_t* U = (bf16_t*)(a.ws + WS_U);
    const int gw = vcu * NWAVES + wave, NGW = G * NWAVES;
    for (int row = gw; row < M; row += NGW) {
        const int b = row >> 11;
        const GAS f32x4* xr = (const GAS f32x4*)(a.in[I_X] + (size_t)row * D) + lane;
        f32x4 v[4]; float s = 0.f;
#pragma unroll
        for (int j = 0; j < 4; ++j) { v[j] = xr[64 * j]; s += (v[j][0] * v[j][0] + v[j][1] * v[j][1]) + (v[j][2] * v[j][2] + v[j][3] * v[j][3]); }
        const float inv = 1.0f / sqrtf(wave_sum(s) * (1.f / D) + NORM_EPS);
        GAS u32x2* o8 = (GAS u32x2*)(U + (size_t)row * D) + lane;
#pragma unroll
        for (int j = 0; j < 4; ++j) { const int col = 4 * lane + 256 * j;
            const f32x4 g = *(const f32x4*)(a.in[I_N1G] + col), sh = *(const f32x4*)(mod + b * 6144 + col), sc = *(const f32x4*)(mod + b * 6144 + 1024 + col);
            const f32x4 y = v[j] * inv * g * (sc + 1.0f) + sh;
            u32x2 w; w.x = pk2(y[0], y[1]); w.y = pk2(y[2], y[3]); o8[64 * j] = w; }
    }
}

__device__ __forceinline__ void p3_conv(const Args& a, int wave, int lane, int vcu, int G) {
    const bf16_t* P = (const bf16_t*)(a.ws + WS_PROJ); bf16_t* Y = (bf16_t*)(a.ws + WS_YMIX);
    const int gw = vcu * NWAVES + wave, NGW = G * NWAVES;
    const int c0 = 8 * lane;
    float w0[8], w1[8], w2[8], gn[8];
#pragma unroll
    for (int e = 0; e < 8; ++e) { w0[e] = a.in[I_CONVW][c0 + e]; w1[e] = a.in[I_CONVW][512 + c0 + e]; w2[e] = a.in[I_CONVW][1024 + c0 + e]; gn[e] = a.in[I_CONVGN][c0 + e]; }
    for (int row = gw; row < M; row += NGW) {
        const int t = row & (SEQ - 1);
        const bf16_t* pr = P + (size_t)row * NIN + c0;
        const u32x4 bg = *(const GAS u32x4*)(pr + COL_B), cg = *(const GAS u32x4*)(pr + COL_C), hg = *(const GAS u32x4*)(pr + COL_H);
        u32x4 c1 = (u32x4){0u, 0u, 0u, 0u}, h1 = c1, c2 = c1, h2 = c1;
        if (t >= 1) { c1 = *(const GAS u32x4*)(pr - NIN + COL_C); h1 = *(const GAS u32x4*)(pr - NIN + COL_H); }
        if (t >= 2) { c2 = *(const GAS u32x4*)(pr - 2 * NIN + COL_C); h2 = *(const GAS u32x4*)(pr - 2 * NIN + COL_H); }
        float y[8]; float ss = 0.f;
#pragma unroll
        for (int q = 0; q < 4; ++q) {
            const float u0l = bflo(cg[q]) * bflo(hg[q]), u0h = bfhi(cg[q]) * bfhi(hg[q]);
            const float u1l = bflo(c1[q]) * bflo(h1[q]), u1h = bfhi(c1[q]) * bfhi(h1[q]);
            const float u2l = bflo(c2[q]) * bflo(h2[q]), u2h = bfhi(c2[q]) * bfhi(h2[q]);
            const float yl = (w0[2 * q] * u2l + w1[2 * q] * u1l + w2[2 * q] * u0l) * bflo(bg[q]);
            const float yh = (w0[2 * q + 1] * u2h + w1[2 * q + 1] * u1h + w2[2 * q + 1] * u0h) * bfhi(bg[q]);
            y[2 * q] = yl; y[2 * q + 1] = yh; ss += yl * yl + yh * yh; }
        ss += __shfl_xor(ss, 1); ss += __shfl_xor(ss, 2); ss += __shfl_xor(ss, 4);
        const float rs = 1.0f / sqrtf(ss * (1.f / 64.f) + NORM_EPS);
        u32x4 o; o.x = pk2(y[0] * rs * gn[0], y[1] * rs * gn[1]); o.y = pk2(y[2] * rs * gn[2], y[3] * rs * gn[3]); o.z = pk2(y[4] * rs * gn[4], y[5] * rs * gn[5]); o.w = pk2(y[6] * rs * gn[6], y[7] * rs * gn[7]);
        *(GAS u32x4*)(Y + (size_t)row * D + c0) = o;
    }
}

__device__ __forceinline__ f32x16 zero16() { f32x16 z;
#pragma unroll
    for (int i = 0; i < 16; ++i) z[i] = 0.f; return z; }
__device__ __forceinline__ int tile_off(int t, int c) { return t * 128 + ((((c >> 3) ^ (t & 7))) << 4) + (c & 7) * 2; }
template <int KC> __device__ __forceinline__ void lora_mm(const LAS unsigned char* codes, int code_off, const bf16_t* WT, int h, int r32, int h2, f32x16 (&acc)[2]) {
    acc[0] = zero16(); acc[1] = zero16();
#pragma unroll
    for (int ks = 0; ks < KC / 16; ++ks) {
        const bf16x8 A = *(const LAS bf16x8*)(codes + r32 * 528 + (code_off + 16 * ks + 8 * h2) * 2);
#pragma unroll
        for (int ct = 0; ct < 2; ++ct) { const bf16x8 B = *(const GAS bf16x8*)(WT + (size_t)(h * 64 + 32 * ct + r32) * KC + 16 * ks + 8 * h2);
            acc[ct] = __builtin_amdgcn_mfma_f32_32x32x16_bf16(A, B, acc[ct], 0, 0, 0); }
    }
}
__device__ __forceinline__ void acc_to_cols(const f32x16 (&acc)[2], LAS float* SC, int lane, int r32, int h2, float (&x)[32]) {
#pragma unroll
    for (int ct = 0; ct < 2; ++ct)
#pragma unroll
        for (int q = 0; q < 4; ++q) *(LAS f32x4*)(SC + (32 * ct + r32) * 36 + 8 * q + 4 * h2) = (f32x4){acc[ct][4 * q], acc[ct][4 * q + 1], acc[ct][4 * q + 2], acc[ct][4 * q + 3]};
    LDS_WAIT(); asm volatile("" ::: "memory");
#pragma unroll
    for (int q = 0; q < 8; ++q) { const f32x4 v = *(const LAS f32x4*)(SC + lane * 36 + 4 * q); x[4 * q] = v[0]; x[4 * q + 1] = v[1]; x[4 * q + 2] = v[2]; x[4 * q + 3] = v[3]; }
    LDS_WAIT(); asm volatile("" ::: "memory");
}
__device__ __forceinline__ void st_frag(unsigned char* blk, int f, int lanepos, u32x4 v) { *(GAS u32x4*)(blk + f * 1024 + lanepos * 16) = v; }
__device__ __forceinline__ u32x4 tile_frag_pi(const LAS unsigned char* T, int t, int ks, int h2) {
    const u32x2 lo = *(const LAS u32x2*)(T + t * 128 + (((2 * ks) ^ (t & 7)) << 4) + 8 * h2);
    const u32x2 hi = *(const LAS u32x2*)(T + t * 128 + (((2 * ks + 1) ^ (t & 7)) << 4) + 8 * h2);
    return (u32x4){lo.x, lo.y, hi.x, hi.y};
}

__device__ __forceinline__ void p3_rwkv_group(const Args& a, int grp, LAS unsigned char* lds, int tid, int wave, int lane) {
    const int b = grp >> 6, ch = grp & 63, t0 = ch * CL; const size_t row0 = (size_t)b * SEQ + t0;
    const bf16_t* P = (const bf16_t*)(a.ws + WS_PROJ);
    LAS unsigned char* codes = lds + 131072;
    {
        const int t = tid >> 4, j0 = (tid & 15) * 16;
        const bf16_t* cur = P + (row0 + t) * NIN + COL_DW + j0;
        const u32x4 c0 = *(const GAS u32x4*)cur, c1 = *(const GAS u32x4*)(cur + 8);
        u32x4 p0 = (u32x4){0u, 0u, 0u, 0u}, p1 = p0;
        if (t0 + t > 0) { p0 = *(const GAS u32x4*)(cur - NIN); p1 = *(const GAS u32x4*)(cur - NIN + 8); }
        const float* mu = a.in[I_MU] + 1536 + j0;
        float o[16];
#pragma unroll
        for (int q = 0; q < 8; ++q) { const unsigned cw = q < 4 ? c0[q] : c1[q - 4], pw = q < 4 ? p0[q] : p1[q - 4];
            const float cl = bflo(cw), chh = bfhi(cw), pl = bflo(pw), ph = bfhi(pw);
            o[2 * q] = cl + (pl - cl) * mu[2 * q]; o[2 * q + 1] = chh + (ph - chh) * mu[2 * q + 1]; }
        if (j0 < 64) {
#pragma unroll
            for (int e = 0; e < 16; ++e) o[e] = 1.0f - 2.0f * __builtin_amdgcn_rcpf(1.0f + __expf(2.0f * o[e]));
        } else if (j0 >= 128) {
#pragma unroll
            for (int e = 0; e < 16; ++e) o[e] = fast_sigmoid(o[e]);
        }
        u32x4 w0, w1; w0.x = pk2(o[0], o[1]); w0.y = pk2(o[2], o[3]); w0.z = pk2(o[4], o[5]); w0.w = pk2(o[6], o[7]);
        w1.x = pk2(o[8], o[9]); w1.y = pk2(o[10], o[11]); w1.z = pk2(o[12], o[13]); w1.w = pk2(o[14], o[15]);
        *(LAS u32x4*)(codes + t * 528 + j0 * 2) = w0; *(LAS u32x4*)(codes + t * 528 + j0 * 2 + 16) = w1;
    }
    __syncthreads();
    const int h = wave, bh = b * 8 + h, hc = h * 64 + lane, r32 = lane & 31, h2 = lane >> 5;
    LAS unsigned char* wl = lds + wave * 16384;
    LAS float* SC = (LAS float*)wl;
    LAS unsigned char* T_A = wl, *T_B = wl + 4096, *T_K = wl + 8192, *T_R = wl + 12288;
    unsigned char* blk = a.ws + WS_CH + ((size_t)bh * NCH + ch) * CHB;
    const bf16_t* lora = (const bf16_t*)(a.ws + WS_LORA);
    f32x16 acc[2]; float x[32];
    const __amdgpu_buffer_rsrc_t prs = __builtin_amdgcn_make_buffer_rsrc((void*)P, 0, M * NIN * 2, 0x00020000);
    const int pvo = (COL_R + hc) * 2; const int pso = (int)row0 * (NIN * 2);
#define PRAW(t, c) __builtin_amdgcn_raw_buffer_load_b16(prs, pvo + (c) * 1024, pso + (t) * (NIN * 2), 0)
    unsigned short rr[8], rk_[8], rv[8];
#pragma unroll
    for (int i = 0; i < 8; ++i) { rr[i] = PRAW(i, 0); rk_[i] = PRAW(i, 1); rv[i] = PRAW(i, 2); }
    lora_mm<128>(codes, 128, lora + 2 * 512 * 64, h, r32, h2, acc); acc_to_cols(acc, SC, lane, r32, h2, x);
    { unsigned char* Gp = blk + CH_G + lane * 64;
#pragma unroll
      for (int q = 0; q < 4; ++q) { u32x4 w; w.x = pk2(x[8 * q], x[8 * q + 1]); w.y = pk2(x[8 * q + 2], x[8 * q + 3]); w.z = pk2(x[8 * q + 4], x[8 * q + 5]); w.w = pk2(x[8 * q + 6], x[8 * q + 7]); *(GAS u32x4*)(Gp + 16 * q) = w; } }
    float cum[32];
    lora_mm<64>(codes, 0, lora, h, r32, h2, acc); acc_to_cols(acc, SC, lane, r32, h2, x);
    { const float w0c = a.in[I_W0][hc]; float run = 0.f;
#pragma unroll
      for (int t = 0; t < 32; ++t) { run -= 0.6065306597f * fast_sigmoid(w0c + x[t]); cum[t] = run; } }
    lora_mm<64>(codes, 64, lora + 512 * 64, h, r32, h2, acc); acc_to_cols(acc, SC, lane, r32, h2, x);
    unsigned xa2[16];
    { const float a0c = a.in[I_A0][hc];
#pragma unroll
      for (int t = 0; t < 16; ++t) xa2[t] = pk2(fast_sigmoid(a0c + x[2 * t]), fast_sigmoid(a0c + x[2 * t + 1])); }
    const float mur = a.in[I_MU][hc], muk = a.in[I_MU][512 + hc], muv = a.in[I_MU][1024 + hc];
    const float kkc = a.in[I_KK][hc], kac = a.in[I_KA][hc], rkc = a.in[I_RK][hc];
    float pr_r = 0.f, pr_k = 0.f, pr_v = 0.f;
    if (t0 > 0) { pr_r = bf2f(PRAW(-1, 0)); pr_k = bf2f(PRAW(-1, 1)); pr_v = bf2f(PRAW(-1, 2)); }
    unsigned vv2[16]; float bon = 0.f; float e_prev = 1.0f;
#pragma unroll
    for (int bi = 0; bi < 4; ++bi) {
        unsigned short nr[8], nk[8], nv[8];
        if (bi < 3) {
#pragma unroll
            for (int i = 0; i < 8; ++i) { nr[i] = PRAW(8 * (bi + 1) + i, 0); nk[i] = PRAW(8 * (bi + 1) + i, 1); nv[i] = PRAW(8 * (bi + 1) + i, 2); }
        }
        asm volatile("" ::: "memory");
        float vprev = 0.f;
#pragma unroll
        for (int i = 0; i < 8; ++i) { const int t = 8 * bi + i;
            const float cr = bf2f(rr[i]), ck = bf2f(rk_[i]), cv = bf2f(rv[i]);
            const float r = cr + (pr_r - cr) * mur, k = ck + (pr_k - ck) * muk, v = cv + (pr_v - cv) * muv;
            pr_r = cr; pr_k = ck; pr_v = cv;
            const float kkr = k * kkc; const float nsq = wave_sum(kkr * kkr);
            const float kkn = kkr * __builtin_amdgcn_rsqf(fmaxf(nsq, 1e-24f));
            const float at = (t & 1) ? bfhi(xa2[t >> 1]) : bflo(xa2[t >> 1]);
            const float kp = k * (1.0f + (at - 1.0f) * kac);
            const float bs = wave_sum(r * kp * rkc);
            bon = (lane == t) ? bs : bon;
            const float e_cur = __expf(cum[t]), e_neg = __builtin_amdgcn_rcpf(e_cur);
            const float Ah = -kkn * e_prev, Bv = kkn * at * e_neg, Kv = kp * e_neg, Rh = r * e_cur;
            e_prev = e_cur;
            if (i & 1) vv2[t >> 1] = pk2(vprev, v); else vprev = v;
            const int to = tile_off(t, lane);
            *(LAS unsigned short*)(T_A + to) = (unsigned short)f2bf(Ah); *(LAS unsigned short*)(T_B + to) = (unsigned short)f2bf(Bv);
            *(LAS unsigned short*)(T_K + to) = (unsigned short)f2bf(Kv); *(LAS unsigned short*)(T_R + to) = (unsigned short)f2bf(Rh);
        }
        asm volatile("" ::: "memory");
        if (bi < 3) {
#pragma unroll
            for (int i = 0; i < 8; ++i) { rr[i] = nr[i]; rk_[i] = nk[i]; rv[i] = nv[i]; }
        }
    }
    { unsigned char* Vp = blk + CH_V + lane * 64;
#pragma unroll
      for (int q = 0; q < 4; ++q) *(GAS u32x4*)(Vp + 16 * q) = (u32x4){vv2[4 * q], vv2[4 * q + 1], vv2[4 * q + 2], vv2[4 * q + 3]};
      if (lane < 32) *(GAS float*)(blk + CH_BON + lane * 4) = bon;
      *(GAS float*)(blk + CH_PL + lane * 4) = e_prev;
#pragma unroll
      for (int ks = 0; ks < 2; ++ks)
#pragma unroll
          for (int hh = 0; hh < 2; ++hh) { const int s0 = 16 * ks + 4 * hh, s1 = s0 + 8;
              st_frag(blk, 22 + 2 * h2 + ks, 32 * hh + r32, (u32x4){vv2[s0 >> 1], vv2[(s0 >> 1) + 1], vv2[s1 >> 1], vv2[(s1 >> 1) + 1]}); } }
    LDS_WAIT(); asm volatile("" ::: "memory");
    f32x16 ab = zero16(), ak = zero16(), rb = zero16(), rk = zero16();
#pragma unroll
    for (int ks = 0; ks < 4; ++ks) { const int fo = r32 * 128 + (((2 * ks + h2) ^ (r32 & 7)) << 4);
        const bf16x8 fa = *(const LAS bf16x8*)(T_A + fo), fb = *(const LAS bf16x8*)(T_B + fo), fk = *(const LAS bf16x8*)(T_K + fo), frr = *(const LAS bf16x8*)(T_R + fo);
        ab = __builtin_amdgcn_mfma_f32_32x32x16_bf16(fb, fa, ab, 0, 0, 0); ak = __builtin_amdgcn_mfma_f32_32x32x16_bf16(fk, fa, ak, 0, 0, 0);
        rb = __builtin_amdgcn_mfma_f32_32x32x16_bf16(fb, frr, rb, 0, 0, 0); rk = __builtin_amdgcn_mfma_f32_32x32x16_bf16(fk, frr, rk, 0, 0, 0); }
#pragma unroll
    for (int ks = 0; ks < 4; ++ks) st_frag(blk, 4 + ks, lane, tile_frag_pi(T_R, r32, ks, h2));
    { unsigned short tb[32], tk[32];
#pragma unroll
      for (int t = 0; t < 32; ++t) { const int to = tile_off(t, lane); tb[t] = *(const LAS unsigned short*)(T_B + to); tk[t] = *(const LAS unsigned short*)(T_K + to); }
#pragma unroll
      for (int ks = 0; ks < 2; ++ks)
#pragma unroll
          for (int hh = 0; hh < 2; ++hh) { const int s0 = 16 * ks + 4 * hh, s1 = s0 + 8; const int lp = 32 * hh + r32;
              u32x4 w; w.x = (unsigned)tb[s0] | ((unsigned)tb[s0 + 1] << 16); w.y = (unsigned)tb[s0 + 2] | ((unsigned)tb[s0 + 3] << 16); w.z = (unsigned)tb[s1] | ((unsigned)tb[s1 + 1] << 16); w.w = (unsigned)tb[s1 + 2] | ((unsigned)tb[s1 + 3] << 16);
              st_frag(blk, 14 + 4 * h2 + ks, lp, w);
              w.x = (unsigned)tk[s0] | ((unsigned)tk[s0 + 1] << 16); w.y = (unsigned)tk[s0 + 2] | ((unsigned)tk[s0 + 3] << 16); w.z = (unsigned)tk[s1] | ((unsigned)tk[s1 + 1] << 16); w.w = (unsigned)tk[s1 + 2] | ((unsigned)tk[s1 + 3] << 16);
              st_frag(blk, 14 + 4 * h2 + 2 + ks, lp, w); } }
    LDS_WAIT(); asm volatile("" ::: "memory");
#pragma unroll
    for (int ks = 0; ks < 2; ++ks) { float m[8], n[8];
#pragma unroll
        for (int j = 0; j < 8; ++j) { const int r = 8 * ks + j; const int s = (r & 3) + 8 * (r >> 2) + 4 * h2; m[j] = (s <= r32) ? rb[r] : 0.f; n[j] = (s <= r32) ? rk[r] : 0.f; }
        u32x4 w; w.x = pk2(m[0], m[1]); w.y = pk2(m[2], m[3]); w.z = pk2(m[4], m[5]); w.w = pk2(m[6], m[7]); st_frag(blk, 8 + ks, lane, w);
        w.x = pk2(n[0], n[1]); w.y = pk2(n[2], n[3]); w.z = pk2(n[4], n[5]); w.w = pk2(n[6], n[7]); st_frag(blk, 12 + ks, lane, w); }
    LAS float* F_AB = (LAS float*)T_B; LAS float* F_AK = (LAS float*)T_K;
#pragma unroll
    for (int q = 0; q < 4; ++q) { f32x4 u, w;
#pragma unroll
        for (int i = 0; i < 4; ++i) { const int s = 8 * q + 4 * h2 + i; u[i] = (s < r32) ? ab[4 * q + i] : 0.f; w[i] = (s < r32) ? ak[4 * q + i] : 0.f; }
        *(LAS f32x4*)(F_AB + r32 * 32 + 8 * q + 4 * h2) = u; *(LAS f32x4*)(F_AK + r32 * 32 + 8 * q + 4 * h2) = w; }
    LDS_WAIT(); asm volatile("" ::: "memory");
    float xs[32], m1[32];
#pragma unroll
    for (int t = 0; t < 32; ++t) { xs[t] = bf2f(*(const LAS unsigned short*)(T_A + tile_off(t, lane))); m1[t] = F_AK[t * 32 + r32]; }
    {
        f32x4 cfc[8], cfn[8];
        cfc[0] = *(const LAS f32x4*)(F_AB + 32);
#pragma unroll
        for (int t = 1; t < 32; ++t) {
            if (t < 31) {
#pragma unroll
                for (int q = 0; q < (t + 4) / 4; ++q) cfn[q] = *(const LAS f32x4*)(F_AB + (t + 1) * 32 + 4 * q);
            }
            asm volatile("" ::: "memory");
            float s1 = xs[t], s2 = m1[t];
#pragma unroll
            for (int q = 0; q < (t + 3) / 4; ++q) {
#pragma unroll
                for (int i = 0; i < 4; ++i) if (4 * q + i < t) { s1 += cfc[q][i] * xs[4 * q + i]; s2 += cfc[q][i] * m1[4 * q + i]; } }
            xs[t] = s1; m1[t] = s2;
            if (t < 31) {
#pragma unroll
                for (int q = 0; q < (t + 4) / 4; ++q) cfc[q] = cfn[q];
            }
            asm volatile("" : "+v"(xs[t]), "+v"(m1[t]));
        }
    }
    LDS_WAIT(); asm volatile("" ::: "memory");
    LAS unsigned char* T_M = T_A;
#pragma unroll
    for (int t = 0; t < 32; ++t) *(LAS unsigned short*)(T_R + tile_off(t, lane)) = (unsigned short)f2bf(xs[t]);
    if (lane < 32) {
#pragma unroll
        for (int t = 0; t < 32; ++t) *(LAS unsigned short*)(T_M + t * 64 + lane * 2) = (unsigned short)f2bf(m1[t]);
    }
    LDS_WAIT(); asm volatile("" ::: "memory");
#pragma unroll
    for (int ks = 0; ks < 4; ++ks) st_frag(blk, ks, lane, tile_frag_pi(T_R, r32, ks, h2));
#pragma unroll
    for (int ks = 0; ks < 2; ++ks) { const u32x2 lo = *(const LAS u32x2*)(T_M + r32 * 64 + (16 * ks + 4 * h2) * 2), hi = *(const LAS u32x2*)(T_M + r32 * 64 + (16 * ks + 8 + 4 * h2) * 2);
        st_frag(blk, 10 + ks, lane, (u32x4){lo.x, lo.y, hi.x, hi.y}); }
    LDS_WAIT(); asm volatile("" ::: "memory");
#if XPOSE_IN_P3
    { const int j = grp / (int)gridDim.x; const int vc = grp - j * (int)gridDim.x; const int base = ((j * (int)gridDim.x + vc) * 8 + wave) * XP3_PER; expert_transposes(a, (LAS float*)wl, base, 1, lane, base + XP3_PER); }
#endif
    __syncthreads();
}
__device__ __forceinline__ void p3_phase(const Args& a, LAS unsigned char* lds, int tid, int wave, int lane, int vcu, int G, int part = 3) {
    if (part & 1) for (int grp = vcu; grp < BATCH * NCH; grp += G) p3_rwkv_group(a, grp, lds, tid, wave, lane);
    if (part & 2) p3_conv(a, wave, lane, vcu, G);
}

constexpr int P4_SLOT = CHB, P4_OBUF = 3 * CHB, P4_OPITCH = 68;
__device__ __forceinline__ void p4_issue(const unsigned char* blkp, LAS unsigned char* slot, int wave, int lane) {
#pragma unroll
    for (int i = 0; i < 5; ++i) { const int p = wave + 8 * i; if (p < CH_PIECES) __builtin_amdgcn_global_load_lds((const unsigned*)(blkp + p * 1024 + lane * 16), (LAS unsigned*)(slot + p * 1024), 16, 0, 0); }
}
#define P4_FRAG(f) (*(const LAS bf16x8*)(base + (f) * 1024 + lane * 16))
__device__ __forceinline__ void p4_phase(const Args& a, LAS unsigned char* lds, int wave, int lane, int vcu, int G) {
    if (blockIdx.x >= NBH) {
#if !XPOSE_IN_P3
        expert_transposes(a, (LAS float*)lds, (blockIdx.x - NBH) * 8 + wave, (G - NBH) * 8, lane);
#else
        expert_transposes(a, (LAS float*)lds, XP3_ITEMS + (blockIdx.x - NBH) * 8 + wave, (G - NBH) * 8, lane);
#endif
        return;
    }
    const int bh = blockIdx.x, b = bh >> 3, h = bh & 7, r32 = lane & 31, h2 = lane >> 5;
    const unsigned char* blk0 = a.ws + WS_CH + (size_t)bh * NCH * CHB;
    const int big = (wave + 32 < CH_PIECES) ? 1 : 0;
    f32x16 S0 = zero16(), S1 = zero16();
    const int gw = wave - 2, tl = lane & 15, q = lane >> 4;
    float lnw[16], lnb[16]; unsigned gv[16]; float bonr = 0.f;
    if (wave == 2 || wave == 3) {
#pragma unroll
        for (int j = 0; j < 16; ++j) { lnw[j] = a.in[I_LNW][h * 64 + 16 * q + j]; lnb[j] = a.in[I_LNB][h * 64 + 16 * q + j]; gv[j] = 0u; }
    }
    p4_issue(blk0, lds, wave, lane);
    p4_issue(blk0 + CHB, lds + P4_SLOT, wave, lane);
    for (int ci = 0; ci <= NCH; ++ci) {
        if (ci < NCH) {
            if (ci + 1 < NCH) { if (big) asm volatile("s_waitcnt vmcnt(5)" ::: "memory"); else asm volatile("s_waitcnt vmcnt(4)" ::: "memory"); }
            else VM_WAIT();
        }
        LDS_WAIT();
        __builtin_amdgcn_s_barrier();
        asm volatile("" ::: "memory");
        if (ci + 2 < NCH) p4_issue(blk0 + (size_t)(ci + 2) * CHB, lds + ((ci + 2) % 3) * P4_SLOT, wave, lane);
        if (wave < 2 && ci < NCH) {
            const int nt = wave;
            const LAS unsigned char* base = lds + (ci % 3) * P4_SLOT;
            const bf16x8 sb00 = pack8(S0[0], S0[1], S0[2], S0[3], S0[4], S0[5], S0[6], S0[7]), sb01 = pack8(S0[8], S0[9], S0[10], S0[11], S0[12], S0[13], S0[14], S0[15]);
            const bf16x8 sb10 = pack8(S1[0], S1[1], S1[2], S1[3], S1[4], S1[5], S1[6], S1[7]), sb11 = pack8(S1[8], S1[9], S1[10], S1[11], S1[12], S1[13], S1[14], S1[15]);
            const bf16x8 vt0 = P4_FRAG(22 + 2 * nt), vt1 = P4_FRAG(23 + 2 * nt);
            f32x16 U = zero16();
            U = __builtin_amdgcn_mfma_f32_32x32x16_bf16(P4_FRAG(0), sb00, U, 0, 0, 0); U = __builtin_amdgcn_mfma_f32_32x32x16_bf16(P4_FRAG(1), sb01, U, 0, 0, 0);
            U = __builtin_amdgcn_mfma_f32_32x32x16_bf16(P4_FRAG(2), sb10, U, 0, 0, 0); U = __builtin_amdgcn_mfma_f32_32x32x16_bf16(P4_FRAG(3), sb11, U, 0, 0, 0);
            U = __builtin_amdgcn_mfma_f32_32x32x16_bf16(P4_FRAG(10), vt0, U, 0, 0, 0); U = __builtin_amdgcn_mfma_f32_32x32x16_bf16(P4_FRAG(11), vt1, U, 0, 0, 0);
            f32x16 O = zero16();
            O = __builtin_amdgcn_mfma_f32_32x32x16_bf16(P4_FRAG(4), sb00, O, 0, 0, 0); O = __builtin_amdgcn_mfma_f32_32x32x16_bf16(P4_FRAG(5), sb01, O, 0, 0, 0);
            O = __builtin_amdgcn_mfma_f32_32x32x16_bf16(P4_FRAG(6), sb10, O, 0, 0, 0); O = __builtin_amdgcn_mfma_f32_32x32x16_bf16(P4_FRAG(7), sb11, O, 0, 0, 0);
            O = __builtin_amdgcn_mfma_f32_32x32x16_bf16(P4_FRAG(12), vt0, O, 0, 0, 0); O = __builtin_amdgcn_mfma_f32_32x32x16_bf16(P4_FRAG(13), vt1, O, 0, 0, 0);
            const bf16x8 ub0 = pack8(U[0], U[1], U[2], U[3], U[4], U[5], U[6], U[7]), ub1 = pack8(U[8], U[9], U[10], U[11], U[12], U[13], U[14], U[15]);
            O = __builtin_amdgcn_mfma_f32_32x32x16_bf16(P4_FRAG(8), ub0, O, 0, 0, 0); O = __builtin_amdgcn_mfma_f32_32x32x16_bf16(P4_FRAG(9), ub1, O, 0, 0, 0);
            S0 = __builtin_amdgcn_mfma_f32_32x32x16_bf16(P4_FRAG(14), ub0, S0, 0, 0, 0); S0 = __builtin_amdgcn_mfma_f32_32x32x16_bf16(P4_FRAG(15), ub1, S0, 0, 0, 0);
            S0 = __builtin_amdgcn_mfma_f32_32x32x16_bf16(P4_FRAG(16), vt0, S0, 0, 0, 0); S0 = __builtin_amdgcn_mfma_f32_32x32x16_bf16(P4_FRAG(17), vt1, S0, 0, 0, 0);
            S1 = __builtin_amdgcn_mfma_f32_32x32x16_bf16(P4_FRAG(18), ub0, S1, 0, 0, 0); S1 = __builtin_amdgcn_mfma_f32_32x32x16_bf16(P4_FRAG(19), ub1, S1, 0, 0, 0);
            S1 = __builtin_amdgcn_mfma_f32_32x32x16_bf16(P4_FRAG(20), vt0, S1, 0, 0, 0); S1 = __builtin_amdgcn_mfma_f32_32x32x16_bf16(P4_FRAG(21), vt1, S1, 0, 0, 0);
            LAS float* ob = (LAS float*)(lds + P4_OBUF) + (ci & 1) * (32 * P4_OPITCH) + 32 * nt + r32;
#pragma unroll
            for (int qq = 0; qq < 4; ++qq) { const f32x4 p0 = *(const LAS f32x4*)(base + CH_PL + (8 * qq + 4 * h2) * 4), p1 = *(const LAS f32x4*)(base + CH_PL + (32 + 8 * qq + 4 * h2) * 4);
#pragma unroll
                for (int i = 0; i < 4; ++i) { S0[4 * qq + i] *= p0[i]; S1[4 * qq + i] *= p1[i]; ob[(8 * qq + 4 * h2 + i) * P4_OPITCH] = O[4 * qq + i]; } }
        }
        if (wave == 2 || wave == 3) {
            if (ci >= 1) {
                const int t = 16 * gw + tl;
                const LAS float* ob = (const LAS float*)(lds + P4_OBUF) + ((ci - 1) & 1) * (32 * P4_OPITCH) + t * P4_OPITCH + 16 * q;
                float o[16]; float s = 0.f;
#pragma unroll
                for (int j4 = 0; j4 < 4; ++j4) { const f32x4 v = *(const LAS f32x4*)(ob + 4 * j4); o[4 * j4] = v[0]; o[4 * j4 + 1] = v[1]; o[4 * j4 + 2] = v[2]; o[4 * j4 + 3] = v[3]; s += (v[0] + v[1]) + (v[2] + v[3]); }
                s += __shfl_xor(s, 16); s += __shfl_xor(s, 32);
                const float mean = s * (1.f / 64.f); float qs = 0.f;
#pragma unroll
                for (int j = 0; j < 16; ++j) { const float d = o[j] - mean; qs += d * d; }
                qs += __shfl_xor(qs, 16); qs += __shfl_xor(qs, 32);
                const float rstd = 1.0f / sqrtf(qs * (1.f / 64.f) + GN_EPS);
                float y[16];
#pragma unroll
                for (int j = 0; j < 16; ++j) y[j] = ((o[j] - mean) * rstd * lnw[j] + lnb[j] + bonr * bfhi(gv[j])) * bflo(gv[j]);
                bf16_t* yp = (bf16_t*)(a.ws + WS_YMIX) + ((size_t)b * SEQ + (ci - 1) * CL + t) * D + 512 + h * 64 + 16 * q;
                u32x4 w0, w1; w0.x = pk2(y[0], y[1]); w0.y = pk2(y[2], y[3]); w0.z = pk2(y[4], y[5]); w0.w = pk2(y[6], y[7]); w1.x = pk2(y[8], y[9]); w1.y = pk2(y[10], y[11]); w1.z = pk2(y[12], y[13]); w1.w = pk2(y[14], y[15]);
                *(GAS u32x4*)yp = w0; *(GAS u32x4*)(yp + 8) = w1;
            }
            if (ci < NCH) {
                const LAS unsigned char* base = lds + (ci % 3) * P4_SLOT; const int t = 16 * gw + tl;
#pragma unroll
                for (int j = 0; j < 16; ++j) { const unsigned g16 = *(const LAS unsigned short*)(base + CH_G + (16 * q + j) * 64 + t * 2), v16 = *(const LAS unsigned short*)(base + CH_V + (16 * q + j) * 64 + t * 2); gv[j] = g16 | (v16 << 16); }
                bonr = *(const LAS float*)(base + CH_BON + t * 4);
            }
        }
    }
    VM_WAIT();
}

__device__ __forceinline__ bool rt_better(float va, int ea, float vb, int eb) { return va > vb || (va == vb && ea < eb); }
__device__ __forceinline__ void p7_phase(const Args& a, LAS unsigned char* lds, int tid, int wave, int lane, int cw_cnt = CW_CNT) {
    LAS int* cntL = (LAS int*)lds;
    LAS int* baseL = cntL + 32;
    LAS int* rec = baseL + 32;
    const float* mod = (const float*)(a.ws + WS_MOD); bf16_t* U = (bf16_t*)(a.ws + WS_U);
    const float* H = a.out; const bf16_t* RWH = (const bf16_t*)(a.ws + WS_RWH);
    if (tid < 32) cntL[tid] = 0;
    __syncthreads();
    const int t = lane & 15, q = lane >> 4;
    const int row = blockIdx.x * 128 + wave * 16 + t, b = row >> 11;
    float inv;
    { const f32x4 p = *(const GAS f32x4*)((const float*)(a.ws + WS_RSS) + (size_t)row * 16 + 4 * q); float s = (p[0] + p[1]) + (p[2] + p[3]);
      s += __shfl_xor(s, 16); s += __shfl_xor(s, 32); inv = 1.0f / sqrtf(s * (1.f / D) + NORM_EPS); }
    const float* hp = H + (size_t)row * D + 8 * q; const float* gp = a.in[I_N2G] + 8 * q; const float* shp = mod + b * 6144 + 3072 + 8 * q; const float* scp = mod + b * 6144 + 4096 + 8 * q;
    bf16_t* up = U + (size_t)row * D + 8 * q; const bf16_t* wp = RWH + (size_t)t * 1024 + 8 * q;
    f32x4 acc0 = (f32x4){0.f, 0.f, 0.f, 0.f}, acc1 = acc0;
#pragma unroll 4
    for (int ks = 0; ks < 32; ++ks) {
        const int ko = 32 * ks;
        const f32x4 h0 = *(const GAS f32x4*)(hp + ko), h1 = *(const GAS f32x4*)(hp + ko + 4);
        const f32x4 g0 = *(const f32x4*)(gp + ko), g1 = *(const f32x4*)(gp + ko + 4), s0 = *(const f32x4*)(scp + ko), s1 = *(const f32x4*)(scp + ko + 4), b0 = *(const f32x4*)(shp + ko), b1 = *(const f32x4*)(shp + ko + 4);
        const bf16x8 ah0 = *(const GAS bf16x8*)(wp + ko), ah1 = *(const GAS bf16x8*)(wp + 16 * 1024 + ko), al0 = *(const GAS bf16x8*)(wp + 32 * 1024 + ko), al1 = *(const GAS bf16x8*)(wp + 48 * 1024 + ko);
        const f32x4 u0 = h0 * inv * g0 * (s0 + 1.0f) + b0, u1 = h1 * inv * g1 * (s1 + 1.0f) + b1;
        u32x4 hi; hi.x = pk2(u0[0], u0[1]); hi.y = pk2(u0[2], u0[3]); hi.z = pk2(u1[0], u1[1]); hi.w = pk2(u1[2], u1[3]);
        if (FP8_G3) { u32x2 w8; w8.x = pk4_fp8(u0[0], u0[1], u0[2], u0[3]); w8.y = pk4_fp8(u1[0], u1[1], u1[2], u1[3]); *(GAS u32x2*)((unsigned char*)U + (size_t)row * D + 8 * q + ko) = w8; }
        else *(GAS u32x4*)(up + ko) = hi;
        u32x4 lo; lo.x = pk2(u0[0] - bflo(hi.x), u0[1] - bfhi(hi.x)); lo.y = pk2(u0[2] - bflo(hi.y), u0[3] - bfhi(hi.y)); lo.z = pk2(u1[0] - bflo(hi.z), u1[1] - bfhi(hi.z)); lo.w = pk2(u1[2] - bflo(hi.w), u1[3] - bfhi(hi.w));
        const bf16x8 bh = __builtin_bit_cast(bf16x8, hi), bl = __builtin_bit_cast(bf16x8, lo);
        acc0 = __builtin_amdgcn_mfma_f32_16x16x32_bf16(ah0, bh, acc0, 0, 0, 0); acc0 = __builtin_amdgcn_mfma_f32_16x16x32_bf16(ah0, bl, acc0, 0, 0, 0); acc0 = __builtin_amdgcn_mfma_f32_16x16x32_bf16(al0, bh, acc0, 0, 0, 0);
        acc1 = __builtin_amdgcn_mfma_f32_16x16x32_bf16(ah1, bh, acc1, 0, 0, 0); acc1 = __builtin_amdgcn_mfma_f32_16x16x32_bf16(ah1, bl, acc1, 0, 0, 0); acc1 = __builtin_amdgcn_mfma_f32_16x16x32_bf16(al1, bh, acc1, 0, 0, 0);
    }
    float val[8]; int ex[8];
#pragma unroll
    for (int r = 0; r < 4; ++r) { ex[r] = 4 * q + r; ex[4 + r] = 16 + 4 * q + r; val[r] = acc0[r] + a.in[I_RB][4 * q + r]; val[4 + r] = acc1[r] + a.in[I_RB][16 + 4 * q + r]; }
    int ek[4]; float lk[4];
#pragma unroll
    for (int k = 0; k < 4; ++k) {
        float bv = val[0]; int be = ex[0];
#pragma unroll
        for (int r = 1; r < 8; ++r) if (rt_better(val[r], ex[r], bv, be)) { bv = val[r]; be = ex[r]; }
        { const float ov = __shfl_xor(bv, 16); const int oe = __shfl_xor(be, 16); if (rt_better(ov, oe, bv, be)) { bv = ov; be = oe; } }
        { const float ov = __shfl_xor(bv, 32); const int oe = __shfl_xor(be, 32); if (rt_better(ov, oe, bv, be)) { bv = ov; be = oe; } }
        ek[k] = be; lk[k] = bv;
#pragma unroll
        for (int r = 0; r < 8; ++r) if (ex[r] == be) val[r] = -INFINITY;
    }
    const float e1 = __expf(lk[1] - lk[0]), e2 = __expf(lk[2] - lk[0]), e3 = __expf(lk[3] - lk[0]); const float rs = 1.0f / (1.0f + e1 + e2 + e3);
    { const int e = q == 0 ? ek[0] : q == 1 ? ek[1] : q == 2 ? ek[2] : ek[3];
      const float g = (q == 0 ? 1.0f : q == 1 ? e1 : q == 2 ? e2 : e3) * rs;
      const int pos = atomicAdd((int*)&cntL[e], 1);
      LAS int* r = rec + ((wave * 16 + t) * 4 + q) * 3; r[0] = e; r[1] = pos; r[2] = __builtin_bit_cast(int, g); }
    __syncthreads();
    if (tid < 32) baseL[tid] = atomicAdd((int*)(a.ws + WS_CTL) + cw_cnt + tid, cntL[tid]);
    __syncthreads();
    { const LAS int* r = rec + tid * 3; const int e = r[0], slot = baseL[e] + r[1]; const int pair = (blockIdx.x * 128 + (tid >> 2)) * 4 + (tid & 3);
      ((GAS u32x2*)(a.ws + WS_LIST))[e * LCAP + slot] = (u32x2){(unsigned)pair, (unsigned)r[2]}; }
}

__device__ __forceinline__ void p10_phase(const Args& a, int wave, int lane, int vcu, int G, float* outp = nullptr) {
    const float* mod = (const float*)(a.ws + WS_MOD); const bf16_t* PAIR = (const bf16_t*)(a.ws + WS_PAIR);
    const int gw = vcu * NWAVES + wave, NGW = G * NWAVES;
    for (int row = gw; row < M; row += NGW) {
        const int b = row >> 11;
        GAS f32x4* hr = (GAS f32x4*)(a.out + (size_t)row * D) + lane; GAS f32x4* orow = outp ? (GAS f32x4*)(outp + (size_t)row * D) + lane : hr;
        const GAS u32x2* pp = (const GAS u32x2*)(PAIR + (size_t)row * 4 * D) + lane;
        f32x4 v[4]; float s = 0.f;
#pragma unroll
        for (int j = 0; j < 4; ++j) { const int col = 4 * lane + 256 * j; v[j] = hr[64 * j];
            f32x4 y = (f32x4){0.f, 0.f, 0.f, 0.f};
#pragma unroll
            for (int k = 0; k < 4; ++k) { const u32x2 w = pp[k * 256 + 64 * j]; y += (f32x4){bflo(w.x), bfhi(w.x), bflo(w.y), bfhi(w.y)}; }
            const f32x4 gt = *(const f32x4*)(mod + b * 6144 + 5120 + col);
            v[j] += gt * y; s += (v[j][0] * v[j][0] + v[j][1] * v[j][1]) + (v[j][2] * v[j][2] + v[j][3] * v[j][3]); }
        const float inv = 1.0f / sqrtf(wave_sum(s) * (1.f / D) + NORM_EPS);
#pragma unroll
        for (int j = 0; j < 4; ++j) { const f32x4 g = *(const f32x4*)(a.in[I_FG] + 4 * lane + 256 * j); orow[64 * j] = v[j] * inv * g; }
    }
}

constexpr int N_PHASES = 11;
__global__ void __launch_bounds__(NWAVES * 64, 2) hymba_fwd(Args a) {
    extern __shared__ __attribute__((aligned(16))) unsigned char lds_raw[];
    LAS unsigned char* lds = (LAS unsigned char*)lds_raw;
    volatile LAS unsigned* MISC = (volatile LAS unsigned*)(lds + LDS_MISC);
    const int tid = threadIdx.x, lane = tid & 63, wave = __builtin_amdgcn_readfirstlane(tid >> 6);
    const int G = gridDim.x; const int bx = blockIdx.x; const int vcu = (G % 8 == 0) ? (bx % 8) * (G / 8) + bx / 8 : bx;
    gu32* ctl = (gu32*)(a.ws + WS_CTL);
    if (tid < 128) MISC[tid] = 0u;
    __syncthreads();
    XcdBarrier bar; bar.bar = (unsigned*)(ctl + CW_BAR); bar.x = 0; bar.st = nullptr;
    if (MK_N_LAUNCHES == 1) bar = xcd_barrier_post((unsigned*)(ctl + CW_BAR), MISC + 8);
    const int lo = a.ph_lo, hi = a.ph_hi;
#ifndef PH_MASK
#define PH_MASK 0x7ff
#endif
#define IN(k) (((PH_MASK >> (k)) & 1) && lo <= (k) && (k) < hi)
#ifndef PROBE_DUP
#define PROBE_DUP -1
#endif
#define SEAM(k) do { if (IN(k) && IN((k) + 1)) xcd_barrier(bar); } while (0)
    if (IN(0)) { p0_phase(a, lds, tid, wave, lane, vcu, G); }
#if PROBE_DUP == 0
    __syncthreads();
    if (IN(0)) { p0_phase(a, lds, tid, wave, lane, vcu, G); }
#endif
    SEAM(0);
    if (IN(1)) { p1_phase(a, wave, lane, vcu, G); }
#if PROBE_DUP == 1
    if (IN(1)) { p1_phase(a, wave, lane, vcu, G); }
#endif
    SEAM(1);
    if (IN(2)) {
        DenseSched S{(const char*)(a.ws + WS_U), (const char*)(a.ws + WS_WIN), M / 256, NIN / 256, G, bx, (size_t)256 * 1024 * 2};
        EpiBf16 E{(bf16_t*)(a.ws + WS_PROJ), NIN};
        pg8::gemm_phase<EpiBf16, DenseSched, false, true>(lds, 1024, S, E);
    }
#if PROBE_DUP == 2
    if (IN(2)) {
        DenseSched S{(const char*)(a.ws + WS_U), (const char*)(a.ws + WS_WIN), M / 256, NIN / 256, G, bx, (size_t)256 * 1024 * 2};
        EpiBf16 E{(bf16_t*)(a.ws + WS_PROJ), NIN};
        pg8::gemm_phase<EpiBf16, DenseSched, false, true>(lds, 1024, S, E);
    }
#endif
    SEAM(2);
    if (IN(3)) { p3_phase(a, lds, tid, wave, lane, vcu, G); }
#if PROBE_DUP == 3
    if (IN(3)) { p3_phase(a, lds, tid, wave, lane, vcu, G); }
#endif
#if PROBE_DUP == 31
    if (IN(3)) { p3_phase(a, lds, tid, wave, lane, vcu, G, 1); }
#endif
#if PROBE_DUP == 32
    if (IN(3)) { p3_phase(a, lds, tid, wave, lane, vcu, G, 2); }
#endif
    SEAM(3);
    if (IN(4)) { p4_phase(a, lds, wave, lane, vcu, G); }
#if PROBE_DUP == 4
    if (IN(4)) { p4_phase(a, lds, wave, lane, vcu, G); }
#endif
    SEAM(4);
    if (IN(6)) {
        DenseSched S{(const char*)(a.ws + WS_YMIX), (const char*)(a.ws + WS_WOUT), M / 256, D / 256, G, bx, (size_t)256 * 1024 * 2};
        EpiResid E{a.in[I_X], a.out, (const float*)(a.ws + WS_MOD), (float*)(a.ws + WS_RSS)};
        pg8::gemm_phase<EpiResid, DenseSched, false, true>(lds, 1024, S, E);
    }
#if PROBE_DUP == 6
    if (IN(6)) {
        DenseSched S{(const char*)(a.ws + WS_YMIX), (const char*)(a.ws + WS_WOUT), M / 256, D / 256, G, bx, (size_t)256 * 1024 * 2};
        EpiResid E{a.in[I_X], a.out, (const float*)(a.ws + WS_MOD), (float*)(a.ws + WS_RSS)};
        pg8::gemm_phase<EpiResid, DenseSched, false, true>(lds, 1024, S, E);
    }
#endif
    SEAM(6);
#if PROBE_DUP == 7
    if (IN(7)) { p7_phase(a, lds, tid, wave, lane, CW_CNT + 1024); __syncthreads(); }
#endif
    if (IN(7)) { p7_phase(a, lds, tid, wave, lane); }
    SEAM(7);
    volatile LAS int* bstart = (volatile LAS int*)(lds + LDS_MISC + 128);
    volatile LAS int* ecnt = bstart + 40;
    volatile LAS unsigned char* blk_e = (volatile LAS unsigned char*)(lds + LDS_MISC - 1024);
    if (IN(8) || IN(9)) {
        if (tid == 0) { int s = 0; for (int e = 0; e < NE; ++e) { const int c = (int)__hip_atomic_load(ctl + CW_CNT + e, RLX_AGENT); ecnt[e] = c; bstart[e] = s; s += (c + 255) >> 8; } bstart[NE] = s; }
        __syncthreads();
        for (int pm = tid; pm < bstart[NE]; pm += NWAVES * 64) { int e = 0; for (int j = 1; j < NE; ++j) e += (bstart[j] <= pm) ? 1 : 0; blk_e[pm] = (unsigned char)e; }
        __syncthreads();
    }
    if (IN(8)) {
        constexpr int EB = FP8_G3 ? 1 : 2;
        MoeSched S{(const char*)(a.ws + WS_U), (const char*)(a.ws + WS_W1T), (size_t)2048 * 1024 * EB, bstart[NE], 8, G, bx, (size_t)256 * 1024 * EB, bstart, ecnt, (const int*)(a.ws + WS_LIST), 1024 * EB, true, blk_e};
        EpiSwiglu<FP8_G4 != 0> E{(bf16_t*)(a.ws + WS_ACT), a.in[I_B1], &S};
        pg8::gemm_phase<EpiSwiglu<FP8_G4 != 0>, MoeSched, true, true, FP8_G3 != 0>(lds, 512 * EB, S, E);
    }
#if PROBE_DUP == 8
    if (IN(8)) {
        constexpr int EB = FP8_G3 ? 1 : 2;
        MoeSched S{(const char*)(a.ws + WS_U), (const char*)(a.ws + WS_W1T), (size_t)2048 * 1024 * EB, bstart[NE], 8, G, bx, (size_t)256 * 1024 * EB, bstart, ecnt, (const int*)(a.ws + WS_LIST), 1024 * EB, true, blk_e};
        EpiSwiglu<FP8_G4 != 0> E{(bf16_t*)(a.ws + WS_ACT), a.in[I_B1], &S};
        pg8::gemm_phase<EpiSwiglu<FP8_G4 != 0>, MoeSched, true, true, FP8_G3 != 0>(lds, 512 * EB, S, E);
    }
#endif
    SEAM(8);
    if (IN(9)) {
        constexpr int EB = FP8_G4 ? 1 : 2;
        MoeSched S{(const char*)(a.ws + WS_ACT), (const char*)(a.ws + WS_W2T), (size_t)1024 * 1024 * EB, bstart[NE], 4, G, bx, (size_t)256 * 1024 * EB, bstart, ecnt, (const int*)(a.ws + WS_LIST), 1024 * EB, false, blk_e};
        EpiPair E{(bf16_t*)(a.ws + WS_PAIR), a.in[I_B2], &S};
        pg8::gemm_phase<EpiPair, MoeSched, false, true, FP8_G4 != 0>(lds, 512 * EB, S, E);
    }
#if PROBE_DUP == 9
    if (IN(9)) {
        constexpr int EB = FP8_G4 ? 1 : 2;
        MoeSched S{(const char*)(a.ws + WS_ACT), (const char*)(a.ws + WS_W2T), (size_t)1024 * 1024 * EB, bstart[NE], 4, G, bx, (size_t)256 * 1024 * EB, bstart, ecnt, (const int*)(a.ws + WS_LIST), 1024 * EB, false, blk_e};
        EpiPair E{(bf16_t*)(a.ws + WS_PAIR), a.in[I_B2], &S};
        pg8::gemm_phase<EpiPair, MoeSched, false, true, FP8_G4 != 0>(lds, 512 * EB, S, E);
    }
#endif
    SEAM(9);
#if PROBE_DUP == 10
    if (IN(10)) { p10_phase(a, wave, lane, vcu, G, (float*)(a.ws + WS_U)); }
#endif
    if (IN(10)) { p10_phase(a, wave, lane, vcu, G); }
#undef IN
#undef SEAM
}

extern "C" void kernel_launch(void* const* d_in, const int* in_sizes, int n_in, void* d_out, int out_size, void* d_ws, size_t ws_size, hipStream_t stream) {
    static int grid = 0;
    if (grid == 0) {
        if (n_in != 28 || in_sizes[0] != M * D || out_size != M * D || ws_size < WS_END) { fprintf(stderr, "kernel_launch: unexpected shapes / workspace (n_in %d, ws %zu)\n", n_in, ws_size); grid = -1; return; }
        int dev = 0, cus = 0;
        if (hipGetDevice(&dev) != hipSuccess || hipDeviceGetAttribute(&cus, hipDeviceAttributeMultiprocessorCount, dev) != hipSuccess) { grid = -1; return; }
        if (hipFuncSetAttribute((const void*)hymba_fwd, hipFuncAttributeMaxDynamicSharedMemorySize, LDS_TOTAL) != hipSuccess) { fprintf(stderr, "kernel_launch: hipFuncSetAttribute failed\n"); grid = -1; return; }
        (void)hipGetLastError();
        grid = cus;
        if (grid != 256) fprintf(stderr, "kernel_launch: %d CUs (built for 256)\n", grid);
    }
    if (grid < 0) return;
    if (hipMemsetAsync((char*)d_ws + WS_CTL, 0, CTL_ZERO_BYTES, stream) != hipSuccess) return;
    Args a{};
    for (int i = 0; i < 28; ++i) a.in[i] = (const float*)d_in[i];
    a.out = (float*)d_out; a.ws = (unsigned char*)d_ws;
#if MK_N_LAUNCHES == 1
    a.ph_lo = 0; a.ph_hi = N_PHASES;
    hipLaunchKernelGGL(hymba_fwd, dim3(grid), dim3(NWAVES * 64), LDS_TOTAL, stream, a);
#else
    for (int p = 0; p < N_PHASES; ++p) { a.ph_lo = p; a.ph_hi = p + 1; hipLaunchKernelGGL(hymba_fwd, dim3(grid), dim3(NWAVES * 64), LDS_TOTAL, stream, a); }
#endif
}
```

```cpp
#include <hip/hip_runtime.h>
#include <cstdio>
#include <cstdint>

#ifndef MK_N_LAUNCHES
#define MK_N_LAUNCHES 1
#endif

#ifndef XPOSE_IN_P3
#define XPOSE_IN_P3 1
#endif
constexpr int XP3_PER = 1;
#ifndef FP8_G3
#define FP8_G3 1
#endif
#ifndef FP8_G4
#define FP8_G4 1
#endif
#define LAS __attribute__((address_space(3)))
#define GAS __attribute__((address_space(1)))
typedef unsigned short bf16_t;
typedef short bf16x8 __attribute__((ext_vector_type(8)));
typedef float f32x4 __attribute__((ext_vector_type(4)));
typedef float f32x16 __attribute__((ext_vector_type(16)));
typedef float f32x2 __attribute__((ext_vector_type(2)));
typedef unsigned u32x4 __attribute__((ext_vector_type(4)));
typedef int v8i __attribute__((ext_vector_type(8)));
typedef unsigned u32x2 __attribute__((ext_vector_type(2)));
typedef GAS unsigned gu32;
#define RLX_AGENT __ATOMIC_RELAXED, __HIP_MEMORY_SCOPE_AGENT
#define LDS_WAIT() asm volatile("s_waitcnt lgkmcnt(0)" ::: "memory")
#define VM_WAIT() asm volatile("s_waitcnt vmcnt(0)" ::: "memory")

constexpr int D = 1024, BATCH = 16, SEQ = 2048, M = BATCH * SEQ;
constexpr int NIN = 3328;
constexpr int COL_B = 0, COL_C = 512, COL_H = 1024, COL_R = 1536, COL_K = 2048, COL_V = 2560, COL_DW = 3072;
constexpr int NE = 32, LCAP = 32768;
constexpr int CL = 32, NCH = SEQ / CL;
constexpr int NBH = BATCH * 8;
constexpr float NORM_EPS = 1e-5f, GN_EPS = 64e-5f;
constexpr int CHB = 35840;
constexpr int CH_PL = 26624, CH_BON = 26624 + 256, CH_G = 27648, CH_V = 31744, CH_PIECES = 35;

constexpr size_t MiB = 1u << 20;
constexpr size_t WS_CTL = 0, CTL_ZERO_BYTES = 64 * 1024;
constexpr size_t WS_MOD = 1 * MiB;
constexpr size_t WS_LORA = 2 * MiB;
constexpr size_t WS_RWH = 2 * MiB + 512 * 1024;
constexpr size_t WS_WOUT = 3 * MiB;
constexpr size_t WS_WIN = 5 * MiB;
constexpr size_t WS_LIST = 12 * MiB;
constexpr size_t WS_W1T = 24 * MiB;
constexpr size_t WS_W2T = 152 * MiB;
constexpr size_t WS_U = 216 * MiB;
constexpr size_t WS_YMIX = 280 * MiB;
constexpr size_t WS_PROJ = 344 * MiB;
constexpr size_t WS_CH = 552 * MiB;
constexpr size_t WS_OT = 768 * MiB;
constexpr size_t WS_G = 832 * MiB;
constexpr size_t WS_V = 864 * MiB;
constexpr size_t WS_BON = 896 * MiB;
constexpr size_t WS_RSS = 897 * MiB;
constexpr size_t WS_ACT = 344 * MiB;
constexpr size_t WS_PAIR = 616 * MiB;
constexpr size_t WS_END = 900 * MiB;
constexpr int CW_TMO = 0;
constexpr int CW_CNT = 64;
constexpr int CW_BAR = 4096;

constexpr int RING_BYTES = 131072;
constexpr int MISC_OFF = 144 * 1024;
constexpr int LDS_BYTES = 147456;

__device__ __forceinline__ unsigned f2bf(float f) { unsigned u = __builtin_bit_cast(unsigned, f); return (u + 0x7fffu + ((u >> 16) & 1u)) >> 16; }
__device__ __forceinline__ unsigned pk2(float lo, float hi) { return f2bf(lo) | (f2bf(hi) << 16); }
__device__ __forceinline__ unsigned pk4_fp8(float a, float b, float c, float d) {
    int r = __builtin_amdgcn_cvt_pk_fp8_f32(a, b, 0, false); r = __builtin_amdgcn_cvt_pk_fp8_f32(c, d, r, true); return (unsigned)r; }
__device__ __forceinline__ float bf2f(unsigned short h) { return __builtin_bit_cast(float, (unsigned)h << 16); }
__device__ __forceinline__ float bflo(unsigned w) { return __builtin_bit_cast(float, w << 16); }
__device__ __forceinline__ float bfhi(unsigned w) { return __builtin_bit_cast(float, w & 0xffff0000u); }
#define DPP_QP1 0xB1
#define DPP_QP2 0x4E
#define DPP_HMIR 0x141
#define DPP_MIR 0x140
#define DPP_BC15 0x142
#define DPP_BC31 0x143
#define dpp_f(old, v, ctrl, rmask) __builtin_bit_cast(float, __builtin_amdgcn_update_dpp(__builtin_bit_cast(int, (float)(old)), __builtin_bit_cast(int, (float)(v)), ctrl, rmask, 0xf, false))
__device__ __forceinline__ float wave_sum(float v) {
    v += dpp_f(0.f, v, DPP_QP1, 0xf); v += dpp_f(0.f, v, DPP_QP2, 0xf); v += dpp_f(0.f, v, DPP_HMIR, 0xf); v += dpp_f(0.f, v, DPP_MIR, 0xf);
    v += dpp_f(0.f, v, DPP_BC15, 0xa); v += dpp_f(0.f, v, DPP_BC31, 0xc);
    return __builtin_bit_cast(float, __builtin_amdgcn_readlane(__builtin_bit_cast(int, v), 63));
}
__device__ __forceinline__ float wave_max(float v) {
    const float ninf = -INFINITY;
    v = fmaxf(v, dpp_f(ninf, v, DPP_QP1, 0xf)); v = fmaxf(v, dpp_f(ninf, v, DPP_QP2, 0xf)); v = fmaxf(v, dpp_f(ninf, v, DPP_HMIR, 0xf)); v = fmaxf(v, dpp_f(ninf, v, DPP_MIR, 0xf));
    v = fmaxf(v, dpp_f(ninf, v, DPP_BC15, 0xa)); v = fmaxf(v, dpp_f(ninf, v, DPP_BC31, 0xc));
    return __builtin_bit_cast(float, __builtin_amdgcn_readlane(__builtin_bit_cast(int, v), 63));
}
__device__ __forceinline__ float fast_sigmoid(float x) { return __builtin_amdgcn_rcpf(1.0f + __expf(-x)); }
__device__ __forceinline__ bf16x8 pack8(float a0, float a1, float a2, float a3, float a4, float a5, float a6, float a7) {
    u32x4 w; w.x = pk2(a0, a1); w.y = pk2(a2, a3); w.z = pk2(a4, a5); w.w = pk2(a6, a7); return __builtin_bit_cast(bf16x8, w);
}

#define XB_TMO      128
#define XB_XCNT(j)  (256  + 64 * (j))
#define XB_XSUB(j)  (1280 + 64 * (j))
#define XB_XGEN(j)  (2304 + 64 * (j))
#define XB_TOP      3328
#define XB_TOPGEN   3392
#define XCD_BAR_WORDS 3456
#define XB_SPIN_CAP (1u << 20)
__device__ __forceinline__ unsigned xb_ld(unsigned* p)              { return __hip_atomic_load(p, __ATOMIC_RELAXED, __HIP_MEMORY_SCOPE_AGENT); }
__device__ __forceinline__ unsigned xb_add(unsigned* p, unsigned v) { return __hip_atomic_fetch_add(p, v, __ATOMIC_RELAXED, __HIP_MEMORY_SCOPE_AGENT); }
__device__ __forceinline__ unsigned xb_xcc_id() { return (unsigned)__builtin_amdgcn_s_getreg((3 << 11) | 20) & 0xFu; }
#define XB_SPIN(cond, bar) do { unsigned _sp = 0; while (cond) { __builtin_amdgcn_s_sleep(1); \
    if ((++_sp & 255u) == 0u) { if (xb_ld(&(bar)[XB_TMO])) break; if (_sp > XB_SPIN_CAP) { atomicAdd(&(bar)[XB_TMO], 1u); break; } } } } while (0)
struct XcdBarrier { unsigned* bar; unsigned x; volatile LAS unsigned* st; };
__device__ __forceinline__ XcdBarrier xcd_barrier_post(unsigned* bar, volatile LAS unsigned* st) {
    XcdBarrier b; b.bar = bar; b.x = xb_xcc_id(); b.st = st;
    if (threadIdx.x == 0) (void)xb_add(&bar[XB_XCNT(b.x)], 1u);
    return b;
}
__device__ __forceinline__ void xcd_barrier_complete(unsigned* bar, unsigned x, unsigned& nloc, unsigned& nx) {
    const unsigned G = gridDim.x * gridDim.y * gridDim.z;
    unsigned sum, cnt, mine, sp = 0u;
    for (;;) {
        sum = 0u; cnt = 0u; mine = 0u;
#pragma unroll
        for (unsigned j = 0; j < 16; ++j) { const unsigned c = xb_ld(&bar[XB_XCNT(j)]); sum += c; cnt += (c > 0u) ? 1u : 0u; mine = (j == x) ? c : mine; }
        if (sum == G) break;
        __builtin_amdgcn_s_sleep(1);
        if ((++sp & 255u) == 0u) { if (xb_ld(&bar[XB_TMO])) break; if (sp > XB_SPIN_CAP) { atomicAdd(&bar[XB_TMO], 1u); break; } }
    }
    nloc = mine > 0u ? mine : 1u; nx = cnt > 0u ? cnt : 1u;
}
__device__ __forceinline__ void xcd_barrier(const XcdBarrier& b) {
    asm volatile("s_waitcnt vmcnt(0)" ::: "memory");
    __syncthreads();
    if (threadIdx.x == 0) {
        unsigned* bar = b.bar;
        __builtin_amdgcn_s_waitcnt(0);
        unsigned nloc = b.st[0], nx = b.st[1];
        if (nloc == 0u) { xcd_barrier_complete(bar, b.x, nloc, nx); b.st[0] = nloc; b.st[1] = nx; }
        const unsigned old = xb_add(&bar[XB_XSUB(b.x)], 1u);
        const unsigned gen = old / nloc;
        if (old + 1u == (gen + 1u) * nloc) {
            __builtin_amdgcn_fence(__ATOMIC_RELEASE, "agent");
            asm volatile("s_waitcnt vmcnt(0)" ::: "memory");
            const unsigned og = xb_add(&bar[XB_TOP], 1u);
            const unsigned tg = og / nx;
            if (og + 1u == (tg + 1u) * nx) xb_add(&bar[XB_TOPGEN], 1u);
            else XB_SPIN(xb_ld(&bar[XB_TOPGEN]) == tg, bar);
            __builtin_amdgcn_fence(__ATOMIC_ACQUIRE, "agent");
            xb_add(&bar[XB_XGEN(b.x)], 1u);
            asm volatile("s_waitcnt vmcnt(0)" ::: "memory");
        } else {
            XB_SPIN(xb_ld(&bar[XB_XGEN(b.x)]) == gen, bar);
            __builtin_amdgcn_fence(__ATOMIC_ACQUIRE, "agent");
            asm volatile("s_waitcnt vmcnt(0)" ::: "memory");
        }
    }
    __syncthreads();
}

namespace pg8 {
constexpr int BM = 256, BK = 64, HALF = 128, HTB = HALF * BK * 2, NXCD = 8, WGM = 8;
__host__ __device__ __forceinline__ int lds_byte(int r, int c) { const int st = (r >> 4) * 2 + (c >> 5), rr = r & 15, cc = c & 31, ob = rr * 64 + cc * 2; return st * 1024 + (ob ^ (((ob >> 9) & 1) << 5)); }
__host__ __device__ __forceinline__ void stage_rc(int b, int& R, int& C) { const int st = b / 1024, sb = b % 1024, swz = sb ^ (((sb >> 9) & 1) << 5); R = (st >> 1) * 16 + swz / 64; C = (st & 1) * 32 + (swz % 64) / 2; }
__host__ __device__ __forceinline__ int perm32(int rho) { const int n = rho >> 4, i = rho & 15; return 8 * (i >> 2) + 4 * n + (i & 3); }
struct Unit { int pm, pn; };
__device__ __forceinline__ bool tile_order(int i, int G, int c, int nM, int nN, Unit& u) {
    const int nwg = nM * nN; const long L = (long)i * G + c; if (L >= nwg) return false;
    int wgid = (int)L; { const int q = nwg / NXCD, r = nwg % NXCD, xcd = wgid % NXCD, off = wgid / NXCD; wgid = (xcd < r ? xcd * (q + 1) : r * (q + 1) + (xcd - r) * q) + off; }
    const int nig = WGM * nN, gid = wgid / nig, fm = gid * WGM, gsz = (nM - fm) < WGM ? (nM - fm) : WGM;
    u.pm = fm + ((wgid % nig) % gsz); u.pn = (wgid % nig) / gsz; return true;
}
__device__ __forceinline__ unsigned cvt_pk_bf16(float lo, float hi) { unsigned r; asm volatile("v_cvt_pk_bf16_f32 %0, %1, %2" : "=v"(r) : "v"(lo), "v"(hi)); return r; }

template <class Epi, class Sched, bool GATHER, bool ALIGN_EPI, bool FP8 = false>
__device__ __forceinline__ void gemm_phase(LAS unsigned char* lds, const int K, const Sched& S, const Epi& E) {
    const int tid = threadIdx.x, wid = __builtin_amdgcn_readfirstlane(tid >> 6), lane = tid & 63, wr = wid >> 2, wc = wid & 3, fr = lane & 15, fq = lane >> 4;
    int nt = K / BK; asm volatile("" : "+s"(nt));
    unsigned voffA[2], voffB[2]; int rowA[2];
#pragma unroll
    for (int i = 0; i < 2; ++i) { int R, C; stage_rc(tid * 16 + i * 8192, R, C); const int Rb = Epi::PERM ? ((R & ~31) + perm32(R & 31)) : R;
        voffA[i] = (unsigned)(R * K + C) * 2u; voffB[i] = (unsigned)(Rb * K + C) * 2u; rowA[i] = R; if (GATHER) voffA[i] = (unsigned)C * 2u; }
    const size_t kstep = (size_t)(BK * 2);
    const size_t hstep = (size_t)HALF * K * 2;
    const unsigned ldsw = (unsigned)wid * 1024u;
    const int aoff = lds_byte(wr * 64 + fr, fq * 8), boff = lds_byte(wc * 32 + fr, fq * 8);
    const int sw8 = (fq >> 1) * 1024 + fr * 64 + ((((fq & 1) ^ (fr >> 3))) << 5);
    const int aoff8 = wr * 8192 + sw8, boff8 = wc * 4096 + sw8;
#define PG8_SA(b, h) (((b) * 2 + (h)) * HTB)
#define PG8_SB(b, h) ((4 + (b) * 2 + (h)) * HTB)
#define PG8_STAGE2(bufoff, gbase, o0, o1) do { \
        __builtin_amdgcn_global_load_lds((const unsigned*)((const char*)(gbase) + (o0)), (LAS unsigned*)(lds + (bufoff) + ldsw), 16, 0, 0); \
        __builtin_amdgcn_global_load_lds((const unsigned*)((const char*)(gbase) + (o1)), (LAS unsigned*)(lds + (bufoff) + ldsw + 8192), 16, 0, 0); } while (0)
#define PG8_STAGEB(bufoff, gbase) PG8_STAGE2(bufoff, gbase, voffB[0], voffB[1])
#define PG8_STAGEA(bufoff, kp, hh, OS) do { if (GATHER) PG8_STAGE2(bufoff, kp, OS[hh][0], OS[hh][1]); else PG8_STAGE2(bufoff, (kp) + (hh) * hstep, voffA[0], voffA[1]); } while (0)
#define PG8_LDA(dst, b, h) do { _Pragma("unroll") for (int m = 0; m < 4; ++m) _Pragma("unroll") for (int k = 0; k < 2; ++k) dst[m][k] = *(const LAS bf16x8*)(lds + PG8_SA(b, h) + aoff + m * 2048 + k * 1024); } while (0)
#define PG8_LDB(dst, b, h) do { _Pragma("unroll") for (int n = 0; n < 2; ++n) _Pragma("unroll") for (int k = 0; k < 2; ++k) dst[n][k] = *(const LAS bf16x8*)(lds + PG8_SB(b, h) + boff + n * 2048 + k * 1024); } while (0)
#define PG8_MMA(ai, bj, At, Bt) do { __builtin_amdgcn_s_setprio(1); _Pragma("unroll") for (int m = 0; m < 4; ++m) _Pragma("unroll") for (int n = 0; n < 2; ++n) _Pragma("unroll") for (int k = 0; k < 2; ++k) \
        acc[ai][bj][m][n] = __builtin_amdgcn_mfma_f32_16x16x32_bf16(Bt[n][k], At[m][k], acc[ai][bj][m][n], 0, 0, 0); __builtin_amdgcn_s_setprio(0); } while (0)
#define PG8_LDA8(dst, b, h) do { _Pragma("unroll") for (int m = 0; m < 4; ++m) { const u32x4 _x = *(const LAS u32x4*)(lds + PG8_SA(b, h) + aoff8 + m * 2048), _y = *(const LAS u32x4*)(lds + PG8_SA(b, h) + aoff8 + m * 2048 + 16); \
        dst[m] = (v8i){(int)_x.x, (int)_x.y, (int)_x.z, (int)_x.w, (int)_y.x, (int)_y.y, (int)_y.z, (int)_y.w}; } } while (0)
#define PG8_LDB8(dst, b, h) do { _Pragma("unroll") for (int n = 0; n < 2; ++n) { const u32x4 _x = *(const LAS u32x4*)(lds + PG8_SB(b, h) + boff8 + n * 2048), _y = *(const LAS u32x4*)(lds + PG8_SB(b, h) + boff8 + n * 2048 + 16); \
        dst[n] = (v8i){(int)_x.x, (int)_x.y, (int)_x.z, (int)_x.w, (int)_y.x, (int)_y.y, (int)_y.z, (int)_y.w}; } } while (0)
#define PG8_MMA8(ai, bj, At, Bt) do { __builtin_amdgcn_s_setprio(1); asm volatile("s_nop 1" ::: "memory"); _Pragma("unroll") for (int m = 0; m < 4; ++m) _Pragma("unroll") for (int n = 0; n < 2; ++n) \
        asm volatile("v_mfma_f32_16x16x128_f8f6f4 %0, %1, %2, %0" : "+v"(acc[ai][bj][m][n]) : "v"(Bt[n]), "v"(At[m])); __builtin_amdgcn_s_setprio(0); } while (0)
#define PG8_WAIT_V(n) asm volatile("s_waitcnt vmcnt(" #n ")" ::: "memory")
#define PG8_WAIT_L(n) asm volatile("s_waitcnt lgkmcnt(" #n ")" ::: "memory")
#define PG8_BAR __builtin_amdgcn_s_barrier()
#define PG8_SCHED __builtin_amdgcn_sched_barrier(0)
    Unit cur, nxt; int ui = 0;
    if (!S.next(0, cur)) return;
    f32x4 acc[2][2][4][2];
#pragma unroll
    for (int a = 0; a < 2; ++a)
#pragma unroll
        for (int b = 0; b < 2; ++b)
#pragma unroll
            for (int m = 0; m < 4; ++m)
#pragma unroll
                for (int n = 0; n < 2; ++n) acc[a][b][m][n] = (f32x4){0.f, 0.f, 0.f, 0.f};
    bf16x8 At[4][2], B0[2][2], B1[2][2];
    v8i At8[4], B08[2], B18[2];
    typename Epi::State est;
    unsigned gC[2][2], gN[2][2];
    const char* cA = S.a_base(cur); const char* cB = S.b_base(cur);
    if (GATHER) { S.a_rows(cur, rowA, gC);
#pragma unroll
        for (int h = 0; h < 2; ++h)
#pragma unroll
            for (int i = 0; i < 2; ++i) gC[h][i] += voffA[i]; }
    PG8_STAGEB(PG8_SB(0, 0), cB); PG8_STAGEB(PG8_SB(0, 1), cB + hstep); PG8_STAGEA(PG8_SA(0, 0), cA, 0, gC); PG8_STAGEA(PG8_SA(0, 1), cA, 1, gC);
    if (wr == 1) PG8_BAR;
    PG8_WAIT_V(2); PG8_BAR;
    PG8_STAGEB(PG8_SB(1, 0), cB + kstep); PG8_STAGEA(PG8_SA(1, 0), cA + kstep, 0, gC); PG8_STAGEB(PG8_SB(1, 1), cB + hstep + kstep);
    PG8_WAIT_V(6); PG8_BAR;
    for (;;) {
        const bool has_next = S.next(ui + 1, nxt);
        const char* nA = has_next ? S.a_base(nxt) : cA; const char* nB = has_next ? S.b_base(nxt) : cB;
        int rawN[2][2];
        if (GATHER) { if (has_next) S.a_rows_raw(nxt, rowA, rawN); }
        for (int t = 0; t < nt; t += 2) {
            const bool last = (t == nt - 2);
            const char* a1 = cA + (size_t)(t + 1) * kstep;
            const char* a2 = last ? nA : cA + (size_t)(t + 2) * kstep; const char* b2 = last ? nB : cB + (size_t)(t + 2) * kstep;
            const char* a3 = a2 + kstep; const char* b3 = b2 + kstep;
            unsigned g2[2][2];
            if (GATHER) {
                if (last) {
#pragma unroll
                    for (int h = 0; h < 2; ++h)
#pragma unroll
                        for (int i = 0; i < 2; ++i) { gN[h][i] = has_next ? S.a_row_off(rawN[h][i]) + voffA[i] : gC[h][i]; g2[h][i] = gN[h][i]; }
                } else {
#pragma unroll
                    for (int h = 0; h < 2; ++h)
#pragma unroll
                        for (int i = 0; i < 2; ++i) g2[h][i] = gC[h][i]; } }
            if constexpr (!FP8) {
            PG8_LDB(B0, 0, 0); PG8_LDB(B1, 0, 1); PG8_SCHED; PG8_LDA(At, 0, 0); PG8_STAGEA(PG8_SA(1, 1), a1, 1, gC);
            PG8_WAIT_V(8); PG8_WAIT_L(0); PG8_BAR; PG8_MMA(0, 0, At, B0); PG8_MMA(0, 1, At, B1); PG8_BAR; PG8_SCHED;
            PG8_LDA(At, 0, 1); PG8_STAGEB(PG8_SB(0, 0), b2); PG8_STAGEB(PG8_SB(0, 1), b2 + hstep); PG8_STAGEA(PG8_SA(0, 0), a2, 0, g2);
            PG8_WAIT_V(8); PG8_WAIT_L(0); PG8_BAR; PG8_MMA(1, 0, At, B0); PG8_MMA(1, 1, At, B1); PG8_BAR; PG8_SCHED;
            PG8_LDB(B0, 1, 0); PG8_LDB(B1, 1, 1); PG8_SCHED; PG8_LDA(At, 1, 0); PG8_STAGEA(PG8_SA(0, 1), a2, 1, g2);
            PG8_WAIT_V(8); PG8_WAIT_L(0); PG8_BAR; PG8_MMA(0, 0, At, B0); PG8_MMA(0, 1, At, B1); PG8_BAR; PG8_SCHED;
            PG8_LDA(At, 1, 1); PG8_STAGEB(PG8_SB(1, 0), b3); PG8_STAGEB(PG8_SB(1, 1), b3 + hstep); PG8_STAGEA(PG8_SA(1, 0), a3, 0, g2);
            PG8_WAIT_V(8); PG8_WAIT_L(0); PG8_BAR; PG8_MMA(1, 0, At, B0); PG8_MMA(1, 1, At, B1); PG8_BAR; PG8_SCHED;
            } else {
            PG8_LDB8(B08, 0, 0); PG8_LDB8(B18, 0, 1); PG8_SCHED; PG8_LDA8(At8, 0, 0); PG8_STAGEA(PG8_SA(1, 1), a1, 1, gC);
            PG8_WAIT_V(8); PG8_WAIT_L(0); PG8_BAR; PG8_MMA8(0, 0, At8, B08); PG8_MMA8(0, 1, At8, B18); PG8_BAR; PG8_SCHED;
            PG8_LDA8(At8, 0, 1); PG8_STAGEB(PG8_SB(0, 0), b2); PG8_STAGEB(PG8_SB(0, 1), b2 + hstep); PG8_STAGEA(PG8_SA(0, 0), a2, 0, g2);
            PG8_WAIT_V(8); PG8_WAIT_L(0); PG8_BAR; PG8_MMA8(1, 0, At8, B08); PG8_MMA8(1, 1, At8, B18); PG8_BAR; PG8_SCHED;
            PG8_LDB8(B08, 1, 0); PG8_LDB8(B18, 1, 1); PG8_SCHED; PG8_LDA8(At8, 1, 0); PG8_STAGEA(PG8_SA(0, 1), a2, 1, g2);
            PG8_WAIT_V(8); PG8_WAIT_L(0); PG8_BAR; PG8_MMA8(0, 0, At8, B08); PG8_MMA8(0, 1, At8, B18); PG8_BAR; PG8_SCHED;
            PG8_LDA8(At8, 1, 1); PG8_STAGEB(PG8_SB(1, 0), b3); PG8_STAGEB(PG8_SB(1, 1), b3 + hstep); PG8_STAGEA(PG8_SA(1, 0), a3, 0, g2);
            PG8_WAIT_V(8); PG8_WAIT_L(0); PG8_BAR; PG8_MMA8(1, 0, At8, B08); PG8_MMA8(1, 1, At8, B18); PG8_BAR; PG8_SCHED;
            }
        }
        if constexpr (ALIGN_EPI) { if (wr == 0) PG8_BAR; }
        if constexpr (FP8) asm volatile("s_nop 15\n\ts_nop 15" ::: "memory");
        E.prefetch(est, cur, wr, wc, fr, fq); E(acc, est, cur, wr, wc, fr, fq);
        if (!has_next) break;
#pragma unroll
        for (int a = 0; a < 2; ++a)
#pragma unroll
            for (int b = 0; b < 2; ++b)
#pragma unroll
                for (int m = 0; m < 4; ++m)
#pragma unroll
                    for (int n = 0; n < 2; ++n) acc[a][b][m][n] = (f32x4){0.f, 0.f, 0.f, 0.f};
        cur = nxt; cA = nA; cB = nB; ++ui;
        if (GATHER) {
#pragma unroll
            for (int h = 0; h < 2; ++h)
#pragma unroll
                for (int i = 0; i < 2; ++i) gC[h][i] = gN[h][i]; }
        if constexpr (ALIGN_EPI) { if (wr == 1) PG8_BAR; }
    }
    PG8_WAIT_V(0);
    if constexpr (!ALIGN_EPI) { if (wr == 0) PG8_BAR; }
    PG8_BAR;
#undef PG8_SA
#undef PG8_SB
#undef PG8_STAGE2
#undef PG8_STAGEA
#undef PG8_STAGEB
#undef PG8_LDA
#undef PG8_LDB
#undef PG8_MMA
#undef PG8_LDA8
#undef PG8_LDB8
#undef PG8_MMA8
#undef PG8_WAIT_V
#undef PG8_WAIT_L
#undef PG8_BAR
#undef PG8_SCHED
}
}
using pg8::Unit;

struct DenseSched {
    const char* A; const char* Bt; int nM, nN, G, c; size_t tstep;
    __device__ __forceinline__ bool next(int i, Unit& u) const { return pg8::tile_order(i, G, c, nM, nN, u); }
    __device__ __forceinline__ const char* a_base(const Unit& u) const { return A + (size_t)u.pm * tstep; }
    __device__ __forceinline__ const char* b_base(const Unit& u) const { return Bt + (size_t)u.pn * tstep; }
    __device__ __forceinline__ void a_rows(const Unit&, const int (&)[2], unsigned (&)[2][2]) const {}
    __device__ __forceinline__ void a_rows_raw(const Unit&, const int (&)[2], int (&)[2][2]) const {}
    __device__ __forceinline__ unsigned a_row_off(int) const { return 0u; }
};
struct MoeSched {
    const char* A; const char* Wt; size_t estride; int nM, nN, G, c; size_t tstep;
    const volatile LAS int* bstart; const volatile LAS int* cnt; const int* list; int K2; bool gather;
    const volatile LAS unsigned char* blk_e;
    __device__ __forceinline__ int expert_of(int pm) const { return (int)blk_e[pm]; }
    __device__ __forceinline__ bool next(int i, Unit& u) const { return pg8::tile_order(i, G, c, nM, nN, u); }
    __device__ __forceinline__ const char* a_base(const Unit& u) const { return gather ? A : A + (size_t)u.pm * tstep; }
    __device__ __forceinline__ const char* b_base(const Unit& u) const { const int e = expert_of(u.pm); return Wt + (size_t)e * estride + (size_t)u.pn * tstep; }
    __device__ __forceinline__ void a_rows_raw(const Unit& u, const int (&rowA)[2], int (&raw)[2][2]) const {
        const int e = expert_of(u.pm), rb = u.pm - bstart[e], n = cnt[e];
#pragma unroll
        for (int h = 0; h < 2; ++h)
#pragma unroll
            for (int i = 0; i < 2; ++i) { const int idx = rb * 256 + h * 128 + rowA[i]; const int ic = idx < n ? idx : 0; const int v = list[2 * (e * LCAP + ic)]; raw[h][i] = idx < n ? v : 0; }
    }
    __device__ __forceinline__ unsigned a_row_off(int raw) const { return (unsigned)(raw >> 2) * (unsigned)K2; }
    __device__ __forceinline__ void a_rows(const Unit& u, const int (&rowA)[2], unsigned (&o)[2][2]) const {
        const int e = expert_of(u.pm), rb = u.pm - bstart[e], n = cnt[e];
#pragma unroll
        for (int h = 0; h < 2; ++h)
#pragma unroll
            for (int i = 0; i < 2; ++i) { const int idx = rb * 256 + h * 128 + rowA[i]; int tok = 0; if (idx < n) tok = list[2 * (e * LCAP + idx)] >> 2; o[h][i] = (unsigned)tok * (unsigned)K2; }
    }
};

struct EpiBf16 {
    static constexpr bool PERM = true;
    struct State {};
    bf16_t* O; int ldc;
    __device__ __forceinline__ void prefetch(State&, const Unit&, int, int, int, int) const {}
    __device__ __forceinline__ void operator()(const f32x4 (&acc)[2][2][4][2], const State&, const Unit& u, int wr, int wc, int fr, int fq) const {
        const int row0 = u.pm * 256 + wr * 64 + fr, col0 = u.pn * 256 + wc * 32 + 8 * fq;
#pragma unroll
        for (int ai = 0; ai < 2; ++ai)
#pragma unroll
            for (int m = 0; m < 4; ++m) { bf16_t* rowp = O + (size_t)(row0 + ai * 128 + m * 16) * ldc + col0;
#pragma unroll
                for (int bj = 0; bj < 2; ++bj) { const f32x4 v0 = acc[ai][bj][m][0], v1 = acc[ai][bj][m][1];
                    u32x4 w; w.x = pg8::cvt_pk_bf16(v0[0], v0[1]); w.y = pg8::cvt_pk_bf16(v0[2], v0[3]); w.z = pg8::cvt_pk_bf16(v1[0], v1[1]); w.w = pg8::cvt_pk_bf16(v1[2], v1[3]);
                    *(u32x4*)(rowp + bj * 128) = w; } }
    }
};
struct EpiResid {
    static constexpr bool PERM = false;
    const float* X; float* H; const float* mod; float* RSS;
    struct State { f32x4 gt[2][2]; };
    __device__ __forceinline__ void prefetch(State& st, const Unit& u, int wr, int wc, int fr, int fq) const {
        const int b = (u.pm * 256) >> 11; const int col0 = u.pn * 256 + wc * 32 + 4 * fq;
#pragma unroll
        for (int bj = 0; bj < 2; ++bj)
#pragma unroll
            for (int n = 0; n < 2; ++n) st.gt[bj][n] = *(const f32x4*)(mod + b * 6144 + 2048 + col0 + bj * 128 + n * 16);
    }
    __device__ __forceinline__ void operator()(const f32x4 (&acc)[2][2][4][2], const State& st, const Unit& u, int wr, int wc, int fr, int fq) const {
        const int col0 = u.pn * 256 + wc * 32 + 4 * fq;
        const f32x4 (&gt)[2][2] = st.gt;
#pragma unroll
        for (int ai = 0; ai < 2; ++ai)
#pragma unroll
            for (int m = 0; m < 4; ++m) { const int row = u.pm * 256 + ai * 128 + wr * 64 + m * 16 + fr; const size_t off = (size_t)row * D + col0; float ss = 0.f;
#pragma unroll
                for (int bj = 0; bj < 2; ++bj)
#pragma unroll
                    for (int n = 0; n < 2; ++n) { const f32x4 xv = *(const f32x4*)(X + off + bj * 128 + n * 16); const f32x4 hv = xv + gt[bj][n] * acc[ai][bj][m][n];
                        *(f32x4*)(H + off + bj * 128 + n * 16) = hv; ss += (hv[0] * hv[0] + hv[1] * hv[1]) + (hv[2] * hv[2] + hv[3] * hv[3]); }
                ss += __shfl_xor(ss, 16); ss += __shfl_xor(ss, 32);
                if (fq == 0) RSS[(size_t)row * 16 + u.pn * 4 + wc] = ss; }
    }
};
struct EpiNull { static constexpr bool PERM = true; struct State {};
    __device__ __forceinline__ void prefetch(State&, const Unit&, int, int, int, int) const {}
    __device__ __forceinline__ void operator()(const f32x4 (&acc)[2][2][4][2], const State&, const Unit&, int, int, int, int) const {
#pragma unroll
        for (int a = 0; a < 2; ++a)
#pragma unroll
            for (int b = 0; b < 2; ++b)
#pragma unroll
                for (int m = 0; m < 4; ++m)
#pragma unroll
                    for (int n = 0; n < 2; ++n) asm volatile("" :: "v"(acc[a][b][m][n])); } };
template <bool OUT8> struct EpiSwiglu {
    static constexpr bool PERM = true;
    bf16_t* ACT; const float* b1; const MoeSched* S;
    struct State {};
    __device__ __forceinline__ void prefetch(State&, const Unit&, int, int, int, int) const {}
    __device__ __forceinline__ void operator()(const f32x4 (&acc)[2][2][4][2], const State&, const Unit& u, int wr, int wc, int fr, int fq) const {
        const int e = S->expert_of(u.pm);
        const int row0 = u.pm * 256 + wr * 64 + fr, col0 = u.pn * 256 + wc * 32 + 8 * fq;
        f32x4 bv[2][2];
#pragma unroll
        for (int bj = 0; bj < 2; ++bj)
#pragma unroll
            for (int n = 0; n < 2; ++n) bv[bj][n] = *(const f32x4*)(b1 + (size_t)e * 2048 + col0 + bj * 128 + 4 * n);
#pragma unroll
        for (int ai = 0; ai < 2; ++ai)
#pragma unroll
            for (int m = 0; m < 4; ++m) { bf16_t* rowp = ACT + (size_t)(row0 + ai * 128 + m * 16) * 1024 + (col0 >> 1);
#pragma unroll
                for (int bj = 0; bj < 2; ++bj) { float a[4];
#pragma unroll
                    for (int n = 0; n < 2; ++n) { const f32x4 v = acc[ai][bj][m][n] + bv[bj][n];
#pragma unroll
                        for (int p = 0; p < 2; ++p) { const float g = fminf(v[2 * p], 7.0f), l = fminf(fmaxf(v[2 * p + 1], -7.0f), 7.0f);
                            a[2 * n + p] = g * fast_sigmoid(1.702f * g) * (l + 1.0f); } }
                    if constexpr (OUT8) { *(unsigned*)((unsigned char*)ACT + (size_t)(row0 + ai * 128 + m * 16) * 1024 + (col0 >> 1) + bj * 64) = pk4_fp8(a[0], a[1], a[2], a[3]); }
                    else { u32x2 w; w.x = pg8::cvt_pk_bf16(a[0], a[1]); w.y = pg8::cvt_pk_bf16(a[2], a[3]); *(u32x2*)(rowp + bj * 64) = w; } } }
    }
};
struct EpiPair {
    static constexpr bool PERM = true;
    bf16_t* PAIR; const float* b2; const MoeSched* S;
    struct State { u32x2 rec[2][4]; };
    __device__ __forceinline__ void prefetch(State& st, const Unit& u, int wr, int wc, int fr, int fq) const {
        const int e = S->expert_of(u.pm), rb = u.pm - S->bstart[e], n_e = S->cnt[e];
#pragma unroll
        for (int ai = 0; ai < 2; ++ai)
#pragma unroll
            for (int m = 0; m < 4; ++m) { const int idx = rb * 256 + ai * 128 + wr * 64 + m * 16 + fr; const int ic = idx < n_e ? idx : 0;
                st.rec[ai][m] = *(const GAS u32x2*)(S->list + 2 * (e * LCAP + ic)); if (idx >= n_e) st.rec[ai][m].x = 0xffffffffu; }
    }
    __device__ __forceinline__ void operator()(const f32x4 (&acc)[2][2][4][2], const State& st, const Unit& u, int wr, int wc, int fr, int fq) const {
        const int e = S->expert_of(u.pm); const int col0 = u.pn * 256 + wc * 32 + 8 * fq;
        f32x4 bv[2][2];
#pragma unroll
        for (int bj = 0; bj < 2; ++bj)
#pragma unroll
            for (int n = 0; n < 2; ++n) bv[bj][n] = *(const f32x4*)(b2 + (size_t)e * 1024 + col0 + bj * 128 + 4 * n);
#pragma unroll
        for (int ai = 0; ai < 2; ++ai)
#pragma unroll
            for (int m = 0; m < 4; ++m) { const unsigned pu = st.rec[ai][m].x; const unsigned gb = st.rec[ai][m].y;
                if (pu != 0xffffffffu) { const float g = __uint_as_float(gb); bf16_t* rowp = PAIR + (size_t)pu * 1024 + col0;
#pragma unroll
                    for (int bj = 0; bj < 2; ++bj) { const f32x4 v0 = (acc[ai][bj][m][0] + bv[bj][0]) * g, v1 = (acc[ai][bj][m][1] + bv[bj][1]) * g;
                        u32x4 w; w.x = pg8::cvt_pk_bf16(v0[0], v0[1]); w.y = pg8::cvt_pk_bf16(v0[2], v0[3]); w.z = pg8::cvt_pk_bf16(v1[0], v1[1]); w.w = pg8::cvt_pk_bf16(v1[2], v1[3]);
                        *(u32x4*)(rowp + bj * 128) = w; } } }
    }
};

struct Args { const float* in[28]; float* out; unsigned char* ws; int ph_lo, ph_hi; };
enum { I_X = 0, I_C, I_ADAW, I_ADAB, I_N1G, I_WIN, I_CONVW, I_CONVGN, I_MU, I_W0, I_WUP, I_A0, I_AUP, I_GUP, I_KK, I_KA, I_RK, I_LNW, I_LNB, I_WOUT, I_N2G, I_RW, I_RB, I_W1, I_B1, I_W2, I_B2, I_FG };
constexpr int NWAVES = 8;
constexpr int LDS_TOTAL = 163840;
constexpr int LDS_MISC = LDS_TOTAL - 512;

__device__ __forceinline__ void p0_mod_unit(const Args& a, int u, LAS unsigned char* lds, int tid) {
    LAS float* cact = (LAS float*)lds; LAS float* red = (LAS float*)(lds + 65536);
    const float* c = a.in[I_C];
    for (int i = tid; i < 16 * 1024; i += 512) { const float v = c[i]; cact[i] = v * fast_sigmoid(v); }
    __syncthreads();
    const int kq = tid >> 5, col = tid & 31;
    float acc[16];
#pragma unroll
    for (int b = 0; b < 16; ++b) acc[b] = 0.f;
    const float* w = a.in[I_ADAW] + (size_t)(kq * 64) * 6144 + u * 32 + col;
#pragma unroll 4
    for (int k = 0; k < 64; ++k) { const float wv = w[(size_t)k * 6144];
#pragma unroll
        for (int b = 0; b < 16; ++b) acc[b] += cact[b * 1024 + kq * 64 + k] * wv; }
#pragma unroll
    for (int b = 0; b < 16; ++b) red[(kq * 16 + b) * 32 + col] = acc[b];
    __syncthreads();
    { const int b = tid >> 5; float s = a.in[I_ADAB][u * 32 + col];
#pragma unroll
      for (int q = 0; q < 16; ++q) s += red[(q * 16 + b) * 32 + col];
      ((float*)(a.ws + WS_MOD))[b * 6144 + u * 32 + col] = s; }
    __syncthreads();
}
__device__ __forceinline__ void tr_item64(const float* W, int ldw, bf16_t* WT, int ldt, int k0, int n0, LAS float* scr, int lane) {
    const int kr = lane >> 4, c4 = lane & 15;
    f32x4 v[16];
#pragma unroll
    for (int i = 0; i < 16; ++i) v[i] = *(const GAS f32x4*)(W + (size_t)(k0 + 4 * i + kr) * ldw + n0 + 4 * c4);
#pragma unroll
    for (int i = 0; i < 16; ++i) { LAS float* s = scr + (4 * i + kr) * 65 + 4 * c4; s[0] = v[i][0]; s[1] = v[i][1]; s[2] = v[i][2]; s[3] = v[i][3]; }
    LDS_WAIT(); asm volatile("" ::: "memory");
    const int c = lane & 7;
#pragma unroll
    for (int j = 0; j < 8; ++j) { const int n = (lane >> 3) + 8 * j; const LAS float* s = scr + (8 * c) * 65 + n;
        u32x4 o; o.x = pk2(s[0], s[65]); o.y = pk2(s[130], s[195]); o.z = pk2(s[260], s[325]); o.w = pk2(s[390], s[455]);
        *(GAS u32x4*)(WT + (size_t)(n0 + n) * ldt + k0 + 8 * c) = o; }
    LDS_WAIT(); asm volatile("" ::: "memory");
}
__device__ __forceinline__ void tr_item64_fp8(const float* W, int ldw, unsigned char* WT, int ldt, int k0, int n0, int lane) {
    const GAS float* src = (const GAS float*)(W + (size_t)k0 * ldw + n0 + lane);
    float v[64];
#pragma unroll
    for (int k = 0; k < 64; ++k) v[k] = src[(size_t)k * ldw];
    GAS u32x4* dst = (GAS u32x4*)(WT + (size_t)(n0 + lane) * ldt + k0);
#pragma unroll
    for (int j = 0; j < 4; ++j) { u32x4 o; o.x = pk4_fp8(v[16 * j], v[16 * j + 1], v[16 * j + 2], v[16 * j + 3]); o.y = pk4_fp8(v[16 * j + 4], v[16 * j + 5], v[16 * j + 6], v[16 * j + 7]);
        o.z = pk4_fp8(v[16 * j + 8], v[16 * j + 9], v[16 * j + 10], v[16 * j + 11]); o.w = pk4_fp8(v[16 * j + 12], v[16 * j + 13], v[16 * j + 14], v[16 * j + 15]); dst[j] = o; }
}
__device__ __forceinline__ void tr_matrix_item(const float* W, int K, int N, bf16_t* WT, int item, LAS float* scr, int lane) {
    const int nb = N / 64; tr_item64(W, N, WT, K, (item / nb) * 64, (item % nb) * 64, scr, lane);
}
constexpr int TI_WIN = 16 * 52, TI_WOUT = 16 * 16, TI_UP = 8, TI_GUP = 16, TI_SMALL = TI_WIN + TI_WOUT + 2 * TI_UP + TI_GUP;
constexpr int TI_W1 = 16 * 32, TI_W2 = 16 * 16, TI_TOTAL = TI_SMALL + NE * (TI_W1 + TI_W2);
constexpr int XP3_ITEMS = 4 * 256 * 8 * XP3_PER;
constexpr int XP2_ITEMS = 8192;
constexpr int XP_ALL = NE * (TI_W1 + TI_W2);
__device__ __forceinline__ void p0_phase(const Args& a, LAS unsigned char* lds, int tid, int wave, int lane, int vcu, int G) {
    if (blockIdx.x < 192) p0_mod_unit(a, blockIdx.x, lds, tid);
    else if (blockIdx.x < 256) { const int i = (blockIdx.x - 192) * 512 + tid, k = i >> 5, e = i & 31; const float w = a.in[I_RW][i];
        const unsigned hi = f2bf(w); const float lo = w - __builtin_bit_cast(float, hi << 16);
        bf16_t* rwh = (bf16_t*)(a.ws + WS_RWH); rwh[e * 1024 + k] = (bf16_t)hi; rwh[32 * 1024 + e * 1024 + k] = (bf16_t)f2bf(lo); }
    LAS float* scr = (LAS float*)(lds + wave * 16640);
    unsigned char* ws = a.ws;
    bf16_t* lora = (bf16_t*)(ws + WS_LORA);
    const int gw = vcu * NWAVES + wave, NGW = G * NWAVES;
    for (int it = gw; it < TI_SMALL; it += NGW) {
        int r = it;
        if (r < TI_WIN) { tr_matrix_item(a.in[I_WIN], 1024, NIN, (bf16_t*)(ws + WS_WIN), r, scr, lane); continue; } r -= TI_WIN;
        if (r < TI_WOUT) { tr_matrix_item(a.in[I_WOUT], 1024, 1024, (bf16_t*)(ws + WS_WOUT), r, scr, lane); continue; } r -= TI_WOUT;
        if (r < TI_UP) { tr_matrix_item(a.in[I_WUP], 64, 512, lora, r, scr, lane); continue; } r -= TI_UP;
        if (r < TI_UP) { tr_matrix_item(a.in[I_AUP], 64, 512, lora + 512 * 64, r, scr, lane); continue; } r -= TI_UP;
        tr_matrix_item(a.in[I_GUP], 128, 512, lora + 2 * 512 * 64, r, scr, lane);
    }
}
__device__ __forceinline__ void expert_transposes(const Args& a, LAS float* scr, int gw, int NGW, int lane, int rend = NE * (TI_W1 + TI_W2)) {
    unsigned char* ws = a.ws;
    for (int r = gw; r < rend; r += NGW) {
        if (r < NE * TI_W1) { const int e = r / TI_W1, it = r % TI_W1;
            if (FP8_G3) tr_item64_fp8(a.in[I_W1] + (size_t)e * 1024 * 2048, 2048, ws + WS_W1T + (size_t)e * 2048 * 1024, 1024, (it / 32) * 64, (it % 32) * 64, lane);
            else tr_matrix_item(a.in[I_W1] + (size_t)e * 1024 * 2048, 1024, 2048, (bf16_t*)(ws + WS_W1T) + (size_t)e * 2048 * 1024, it, scr, lane); }
        else { const int q = r - NE * TI_W1; const int e = q / TI_W2, it = q % TI_W2;
            if (FP8_G4) tr_item64_fp8(a.in[I_W2] + (size_t)e * 1024 * 1024, 1024, ws + WS_W2T + (size_t)e * 1024 * 1024, 1024, (it / 16) * 64, (it % 16) * 64, lane);
            else tr_matrix_item(a.in[I_W2] + (size_t)e * 1024 * 1024, 1024, 1024, (bf16_t*)(ws + WS_W2T) + (size_t)e * 1024 * 1024, it, scr, lane); }
    }
}

__device__ __forceinline__ void p1_phase(const Args& a, int wave, int lane, int vcu, int G) {
    const float* mod = (const float*)(a.ws + WS_MOD); bf16_t* U = (bf16_t*)(a.ws + WS_U);
    const int gw = vcu * NWAVES + wave, NGW = G * NWAVES;
    for (int row = gw; row < M; row += NGW) {
        const int b = row >> 11;
        const GAS f32x4* xr = (const GAS f32x4*)(a.in[I_X] + (size_t)row * D) + lane;
        f32x4 v[4]; float s = 0.f;
#pragma unroll
        for (int j = 0; j < 4; ++j) { v[j] = xr[64 * j]; s += (v[j][0] * v[j][0] + v[j][1] * v[j][1]) + (v[j][2] * v[j][2] + v[j][3] * v[j][3]); }
        const float inv = 1.0f / sqrtf(wave_sum(s) * (1.f / D) + NORM_EPS);
        GAS u32x2* o8 = (GAS u32x2*)(U + (size_t)row * D) + lane;
#pragma unroll
        for (int j = 0; j < 4; ++j) { const int col = 4 * lane + 256 * j;
            const f32x4 g = *(const f32x4*)(a.in[I_N1G] + col), sh = *(const f32x4*)(mod + b * 6144 + col), sc = *(const f32x4*)(mod + b * 6144 + 1024 + col);
            const f32x4 y = v[j] * inv * g * (sc + 1.0f) + sh;
            u32x2 w; w.x = pk2(y[0], y[1]); w.y = pk2(y[2], y[3]); o8[64 * j] = w; }
    }
}

__device__ __forceinline__ void p3_conv(const Args& a, int wave, int lane, int vcu, int G) {
    const bf16_t* P = (const bf16_t*)(a.ws + WS_PROJ); bf16_t* Y = (bf16_t*)(a.ws + WS_YMIX);
    const int gw = vcu * NWAVES + wave, NGW = G * NWAVES;
    const int c0 = 8 * lane;
    float w0[8], w1[8], w2[8], gn[8];
#pragma unroll
    for (int e = 0; e < 8; ++e) { w0[e] = a.in[I_CONVW][c0 + e]; w1[e] = a.in[I_CONVW][512 + c0 + e]; w2[e] = a.in[I_CONVW][1024 + c0 + e]; gn[e] = a.in[I_CONVGN][c0 + e]; }
    for (int run = gw; run < M / 16; run += NGW) {
        const int row0 = run * 16, t0 = row0 & (SEQ - 1);
        const bf16_t* pr = P + (size_t)row0 * NIN + c0;
        float u1[8], u2[8];
#pragma unroll
        for (int e = 0; e < 8; ++e) { u1[e] = 0.f; u2[e] = 0.f; }
        if (t0 > 0) { const u32x4 c1 = *(const GAS u32x4*)(pr - NIN + COL_C), h1 = *(const GAS u32x4*)(pr - NIN + COL_H), c2 = *(const GAS u32x4*)(pr - 2 * NIN + COL_C), h2 = *(const GAS u32x4*)(pr - 2 * NIN + COL_H);
#pragma unroll
            for (int q = 0; q < 4; ++q) { u1[2 * q] = bflo(c1[q]) * bflo(h1[q]); u1[2 * q + 1] = bfhi(c1[q]) * bfhi(h1[q]); u2[2 * q] = bflo(c2[q]) * bflo(h2[q]); u2[2 * q + 1] = bfhi(c2[q]) * bfhi(h2[q]); } }
        u32x4 bg = *(const GAS u32x4*)(pr + COL_B), cg = *(const GAS u32x4*)(pr + COL_C), hg = *(const GAS u32x4*)(pr + COL_H);
#pragma unroll 4
        for (int i = 0; i < 16; ++i) {
            u32x4 nb = bg, nc = cg, nh = hg;
            if (i < 15) { const bf16_t* pn = pr + (size_t)(i + 1) * NIN; nb = *(const GAS u32x4*)(pn + COL_B); nc = *(const GAS u32x4*)(pn + COL_C); nh = *(const GAS u32x4*)(pn + COL_H); }
            float y[8], u0[8]; float ss = 0.f;
#pragma unroll
            for (int q = 0; q < 4; ++q) { u0[2 * q] = bflo(cg[q]) * bflo(hg[q]); u0[2 * q + 1] = bfhi(cg[q]) * bfhi(hg[q]); }
#pragma unroll
            for (int e = 0; e < 8; ++e) { const float bgv = (e & 1) ? bfhi(bg[e >> 1]) : bflo(bg[e >> 1]); y[e] = (w0[e] * u2[e] + w1[e] * u1[e] + w2[e] * u0[e]) * bgv; ss += y[e] * y[e]; u2[e] = u1[e]; u1[e] = u0[e]; }
            ss += __shfl_xor(ss, 1); ss += __shfl_xor(ss, 2); ss += __shfl_xor(ss, 4);
            const float rs = 1.0f / sqrtf(ss * (1.f / 64.f) + NORM_EPS);
            u32x4 o; o.x = pk2(y[0] * rs * gn[0], y[1] * rs * gn[1]); o.y = pk2(y[2] * rs * gn[2], y[3] * rs * gn[3]); o.z = pk2(y[4] * rs * gn[4], y[5] * rs * gn[5]); o.w = pk2(y[6] * rs * gn[6], y[7] * rs * gn[7]);
            *(GAS u32x4*)(Y + (size_t)(row0 + i) * D + c0) = o;
            bg = nb; cg = nc; hg = nh;
        }
    }
}

__device__ __forceinline__ f32x16 zero16() { f32x16 z;
#pragma unroll
    for (int i = 0; i < 16; ++i) z[i] = 0.f; return z; }
__device__ __forceinline__ int tile_off(int t, int c) { return t * 128 + ((((c >> 3) ^ (t & 7))) << 4) + (c & 7) * 2; }
template <int KC> __device__ __forceinline__ void lora_mm(const LAS unsigned char* codes, int code_off, const bf16_t* WT, int h, int r32, int h2, f32x16 (&acc)[2]) {
    acc[0] = zero16(); acc[1] = zero16();
#pragma unroll
    for (int ks = 0; ks < KC / 16; ++ks) {
        const bf16x8 A = *(const LAS bf16x8*)(codes + r32 * 528 + (code_off + 16 * ks + 8 * h2) * 2);
#pragma unroll
        for (int ct = 0; ct < 2; ++ct) { const bf16x8 B = *(const GAS bf16x8*)(WT + (size_t)(h * 64 + 32 * ct + r32) * KC + 16 * ks + 8 * h2);
            acc[ct] = __builtin_amdgcn_mfma_f32_32x32x16_bf16(A, B, acc[ct], 0, 0, 0); }
    }
}
__device__ __forceinline__ void acc_to_cols(const f32x16 (&acc)[2], LAS float* SC, int lane, int r32, int h2, float (&x)[32]) {
#pragma unroll
    for (int ct = 0; ct < 2; ++ct)
#pragma unroll
        for (int q = 0; q < 4; ++q) *(LAS f32x4*)(SC + (32 * ct + r32) * 36 + 8 * q + 4 * h2) = (f32x4){acc[ct][4 * q], acc[ct][4 * q + 1], acc[ct][4 * q + 2], acc[ct][4 * q + 3]};
    LDS_WAIT(); asm volatile("" ::: "memory");
#pragma unroll
    for (int q = 0; q < 8; ++q) { const f32x4 v = *(const LAS f32x4*)(SC + lane * 36 + 4 * q); x[4 * q] = v[0]; x[4 * q + 1] = v[1]; x[4 * q + 2] = v[2]; x[4 * q + 3] = v[3]; }
    LDS_WAIT(); asm volatile("" ::: "memory");
}
__device__ __forceinline__ void st_frag(unsigned char* blk, int f, int lanepos, u32x4 v) { *(GAS u32x4*)(blk + f * 1024 + lanepos * 16) = v; }
__device__ __forceinline__ u32x4 tile_frag_pi(const LAS unsigned char* T, int t, int ks, int h2) {
    const u32x2 lo = *(const LAS u32x2*)(T + t * 128 + (((2 * ks) ^ (t & 7)) << 4) + 8 * h2);
    const u32x2 hi = *(const LAS u32x2*)(T + t * 128 + (((2 * ks + 1) ^ (t & 7)) << 4) + 8 * h2);
    return (u32x4){lo.x, lo.y, hi.x, hi.y};
}

#ifndef PROBE_DUP
#define PROBE_DUP -1
#endif
#define P3REP(k) _Pragma("unroll 1") for (int _rep = 0; _rep < ((PROBE_DUP == 300 + (k)) ? 2 : 1); ++_rep)
__device__ __forceinline__ void p3_rwkv_group(const Args& a, int grp, LAS unsigned char* lds, int tid, int wave, int lane) {
    const int b = grp >> 6, ch = grp & 63, t0 = ch * CL; const size_t row0 = (size_t)b * SEQ + t0;
    const bf16_t* P = (const bf16_t*)(a.ws + WS_PROJ);
    LAS unsigned char* codes = lds + 131072;
    P3REP(1) {
        const int t = tid >> 4, j0 = (tid & 15) * 16;
        const bf16_t* cur = P + (row0 + t) * NIN + COL_DW + j0;
        const u32x4 c0 = *(const GAS u32x4*)cur, c1 = *(const GAS u32x4*)(cur + 8);
        u32x4 p0 = (u32x4){0u, 0u, 0u, 0u}, p1 = p0;
        if (t0 + t > 0) { p0 = *(const GAS u32x4*)(cur - NIN); p1 = *(const GAS u32x4*)(cur - NIN + 8); }
        const float* mu = a.in[I_MU] + 1536 + j0;
        float o[16];
#pragma unroll
        for (int q = 0; q < 8; ++q) { const unsigned cw = q < 4 ? c0[q] : c1[q - 4], pw = q < 4 ? p0[q] : p1[q - 4];
            const float cl = bflo(cw), chh = bfhi(cw), pl = bflo(pw), ph = bfhi(pw);
            o[2 * q] = cl + (pl - cl) * mu[2 * q]; o[2 * q + 1] = chh + (ph - chh) * mu[2 * q + 1]; }
        if (j0 < 64) {
#pragma unroll
            for (int e = 0; e < 16; ++e) o[e] = 1.0f - 2.0f * __builtin_amdgcn_rcpf(1.0f + __expf(2.0f * o[e]));
        } else if (j0 >= 128) {
#pragma unroll
            for (int e = 0; e < 16; ++e) o[e] = fast_sigmoid(o[e]);
        }
        u32x4 w0, w1; w0.x = pk2(o[0], o[1]); w0.y = pk2(o[2], o[3]); w0.z = pk2(o[4], o[5]); w0.w = pk2(o[6], o[7]);
        w1.x = pk2(o[8], o[9]); w1.y = pk2(o[10], o[11]); w1.z = pk2(o[12], o[13]); w1.w = pk2(o[14], o[15]);
        *(LAS u32x4*)(codes + t * 528 + j0 * 2) = w0; *(LAS u32x4*)(codes + t * 528 + j0 * 2 + 16) = w1;
        __syncthreads();
    }
    const int h = wave, bh = b * 8 + h, hc = h * 64 + lane, r32 = lane & 31, h2 = lane >> 5;
    LAS unsigned char* wl = lds + wave * 16384;
    LAS float* SC = (LAS float*)wl;
    LAS unsigned char* T_A = wl, *T_B = wl + 4096, *T_K = wl + 8192, *T_R = wl + 12288;
    unsigned char* blk = a.ws + WS_CH + ((size_t)bh * NCH + ch) * CHB;
    const bf16_t* lora = (const bf16_t*)(a.ws + WS_LORA);
    f32x16 acc[2]; float x[32];
    const __amdgpu_buffer_rsrc_t prs = __builtin_amdgcn_make_buffer_rsrc((void*)P, 0, M * NIN * 2, 0x00020000);
    const int pvo = (COL_R + hc) * 2; const int pso = (int)row0 * (NIN * 2);
#define PRAW(t, c) __builtin_amdgcn_raw_buffer_load_b16(prs, pvo + (c) * 1024, pso + (t) * (NIN * 2), 0)
    unsigned short rr[8], rk_[8], rv[8];
#pragma unroll
    for (int i = 0; i < 8; ++i) { rr[i] = PRAW(i, 0); rk_[i] = PRAW(i, 1); rv[i] = PRAW(i, 2); }
    float cum[32]; unsigned xa2[16];
    P3REP(2) {
    lora_mm<128>(codes, 128, lora + 2 * 512 * 64, h, r32, h2, acc); acc_to_cols(acc, SC, lane, r32, h2, x);
    { unsigned char* Gp = blk + CH_G + lane * 64;
#pragma unroll
      for (int q = 0; q < 4; ++q) { u32x4 w; w.x = pk2(x[8 * q], x[8 * q + 1]); w.y = pk2(x[8 * q + 2], x[8 * q + 3]); w.z = pk2(x[8 * q + 4], x[8 * q + 5]); w.w = pk2(x[8 * q + 6], x[8 * q + 7]); *(GAS u32x4*)(Gp + 16 * q) = w; } }
    lora_mm<64>(codes, 0, lora, h, r32, h2, acc); acc_to_cols(acc, SC, lane, r32, h2, x);
    { const float w0c = a.in[I_W0][hc]; float run = 0.f;
#pragma unroll
      for (int t = 0; t < 32; ++t) { run -= 0.6065306597f * fast_sigmoid(w0c + x[t]); cum[t] = run; } }
    lora_mm<64>(codes, 64, lora + 512 * 64, h, r32, h2, acc); acc_to_cols(acc, SC, lane, r32, h2, x);
    { const float a0c = a.in[I_A0][hc];
#pragma unroll
      for (int t = 0; t < 16; ++t) xa2[t] = pk2(fast_sigmoid(a0c + x[2 * t]), fast_sigmoid(a0c + x[2 * t + 1])); }
    }
    unsigned vv2[16]; float bon = 0.f; float e_prev = 1.0f;
    P3REP(3) {
    if (_rep) {
#pragma unroll
        for (int i = 0; i < 8; ++i) { rr[i] = PRAW(i, 0); rk_[i] = PRAW(i, 1); rv[i] = PRAW(i, 2); } }
    bon = 0.f; e_prev = 1.0f;
    const float mur = a.in[I_MU][hc], muk = a.in[I_MU][512 + hc], muv = a.in[I_MU][1024 + hc];
    const float kkc = a.in[I_KK][hc], kac = a.in[I_KA][hc], rkc = a.in[I_RK][hc];
    float pr_r = 0.f, pr_k = 0.f, pr_v = 0.f;
    if (t0 > 0) { pr_r = bf2f(PRAW(-1, 0)); pr_k = bf2f(PRAW(-1, 1)); pr_v = bf2f(PRAW(-1, 2)); }
#pragma unroll
    for (int bi = 0; bi < 4; ++bi) {
        unsigned short nr[8], nk[8], nv[8];
        if (bi < 3) {
#pragma unroll
            for (int i = 0; i < 8; ++i) { nr[i] = PRAW(8 * (bi + 1) + i, 0); nk[i] = PRAW(8 * (bi + 1) + i, 1); nv[i] = PRAW(8 * (bi + 1) + i, 2); }
        }
        asm volatile("" ::: "memory");
        float vprev = 0.f;
#pragma unroll
        for (int i = 0; i < 8; ++i) { const int t = 8 * bi + i;
            const float cr = bf2f(rr[i]), ck = bf2f(rk_[i]), cv = bf2f(rv[i]);
            const float r = cr + (pr_r - cr) * mur, k = ck + (pr_k - ck) * muk, v = cv + (pr_v - cv) * muv;
            pr_r = cr; pr_k = ck; pr_v = cv;
            const float kkr = k * kkc; const float nsq = wave_sum(kkr * kkr);
            const float kkn = kkr * __builtin_amdgcn_rsqf(fmaxf(nsq, 1e-24f));
            const float at = (t & 1) ? bfhi(xa2[t >> 1]) : bflo(xa2[t >> 1]);
            const float kp = k * (1.0f + (at - 1.0f) * kac);
            const float bs = wave_sum(r * kp * rkc);
            bon = (lane == t) ? bs : bon;
            const float e_cur = __expf(cum[t]), e_neg = __builtin_amdgcn_rcpf(e_cur);
            const float Ah = -kkn * e_prev, Bv = kkn * at * e_neg, Kv = kp * e_neg, Rh = r * e_cur;
            e_prev = e_cur;
            if (i & 1) vv2[t >> 1] = pk2(vprev, v); else vprev = v;
            const int to = tile_off(t, lane);
            *(LAS unsigned short*)(T_A + to) = (unsigned short)f2bf(Ah); *(LAS unsigned short*)(T_B + to) = (unsigned short)f2bf(Bv);
            *(LAS unsigned short*)(T_K + to) = (unsigned short)f2bf(Kv); *(LAS unsigned short*)(T_R + to) = (unsigned short)f2bf(Rh);
        }
        asm volatile("" ::: "memory");
        if (bi < 3) {
#pragma unroll
            for (int i = 0; i < 8; ++i) { rr[i] = nr[i]; rk_[i] = nk[i]; rv[i] = nv[i]; }
        }
    }
    }
    f32x16 ab, ak, rb, rk;
    P3REP(4) {
    { unsigned char* Vp = blk + CH_V + lane * 64;
#pragma unroll
      for (int q = 0; q < 4; ++q) *(GAS u32x4*)(Vp + 16 * q) = (u32x4){vv2[4 * q], vv2[4 * q + 1], vv2[4 * q + 2], vv2[4 * q + 3]};
      if (lane < 32) *(GAS float*)(blk + CH_BON + lane * 4) = bon;
      *(GAS float*)(blk + CH_PL + lane * 4) = e_prev;
#pragma unroll
      for (int ks = 0; ks < 2; ++ks)
#pragma unroll
          for (int hh = 0; hh < 2; ++hh) { const int s0 = 16 * ks + 4 * hh, s1 = s0 + 8;
              st_frag(blk, 22 + 2 * h2 + ks, 32 * hh + r32, (u32x4){vv2[s0 >> 1], vv2[(s0 >> 1) + 1], vv2[s1 >> 1], vv2[(s1 >> 1) + 1]}); } }
    LDS_WAIT(); asm volatile("" ::: "memory");
    ab = zero16(); ak = zero16(); rb = zero16(); rk = zero16();
#pragma unroll
    for (int ks = 0; ks < 4; ++ks) { const int fo = r32 * 128 + (((2 * ks + h2) ^ (r32 & 7)) << 4);
        const bf16x8 fa = *(const LAS bf16x8*)(T_A + fo), fb = *(const LAS bf16x8*)(T_B + fo), fk = *(const LAS bf16x8*)(T_K + fo), frr = *(const LAS bf16x8*)(T_R + fo);
        ab = __builtin_amdgcn_mfma_f32_32x32x16_bf16(fb, fa, ab, 0, 0, 0); ak = __builtin_amdgcn_mfma_f32_32x32x16_bf16(fk, fa, ak, 0, 0, 0);
        rb = __builtin_amdgcn_mfma_f32_32x32x16_bf16(fb, frr, rb, 0, 0, 0); rk = __builtin_amdgcn_mfma_f32_32x32x16_bf16(fk, frr, rk, 0, 0, 0); }
#pragma unroll
    for (int ks = 0; ks < 4; ++ks) st_frag(blk, 4 + ks, lane, tile_frag_pi(T_R, r32, ks, h2));
    { unsigned short tb[32], tk[32];
#pragma unroll
      for (int t = 0; t < 32; ++t) { const int to = tile_off(t, lane); tb[t] = *(const LAS unsigned short*)(T_B + to); tk[t] = *(const LAS unsigned short*)(T_K + to); }
#pragma unroll
      for (int ks = 0; ks < 2; ++ks)
#pragma unroll
          for (int hh = 0; hh < 2; ++hh) { const int s0 = 16 * ks + 4 * hh, s1 = s0 + 8; const int lp = 32 * hh + r32;
              u32x4 w; w.x = (unsigned)tb[s0] | ((unsigned)tb[s0 + 1] << 16); w.y = (unsigned)tb[s0 + 2] | ((unsigned)tb[s0 + 3] << 16); w.z = (unsigned)tb[s1] | ((unsigned)tb[s1 + 1] << 16); w.w = (unsigned)tb[s1 + 2] | ((unsigned)tb[s1 + 3] << 16);
              st_frag(blk, 14 + 4 * h2 + ks, lp, w);
              w.x = (unsigned)tk[s0] | ((unsigned)tk[s0 + 1] << 16); w.y = (unsigned)tk[s0 + 2] | ((unsigned)tk[s0 + 3] << 16); w.z = (unsigned)tk[s1] | ((unsigned)tk[s1 + 1] << 16); w.w = (unsigned)tk[s1 + 2] | ((unsigned)tk[s1 + 3] << 16);
              st_frag(blk, 14 + 4 * h2 + 2 + ks, lp, w); } }
    LDS_WAIT(); asm volatile("" ::: "memory");
#pragma unroll
    for (int ks = 0; ks < 2; ++ks) { float m[8], n[8];
#pragma unroll
        for (int j = 0; j < 8; ++j) { const int r = 8 * ks + j; const int s = (r & 3) + 8 * (r >> 2) + 4 * h2; m[j] = (s <= r32) ? rb[r] : 0.f; n[j] = (s <= r32) ? rk[r] : 0.f; }
        u32x4 w; w.x = pk2(m[0], m[1]); w.y = pk2(m[2], m[3]); w.z = pk2(m[4], m[5]); w.w = pk2(m[6], m[7]); st_frag(blk, 8 + ks, lane, w);
        w.x = pk2(n[0], n[1]); w.y = pk2(n[2], n[3]); w.z = pk2(n[4], n[5]); w.w = pk2(n[6], n[7]); st_frag(blk, 12 + ks, lane, w); }
    }
    float xs[32], m1[32];
    P3REP(5) {
    LAS float* F_AB = (LAS float*)T_B; LAS float* F_AK = (LAS float*)T_K;
#pragma unroll
    for (int q = 0; q < 4; ++q) { f32x4 u, w;
#pragma unroll
        for (int i = 0; i < 4; ++i) { const int s = 8 * q + 4 * h2 + i; u[i] = (s < r32) ? ab[4 * q + i] : 0.f; w[i] = (s < r32) ? ak[4 * q + i] : 0.f; }
        *(LAS f32x4*)(F_AB + r32 * 32 + 8 * q + 4 * h2) = u; *(LAS f32x4*)(F_AK + r32 * 32 + 8 * q + 4 * h2) = w; }
    LDS_WAIT(); asm volatile("" ::: "memory");
#pragma unroll
    for (int t = 0; t < 32; ++t) { xs[t] = bf2f(*(const LAS unsigned short*)(T_A + tile_off(t, lane))); m1[t] = F_AK[t * 32 + r32]; }
    {
        f32x4 cfc[8], cfn[8];
        cfc[0] = *(const LAS f32x4*)(F_AB + 32);
#pragma unroll
        for (int t = 1; t < 32; ++t) {
            if (t < 31) {
#pragma unroll
                for (int q = 0; q < (t + 4) / 4; ++q) cfn[q] = *(const LAS f32x4*)(F_AB + (t + 1) * 32 + 4 * q);
            }
            asm volatile("" ::: "memory");
            float s1 = xs[t], s2 = m1[t];
#pragma unroll
            for (int q = 0; q < (t + 3) / 4; ++q) {
#pragma unroll
                for (int i = 0; i < 4; ++i) if (4 * q + i < t) { s1 += cfc[q][i] * xs[4 * q + i]; s2 += cfc[q][i] * m1[4 * q + i]; } }
            xs[t] = s1; m1[t] = s2;
            if (t < 31) {
#pragma unroll
                for (int q = 0; q < (t + 4) / 4; ++q) cfc[q] = cfn[q];
            }
            asm volatile("" : "+v"(xs[t]), "+v"(m1[t]));
        }
    }
    LDS_WAIT(); asm volatile("" ::: "memory");
    }
    LAS unsigned char* T_M = T_A;
#pragma unroll
    for (int t = 0; t < 32; ++t) *(LAS unsigned short*)(T_R + tile_off(t, lane)) = (unsigned short)f2bf(xs[t]);
    if (lane < 32) {
#pragma unroll
        for (int t = 0; t < 32; ++t) *(LAS unsigned short*)(T_M + t * 64 + lane * 2) = (unsigned short)f2bf(m1[t]);
    }
    LDS_WAIT(); asm volatile("" ::: "memory");
#pragma unroll
    for (int ks = 0; ks < 4; ++ks) st_frag(blk, ks, lane, tile_frag_pi(T_R, r32, ks, h2));
#pragma unroll
    for (int ks = 0; ks < 2; ++ks) { const u32x2 lo = *(const LAS u32x2*)(T_M + r32 * 64 + (16 * ks + 4 * h2) * 2), hi = *(const LAS u32x2*)(T_M + r32 * 64 + (16 * ks + 8 + 4 * h2) * 2);
        st_frag(blk, 10 + ks, lane, (u32x4){lo.x, lo.y, hi.x, hi.y}); }
    LDS_WAIT(); asm volatile("" ::: "memory");
#if XPOSE_IN_P3
    { const int j = grp / (int)gridDim.x; const int vc = grp - j * (int)gridDim.x; const int base = ((j * (int)gridDim.x + vc) * 8 + wave) * XP3_PER; expert_transposes(a, (LAS float*)wl, base, 1, lane, base + XP3_PER); }
#endif
    __syncthreads();
}
__device__ __forceinline__ void p3_phase(const Args& a, LAS unsigned char* lds, int tid, int wave, int lane, int vcu, int G, int part = 3) {
    if (part & 1) for (int grp = vcu; grp < BATCH * NCH; grp += G) p3_rwkv_group(a, grp, lds, tid, wave, lane);
    if (part & 2) p3_conv(a, wave, lane, vcu, G);
}

constexpr int P4_SLOT = CHB, P4_OBUF = 3 * CHB, P4_OPITCH = 68;
__device__ __forceinline__ void p4_issue(const unsigned char* blkp, LAS unsigned char* slot, int wave, int lane) {
#pragma unroll
    for (int i = 0; i < 5; ++i) { const int p = wave + 8 * i; if (p < CH_PIECES) __builtin_amdgcn_global_load_lds((const unsigned*)(blkp + p * 1024 + lane * 16), (LAS unsigned*)(slot + p * 1024), 16, 0, 0); }
}
#define P4_FRAG(f) (*(const LAS bf16x8*)(base + (f) * 1024 + lane * 16))
__device__ __forceinline__ void p4_phase(const Args& a, LAS unsigned char* lds, int wave, int lane, int vcu, int G) {
    if (blockIdx.x >= NBH) {
#if !XPOSE_IN_P3
        expert_transposes(a, (LAS float*)lds, (blockIdx.x - NBH) * 8 + wave, (G - NBH) * 8, lane);
#else
        expert_transposes(a, (LAS float*)lds, XP3_ITEMS + (blockIdx.x - NBH) * 8 + wave, (G - NBH) * 8, lane, XP_ALL - XP2_ITEMS);
#endif
        return;
    }
    const int bh = blockIdx.x, b = bh >> 3, h = bh & 7, r32 = lane & 31, h2 = lane >> 5;
    const unsigned char* blk0 = a.ws + WS_CH + (size_t)bh * NCH * CHB;
    const int big = (wave + 32 < CH_PIECES) ? 1 : 0;
    f32x16 S0 = zero16(), S1 = zero16();
    const int gw = wave - 2, tl = lane & 15, q = lane >> 4;
    float lnw[16], lnb[16]; unsigned gv[16]; float bonr = 0.f;
    if (wave == 2 || wave == 3) {
#pragma unroll
        for (int j = 0; j < 16; ++j) { lnw[j] = a.in[I_LNW][h * 64 + 16 * q + j]; lnb[j] = a.in[I_LNB][h * 64 + 16 * q + j]; gv[j] = 0u; }
    }
    p4_issue(blk0, lds, wave, lane);
    p4_issue(blk0 + CHB, lds + P4_SLOT, wave, lane);
    for (int ci = 0; ci <= NCH; ++ci) {
        if (ci < NCH) {
            if (ci + 1 < NCH) { if (big) asm volatile("s_waitcnt vmcnt(5)" ::: "memory"); else asm volatile("s_waitcnt vmcnt(4)" ::: "memory"); }
            else VM_WAIT();
        }
        LDS_WAIT();
        __builtin_amdgcn_s_barrier();
        asm volatile("" ::: "memory");
        if (ci + 2 < NCH) p4_issue(blk0 + (size_t)(ci + 2) * CHB, lds + ((ci + 2) % 3) * P4_SLOT, wave, lane);
        if (wave < 2 && ci < NCH) {
            const int nt = wave;
            const LAS unsigned char* base = lds + (ci % 3) * P4_SLOT;
            const bf16x8 sb00 = pack8(S0[0], S0[1], S0[2], S0[3], S0[4], S0[5], S0[6], S0[7]), sb01 = pack8(S0[8], S0[9], S0[10], S0[11], S0[12], S0[13], S0[14], S0[15]);
            const bf16x8 sb10 = pack8(S1[0], S1[1], S1[2], S1[3], S1[4], S1[5], S1[6], S1[7]), sb11 = pack8(S1[8], S1[9], S1[10], S1[11], S1[12], S1[13], S1[14], S1[15]);
            const bf16x8 vt0 = P4_FRAG(22 + 2 * nt), vt1 = P4_FRAG(23 + 2 * nt);
            f32x16 U = zero16();
            U = __builtin_amdgcn_mfma_f32_32x32x16_bf16(P4_FRAG(0), sb00, U, 0, 0, 0); U = __builtin_amdgcn_mfma_f32_32x32x16_bf16(P4_FRAG(1), sb01, U, 0, 0, 0);
            U = __builtin_amdgcn_mfma_f32_32x32x16_bf16(P4_FRAG(2), sb10, U, 0, 0, 0); U = __builtin_amdgcn_mfma_f32_32x32x16_bf16(P4_FRAG(3), sb11, U, 0, 0, 0);
            U = __builtin_amdgcn_mfma_f32_32x32x16_bf16(P4_FRAG(10), vt0, U, 0, 0, 0); U = __builtin_amdgcn_mfma_f32_32x32x16_bf16(P4_FRAG(11), vt1, U, 0, 0, 0);
            f32x16 O = zero16();
            O = __builtin_amdgcn_mfma_f32_32x32x16_bf16(P4_FRAG(4), sb00, O, 0, 0, 0); O = __builtin_amdgcn_mfma_f32_32x32x16_bf16(P4_FRAG(5), sb01, O, 0, 0, 0);
            O = __builtin_amdgcn_mfma_f32_32x32x16_bf16(P4_FRAG(6), sb10, O, 0, 0, 0); O = __builtin_amdgcn_mfma_f32_32x32x16_bf16(P4_FRAG(7), sb11, O, 0, 0, 0);
            O = __builtin_amdgcn_mfma_f32_32x32x16_bf16(P4_FRAG(12), vt0, O, 0, 0, 0); O = __builtin_amdgcn_mfma_f32_32x32x16_bf16(P4_FRAG(13), vt1, O, 0, 0, 0);
            const bf16x8 ub0 = pack8(U[0], U[1], U[2], U[3], U[4], U[5], U[6], U[7]), ub1 = pack8(U[8], U[9], U[10], U[11], U[12], U[13], U[14], U[15]);
            O = __builtin_amdgcn_mfma_f32_32x32x16_bf16(P4_FRAG(8), ub0, O, 0, 0, 0); O = __builtin_amdgcn_mfma_f32_32x32x16_bf16(P4_FRAG(9), ub1, O, 0, 0, 0);
            S0 = __builtin_amdgcn_mfma_f32_32x32x16_bf16(P4_FRAG(14), ub0, S0, 0, 0, 0); S0 = __builtin_amdgcn_mfma_f32_32x32x16_bf16(P4_FRAG(15), ub1, S0, 0, 0, 0);
            S0 = __builtin_amdgcn_mfma_f32_32x32x16_bf16(P4_FRAG(16), vt0, S0, 0, 0, 0); S0 = __builtin_amdgcn_mfma_f32_32x32x16_bf16(P4_FRAG(17), vt1, S0, 0, 0, 0);
            S1 = __builtin_amdgcn_mfma_f32_32x32x16_bf16(P4_FRAG(18), ub0, S1, 0, 0, 0); S1 = __builtin_amdgcn_mfma_f32_32x32x16_bf16(P4_FRAG(19), ub1, S1, 0, 0, 0);
            S1 = __builtin_amdgcn_mfma_f32_32x32x16_bf16(P4_FRAG(20), vt0, S1, 0, 0, 0); S1 = __builtin_amdgcn_mfma_f32_32x32x16_bf16(P4_FRAG(21), vt1, S1, 0, 0, 0);
            LAS float* ob = (LAS float*)(lds + P4_OBUF) + (ci & 1) * (32 * P4_OPITCH) + 32 * nt + r32;
#pragma unroll
            for (int qq = 0; qq < 4; ++qq) { const f32x4 p0 = *(const LAS f32x4*)(base + CH_PL + (8 * qq + 4 * h2) * 4), p1 = *(const LAS f32x4*)(base + CH_PL + (32 + 8 * qq + 4 * h2) * 4);
#pragma unroll
                for (int i = 0; i < 4; ++i) { S0[4 * qq + i] *= p0[i]; S1[4 * qq + i] *= p1[i]; ob[(8 * qq + 4 * h2 + i) * P4_OPITCH] = O[4 * qq + i]; } }
        }
        if (wave == 2 || wave == 3) {
            if (ci >= 1) {
                const int t = 16 * gw + tl;
                const LAS float* ob = (const LAS float*)(lds + P4_OBUF) + ((ci - 1) & 1) * (32 * P4_OPITCH) + t * P4_OPITCH + 16 * q;
                float o[16]; float s = 0.f;
#pragma unroll
                for (int j4 = 0; j4 < 4; ++j4) { const f32x4 v = *(const LAS f32x4*)(ob + 4 * j4); o[4 * j4] = v[0]; o[4 * j4 + 1] = v[1]; o[4 * j4 + 2] = v[2]; o[4 * j4 + 3] = v[3]; s += (v[0] + v[1]) + (v[2] + v[3]); }
                s += __shfl_xor(s, 16); s += __shfl_xor(s, 32);
                const float mean = s * (1.f / 64.f); float qs = 0.f;
#pragma unroll
                for (int j = 0; j < 16; ++j) { const float d = o[j] - mean; qs += d * d; }
                qs += __shfl_xor(qs, 16); qs += __shfl_xor(qs, 32);
                const float rstd = 1.0f / sqrtf(qs * (1.f / 64.f) + GN_EPS);
                float y[16];
#pragma unroll
                for (int j = 0; j < 16; ++j) y[j] = ((o[j] - mean) * rstd * lnw[j] + lnb[j] + bonr * bfhi(gv[j])) * bflo(gv[j]);
                bf16_t* yp = (bf16_t*)(a.ws + WS_YMIX) + ((size_t)b * SEQ + (ci - 1) * CL + t) * D + 512 + h * 64 + 16 * q;
                u32x4 w0, w1; w0.x = pk2(y[0], y[1]); w0.y = pk2(y[2], y[3]); w0.z = pk2(y[4], y[5]); w0.w = pk2(y[6], y[7]); w1.x = pk2(y[8], y[9]); w1.y = pk2(y[10], y[11]); w1.z = pk2(y[12], y[13]); w1.w = pk2(y[14], y[15]);
                *(GAS u32x4*)yp = w0; *(GAS u32x4*)(yp + 8) = w1;
            }
            if (ci < NCH) {
                const LAS unsigned char* base = lds + (ci % 3) * P4_SLOT; const int t = 16 * gw + tl;
#pragma unroll
                for (int j = 0; j < 16; ++j) { const unsigned g16 = *(const LAS unsigned short*)(base + CH_G + (16 * q + j) * 64 + t * 2), v16 = *(const LAS unsigned short*)(base + CH_V + (16 * q + j) * 64 + t * 2); gv[j] = g16 | (v16 << 16); }
                bonr = *(const LAS float*)(base + CH_BON + t * 4);
            }
        }
    }
    VM_WAIT();
}

__device__ __forceinline__ bool rt_better(float va, int ea, float vb, int eb) { return va > vb || (va == vb && ea < eb); }
__device__ __forceinline__ void p7_phase(const Args& a, LAS unsigned char* lds, int tid, int wave, int lane, int cw_cnt = CW_CNT) {
    LAS int* cntL = (LAS int*)lds;
    LAS int* baseL = cntL + 32;
    LAS int* rec = baseL + 32;
    const float* mod = (const float*)(a.ws + WS_MOD); bf16_t* U = (bf16_t*)(a.ws + WS_U);
    const float* H = a.out; const bf16_t* RWH = (const bf16_t*)(a.ws + WS_RWH);
    if (tid < 32) cntL[tid] = 0;
    __syncthreads();
    const int t = lane & 15, q = lane >> 4;
    const int row = blockIdx.x * 128 + wave * 16 + t, b = row >> 11;
    float inv;
    { const f32x4 p = *(const GAS f32x4*)((const float*)(a.ws + WS_RSS) + (size_t)row * 16 + 4 * q); float s = (p[0] + p[1]) + (p[2] + p[3]);
      s += __shfl_xor(s, 16); s += __shfl_xor(s, 32); inv = 1.0f / sqrtf(s * (1.f / D) + NORM_EPS); }
    const float* hp = H + (size_t)row * D + 8 * q; const float* gp = a.in[I_N2G] + 8 * q; const float* shp = mod + b * 6144 + 3072 + 8 * q; const float* scp = mod + b * 6144 + 4096 + 8 * q;
    bf16_t* up = U + (size_t)row * D + 8 * q; const bf16_t* wp = RWH + (size_t)t * 1024 + 8 * q;
    f32x4 acc0 = (f32x4){0.f, 0.f, 0.f, 0.f}, acc1 = acc0;
#pragma unroll 4
    for (int ks = 0; ks < 32; ++ks) {
        const int ko = 32 * ks;
        const f32x4 h0 = *(const GAS f32x4*)(hp + ko), h1 = *(const GAS f32x4*)(hp + ko + 4);
        const f32x4 g0 = *(const f32x4*)(gp + ko), g1 = *(const f32x4*)(gp + ko + 4), s0 = *(const f32x4*)(scp + ko), s1 = *(const f32x4*)(scp + ko + 4), b0 = *(const f32x4*)(shp + ko), b1 = *(const f32x4*)(shp + ko + 4);
        const bf16x8 ah0 = *(const GAS bf16x8*)(wp + ko), ah1 = *(const GAS bf16x8*)(wp + 16 * 1024 + ko), al0 = *(const GAS bf16x8*)(wp + 32 * 1024 + ko), al1 = *(const GAS bf16x8*)(wp + 48 * 1024 + ko);
        const f32x4 u0 = h0 * inv * g0 * (s0 + 1.0f) + b0, u1 = h1 * inv * g1 * (s1 + 1.0f) + b1;
        u32x4 hi; hi.x = pk2(u0[0], u0[1]); hi.y = pk2(u0[2], u0[3]); hi.z = pk2(u1[0], u1[1]); hi.w = pk2(u1[2], u1[3]);
        if (FP8_G3) { u32x2 w8; w8.x = pk4_fp8(u0[0], u0[1], u0[2], u0[3]); w8.y = pk4_fp8(u1[0], u1[1], u1[2], u1[3]); *(GAS u32x2*)((unsigned char*)U + (size_t)row * D + 8 * q + ko) = w8; }
        else *(GAS u32x4*)(up + ko) = hi;
        u32x4 lo; lo.x = pk2(u0[0] - bflo(hi.x), u0[1] - bfhi(hi.x)); lo.y = pk2(u0[2] - bflo(hi.y), u0[3] - bfhi(hi.y)); lo.z = pk2(u1[0] - bflo(hi.z), u1[1] - bfhi(hi.z)); lo.w = pk2(u1[2] - bflo(hi.w), u1[3] - bfhi(hi.w));
        const bf16x8 bh = __builtin_bit_cast(bf16x8, hi), bl = __builtin_bit_cast(bf16x8, lo);
        acc0 = __builtin_amdgcn_mfma_f32_16x16x32_bf16(ah0, bh, acc0, 0, 0, 0); acc0 = __builtin_amdgcn_mfma_f32_16x16x32_bf16(ah0, bl, acc0, 0, 0, 0); acc0 = __builtin_amdgcn_mfma_f32_16x16x32_bf16(al0, bh, acc0, 0, 0, 0);
        acc1 = __builtin_amdgcn_mfma_f32_16x16x32_bf16(ah1, bh, acc1, 0, 0, 0); acc1 = __builtin_amdgcn_mfma_f32_16x16x32_bf16(ah1, bl, acc1, 0, 0, 0); acc1 = __builtin_amdgcn_mfma_f32_16x16x32_bf16(al1, bh, acc1, 0, 0, 0);
    }
    float val[8]; int ex[8];
#pragma unroll
    for (int r = 0; r < 4; ++r) { ex[r] = 4 * q + r; ex[4 + r] = 16 + 4 * q + r; val[r] = acc0[r] + a.in[I_RB][4 * q + r]; val[4 + r] = acc1[r] + a.in[I_RB][16 + 4 * q + r]; }
    int ek[4]; float lk[4];
#pragma unroll
    for (int k = 0; k < 4; ++k) {
        float bv = val[0]; int be = ex[0];
#pragma unroll
        for (int r = 1; r < 8; ++r) if (rt_better(val[r], ex[r], bv, be)) { bv = val[r]; be = ex[r]; }
        { const float ov = __shfl_xor(bv, 16); const int oe = __shfl_xor(be, 16); if (rt_better(ov, oe, bv, be)) { bv = ov; be = oe; } }
        { const float ov = __shfl_xor(bv, 32); const int oe = __shfl_xor(be, 32); if (rt_better(ov, oe, bv, be)) { bv = ov; be = oe; } }
        ek[k] = be; lk[k] = bv;
#pragma unroll
        for (int r = 0; r < 8; ++r) if (ex[r] == be) val[r] = -INFINITY;
    }
    const float e1 = __expf(lk[1] - lk[0]), e2 = __expf(lk[2] - lk[0]), e3 = __expf(lk[3] - lk[0]); const float rs = 1.0f / (1.0f + e1 + e2 + e3);
    { const int e = q == 0 ? ek[0] : q == 1 ? ek[1] : q == 2 ? ek[2] : ek[3];
      const float g = (q == 0 ? 1.0f : q == 1 ? e1 : q == 2 ? e2 : e3) * rs;
      const int pos = atomicAdd((int*)&cntL[e], 1);
      LAS int* r = rec + ((wave * 16 + t) * 4 + q) * 3; r[0] = e; r[1] = pos; r[2] = __builtin_bit_cast(int, g); }
    __syncthreads();
    if (tid < 32) baseL[tid] = atomicAdd((int*)(a.ws + WS_CTL) + cw_cnt + tid, cntL[tid]);
    __syncthreads();
    { const LAS int* r = rec + tid * 3; const int e = r[0], slot = baseL[e] + r[1]; const int pair = (blockIdx.x * 128 + (tid >> 2)) * 4 + (tid & 3);
      ((GAS u32x2*)(a.ws + WS_LIST))[e * LCAP + slot] = (u32x2){(unsigned)pair, (unsigned)r[2]}; }
}

__device__ __forceinline__ void p10_phase(const Args& a, int wave, int lane, int vcu, int G, float* outp = nullptr) {
    const float* mod = (const float*)(a.ws + WS_MOD); const bf16_t* PAIR = (const bf16_t*)(a.ws + WS_PAIR);
    const int gw = vcu * NWAVES + wave, NGW = G * NWAVES;
    for (int row = gw; row < M; row += NGW) {
        const int b = row >> 11;
        GAS f32x4* hr = (GAS f32x4*)(a.out + (size_t)row * D) + lane; GAS f32x4* orow = outp ? (GAS f32x4*)(outp + (size_t)row * D) + lane : hr;
        const GAS u32x2* pp = (const GAS u32x2*)(PAIR + (size_t)row * 4 * D) + lane;
        f32x4 v[4]; float s = 0.f;
#pragma unroll
        for (int j = 0; j < 4; ++j) { const int col = 4 * lane + 256 * j; v[j] = hr[64 * j];
            f32x4 y = (f32x4){0.f, 0.f, 0.f, 0.f};
#pragma unroll
            for (int k = 0; k < 4; ++k) { const u32x2 w = pp[k * 256 + 64 * j]; y += (f32x4){bflo(w.x), bfhi(w.x), bflo(w.y), bfhi(w.y)}; }
            const f32x4 gt = *(const f32x4*)(mod + b * 6144 + 5120 + col);
            v[j] += gt * y; s += (v[j][0] * v[j][0] + v[j][1] * v[j][1]) + (v[j][2] * v[j][2] + v[j][3] * v[j][3]); }
        const float inv = 1.0f / sqrtf(wave_sum(s) * (1.f / D) + NORM_EPS);
#pragma unroll
        for (int j = 0; j < 4; ++j) { const f32x4 g = *(const f32x4*)(a.in[I_FG] + 4 * lane + 256 * j); orow[64 * j] = v[j] * inv * g; }
    }
}

constexpr int N_PHASES = 11;
__global__ void __launch_bounds__(NWAVES * 64, 2) hymba_fwd(Args a) {
    extern __shared__ __attribute__((aligned(16))) unsigned char lds_raw[];
    LAS unsigned char* lds = (LAS unsigned char*)lds_raw;
    volatile LAS unsigned* MISC = (volatile LAS unsigned*)(lds + LDS_MISC);
    const int tid = threadIdx.x, lane = tid & 63, wave = __builtin_amdgcn_readfirstlane(tid >> 6);
    const int G = gridDim.x; const int bx = blockIdx.x; const int vcu = (G % 8 == 0) ? (bx % 8) * (G / 8) + bx / 8 : bx;
    gu32* ctl = (gu32*)(a.ws + WS_CTL);
    if (tid < 128) MISC[tid] = 0u;
    __syncthreads();
    XcdBarrier bar; bar.bar = (unsigned*)(ctl + CW_BAR); bar.x = 0; bar.st = nullptr;
    if (MK_N_LAUNCHES == 1) bar = xcd_barrier_post((unsigned*)(ctl + CW_BAR), MISC + 8);
    const int lo = a.ph_lo, hi = a.ph_hi;
#ifndef PH_MASK
#define PH_MASK 0x7ff
#endif
#define IN(k) (((PH_MASK >> (k)) & 1) && lo <= (k) && (k) < hi)
#ifndef PROBE_DUP
#define PROBE_DUP -1
#endif
#define SEAM(k) do { if (IN(k) && IN((k) + 1)) xcd_barrier(bar); } while (0)
    if (IN(0)) { p0_phase(a, lds, tid, wave, lane, vcu, G); }
#if PROBE_DUP == 0
    __syncthreads();
    if (IN(0)) { p0_phase(a, lds, tid, wave, lane, vcu, G); }
#endif
    SEAM(0);
    if (IN(1)) { p1_phase(a, wave, lane, vcu, G); }
#if PROBE_DUP == 1
    if (IN(1)) { p1_phase(a, wave, lane, vcu, G); }
#endif
    SEAM(1);
    if (IN(2)) {
        DenseSched S{(const char*)(a.ws + WS_U), (const char*)(a.ws + WS_WIN), M / 256, NIN / 256, G, bx, (size_t)256 * 1024 * 2};
        EpiBf16 E{(bf16_t*)(a.ws + WS_PROJ), NIN};
        pg8::gemm_phase<EpiBf16, DenseSched, false, true>(lds, 1024, S, E);
        if (bx >= 128) expert_transposes(a, (LAS float*)lds, XP_ALL - XP2_ITEMS + (bx - 128) * 8 + wave, 128 * 8, lane);
    }
#if PROBE_DUP == 2
    if (IN(2)) {
        DenseSched S{(const char*)(a.ws + WS_U), (const char*)(a.ws + WS_WIN), M / 256, NIN / 256, G, bx, (size_t)256 * 1024 * 2};
        EpiBf16 E{(bf16_t*)(a.ws + WS_PROJ), NIN};
        pg8::gemm_phase<EpiBf16, DenseSched, false, true>(lds, 1024, S, E);
    }
#endif
    SEAM(2);
    if (IN(3)) { p3_phase(a, lds, tid, wave, lane, vcu, G); }
#if PROBE_DUP == 3
    if (IN(3)) { p3_phase(a, lds, tid, wave, lane, vcu, G); }
#endif
#if PROBE_DUP == 31
    if (IN(3)) { p3_phase(a, lds, tid, wave, lane, vcu, G, 1); }
#endif
#if PROBE_DUP == 32
    if (IN(3)) { p3_phase(a, lds, tid, wave, lane, vcu, G, 2); }
#endif
    SEAM(3);
    if (IN(4)) { p4_phase(a, lds, wave, lane, vcu, G); }
#if PROBE_DUP == 4
    if (IN(4)) { p4_phase(a, lds, wave, lane, vcu, G); }
#endif
    SEAM(4);
    if (IN(6)) {
        DenseSched S{(const char*)(a.ws + WS_YMIX), (const char*)(a.ws + WS_WOUT), M / 256, D / 256, G, bx, (size_t)256 * 1024 * 2};
        EpiResid E{a.in[I_X], a.out, (const float*)(a.ws + WS_MOD), (float*)(a.ws + WS_RSS)};
        pg8::gemm_phase<EpiResid, DenseSched, false, true>(lds, 1024, S, E);
    }
#if PROBE_DUP == 6
    if (IN(6)) {
        DenseSched S{(const char*)(a.ws + WS_YMIX), (const char*)(a.ws + WS_WOUT), M / 256, D / 256, G, bx, (size_t)256 * 1024 * 2};
        EpiResid E{a.in[I_X], a.out, (const float*)(a.ws + WS_MOD), (float*)(a.ws + WS_RSS)};
        pg8::gemm_phase<EpiResid, DenseSched, false, true>(lds, 1024, S, E);
    }
#endif
    SEAM(6);
#if PROBE_DUP == 7
    if (IN(7)) { p7_phase(a, lds, tid, wave, lane, CW_CNT + 1024); __syncthreads(); }
#endif
    if (IN(7)) { p7_phase(a, lds, tid, wave, lane); }
    SEAM(7);
    volatile LAS int* bstart = (volatile LAS int*)(lds + LDS_MISC + 128);
    volatile LAS int* ecnt = bstart + 40;
    volatile LAS unsigned char* blk_e = (volatile LAS unsigned char*)(lds + LDS_MISC - 1024);
    if (IN(8) || IN(9)) {
        if (tid == 0) { int s = 0; for (int e = 0; e < NE; ++e) { const int c = (int)__hip_atomic_load(ctl + CW_CNT + e, RLX_AGENT); ecnt[e] = c; bstart[e] = s; s += (c + 255) >> 8; } bstart[NE] = s; }
        __syncthreads();
        for (int pm = tid; pm < bstart[NE]; pm += NWAVES * 64) { int e = 0; for (int j = 1; j < NE; ++j) e += (bstart[j] <= pm) ? 1 : 0; blk_e[pm] = (unsigned char)e; }
        __syncthreads();
    }
    if (IN(8)) {
        constexpr int EB = FP8_G3 ? 1 : 2;
        MoeSched S{(const char*)(a.ws + WS_U), (const char*)(a.ws + WS_W1T), (size_t)2048 * 1024 * EB, bstart[NE], 8, G, bx, (size_t)256 * 1024 * EB, bstart, ecnt, (const int*)(a.ws + WS_LIST), 1024 * EB, true, blk_e};
        EpiSwiglu<FP8_G4 != 0> E{(bf16_t*)(a.ws + WS_ACT), a.in[I_B1], &S};
        pg8::gemm_phase<EpiSwiglu<FP8_G4 != 0>, MoeSched, true, true, FP8_G3 != 0>(lds, 512 * EB, S, E);
    }
#if PROBE_DUP == 8
    if (IN(8)) {
        constexpr int EB = FP8_G3 ? 1 : 2;
        MoeSched S{(const char*)(a.ws + WS_U), (const char*)(a.ws + WS_W1T), (size_t)2048 * 1024 * EB, bstart[NE], 8, G, bx, (size_t)256 * 1024 * EB, bstart, ecnt, (const int*)(a.ws + WS_LIST), 1024 * EB, true, blk_e};
        EpiSwiglu<FP8_G4 != 0> E{(bf16_t*)(a.ws + WS_ACT), a.in[I_B1], &S};
        pg8::gemm_phase<EpiSwiglu<FP8_G4 != 0>, MoeSched, true, true, FP8_G3 != 0>(lds, 512 * EB, S, E);
    }
#endif
#if PROBE_DUP == 81
    if (IN(8)) {
        constexpr int EB = FP8_G3 ? 1 : 2;
        MoeSched S{(const char*)(a.ws + WS_U), (const char*)(a.ws + WS_W1T), (size_t)2048 * 1024 * EB, bstart[NE], 8, G, bx, (size_t)256 * 1024 * EB, bstart, ecnt, (const int*)(a.ws + WS_LIST), 1024 * EB, true, blk_e};
        EpiNull E{};
        pg8::gemm_phase<EpiNull, MoeSched, true, true, FP8_G3 != 0>(lds, 512 * EB, S, E);
    }
#endif
    SEAM(8);
    if (IN(9)) {
        constexpr int EB = FP8_G4 ? 1 : 2;
        MoeSched S{(const char*)(a.ws + WS_ACT), (const char*)(a.ws + WS_W2T), (size_t)1024 * 1024 * EB, bstart[NE], 4, G, bx, (size_t)256 * 1024 * EB, bstart, ecnt, (const int*)(a.ws + WS_LIST), 1024 * EB, false, blk_e};
        EpiPair E{(bf16_t*)(a.ws + WS_PAIR), a.in[I_B2], &S};
        pg8::gemm_phase<EpiPair, MoeSched, false, true, FP8_G4 != 0>(lds, 512 * EB, S, E);
    }
#if PROBE_DUP == 9
    if (IN(9)) {
        constexpr int EB = FP8_G4 ? 1 : 2;
        MoeSched S{(const char*)(a.ws + WS_ACT), (const char*)(a.ws + WS_W2T), (size_t)1024 * 1024 * EB, bstart[NE], 4, G, bx, (size_t)256 * 1024 * EB, bstart, ecnt, (const int*)(a.ws + WS_LIST), 1024 * EB, false, blk_e};
        EpiPair E{(bf16_t*)(a.ws + WS_PAIR), a.in[I_B2], &S};
        pg8::gemm_phase<EpiPair, MoeSched, false, true, FP8_G4 != 0>(lds, 512 * EB, S, E);
    }
#endif
#if PROBE_DUP == 91
    if (IN(9)) {
        constexpr int EB = FP8_G4 ? 1 : 2;
        MoeSched S{(const char*)(a.ws + WS_ACT), (const char*)(a.ws + WS_W2T), (size_t)1024 * 1024 * EB, bstart[NE], 4, G, bx, (size_t)256 * 1024 * EB, bstart, ecnt, (const int*)(a.ws + WS_LIST), 1024 * EB, false, blk_e};
        EpiNull E{};
        pg8::gemm_phase<EpiNull, MoeSched, false, true, FP8_G4 != 0>(lds, 512 * EB, S, E);
    }
#endif
    SEAM(9);
#if PROBE_DUP == 10
    if (IN(10)) { p10_phase(a, wave, lane, vcu, G, (float*)(a.ws + WS_U)); }
#endif
    if (IN(10)) { p10_phase(a, wave, lane, vcu, G); }
#undef IN
#undef SEAM
}

extern "C" void kernel_launch(void* const* d_in, const int* in_sizes, int n_in, void* d_out, int out_size, void* d_ws, size_t ws_size, hipStream_t stream) {
    static int grid = 0;
    if (grid == 0) {
        if (n_in != 28 || in_sizes[0] != M * D || out_size != M * D || ws_size < WS_END) { fprintf(stderr, "kernel_launch: unexpected shapes / workspace (n_in %d, ws %zu)\n", n_in, ws_size); grid = -1; return; }
        int dev = 0, cus = 0;
        if (hipGetDevice(&dev) != hipSuccess || hipDeviceGetAttribute(&cus, hipDeviceAttributeMultiprocessorCount, dev) != hipSuccess) { grid = -1; return; }
        if (hipFuncSetAttribute((const void*)hymba_fwd, hipFuncAttributeMaxDynamicSharedMemorySize, LDS_TOTAL) != hipSuccess) { fprintf(stderr, "kernel_launch: hipFuncSetAttribute failed\n"); grid = -1; return; }
        (void)hipGetLastError();
        grid = cus;
        if (grid != 256) fprintf(stderr, "kernel_launch: %d CUs (built for 256)\n", grid);
    }
    if (grid < 0) return;
    if (hipMemsetAsync((char*)d_ws + WS_CTL, 0, CTL_ZERO_BYTES, stream) != hipSuccess) return;
    Args a{};
    for (int i = 0; i < 28; ++i) a.in[i] = (const float*)d_in[i];
    a.out = (float*)d_out; a.ws = (unsigned char*)d_ws;
#if MK_N_LAUNCHES == 1
    a.ph_lo = 0; a.ph_hi = N_PHASES;
    hipLaunchKernelGGL(hymba_fwd, dim3(grid), dim3(NWAVES * 64), LDS_TOTAL, stream, a);
#else
    for (int p = 0; p < N_PHASES; ++p) { a.ph_lo = p; a.ph_hi = p + 1; hipLaunchKernelGGL(hymba_fwd, dim3(grid), dim3(NWAVES * 64), LDS_TOTAL, stream, a); }
#endif
}
```
